# Optimizing an MI355X kernel written in HIP

```python
import math
import jax, jax.numpy as jnp
from jax import lax
import numpy as np

D_MODEL = 1024
BATCH = 32
SEQ = 2048
DEPTH = 4

GRID_W = 64
CTX_LEN = 256
N_EVEN = (DEPTH + 1) // 2
N_ODD = DEPTH // 2
D_FF = 4 * D_MODEL
Q_BLOCK = 128
ROPE_THETA = 10000.0
RMS_EPS = 1e-6
N_MOD = 6

HEAD_DIM = 64
DIFF_QK_DIM = HEAD_DIM
DIFF_V_DIM = 2 * HEAD_DIM
DIFF_HEADS = (D_MODEL // 2) // DIFF_V_DIM
DIFF_SCALE = DIFF_QK_DIM ** -0.5
GQA_DIM = HEAD_DIM
GQA_Q_HEADS = (D_MODEL // 2) // GQA_DIM
GQA_KV_HEADS = 2
GQA_GROUP = GQA_Q_HEADS // GQA_KV_HEADS
GQA_SCALE = GQA_DIM ** -0.5
AB_SPLITS = (DIFF_HEADS * 2 * DIFF_QK_DIM, DIFF_HEADS * 2 * DIFF_QK_DIM, DIFF_HEADS * DIFF_V_DIM,
             GQA_Q_HEADS * GQA_DIM, GQA_KV_HEADS * GQA_DIM, GQA_KV_HEADS * GQA_DIM)
AB_IN_W = sum(AB_SPLITS)
AB_OUT_W = DIFF_HEADS * DIFF_V_DIM + GQA_Q_HEADS * GQA_DIM
MLA_NOPE = 64
MLA_ROPE = 32
MLA_QK_DIM = MLA_NOPE + MLA_ROPE
MLA_V = 64
MLA_HEADS = D_MODEL // MLA_V
MLA_Q_RANK = D_MODEL // 2
MLA_KV_RANK = D_MODEL // 4
MLA_SPLITS = (MLA_Q_RANK, MLA_KV_RANK, MLA_ROPE)
MLA_IN_W = sum(MLA_SPLITS)
MLA_OUT_W = MLA_HEADS * MLA_V
MLA_SCALE = MLA_QK_DIM ** -0.5

kernel_name = 'hybrid_diffattn_gqa_mla_prefix_dit'


def rmsnorm(x, g):
    xf = x.astype(jnp.float32)
    y = xf * lax.rsqrt(jnp.mean(xf * xf, axis=-1, keepdims=True) + RMS_EPS)
    return (y * g.astype(jnp.float32)).astype(x.dtype)


def modulate(h, shift, scale):
    return h * (1 + scale) + shift


def lambda_init(layer):
    return 0.8 - 0.6 * math.exp(-0.3 * layer)


def split_cols(t, widths):
    idx = np.cumsum(widths)[:-1].tolist()
    return jnp.split(t, idx, axis=-1)


def axial_rope(n_tokens, rot_dim):
    rows = n_tokens // GRID_W
    n_freq = rot_dim // 4
    inv_freq = ROPE_THETA ** (-jnp.arange(n_freq, dtype=jnp.float32) / n_freq)
    row = jnp.repeat(jnp.arange(rows, dtype=jnp.float32), GRID_W)
    col = jnp.tile(jnp.arange(GRID_W, dtype=jnp.float32), rows)
    ang = jnp.concatenate([row[:, None] * inv_freq, col[:, None] * inv_freq], axis=-1)
    return jnp.cos(ang), jnp.sin(ang)


def apply_rope(x, cos, sin):
    half = x.shape[-1] // 2
    x1, x2 = x[..., :half], x[..., half:]
    cos, sin = cos.astype(x.dtype), sin.astype(x.dtype)
    return jnp.concatenate([x1 * cos - x2 * sin, x2 * cos + x1 * sin], axis=-1)


def blockwise(fn, q):
    *lead, n_q, d = q.shape
    nb = n_q // Q_BLOCK
    qb = jnp.moveaxis(q.reshape(*lead, nb, Q_BLOCK, d), -3, 0)
    ob = jnp.moveaxis(lax.map(fn, qb), 0, -3)
    return ob.reshape(*ob.shape[:-3], n_q, ob.shape[-1])


def gqa_attend(q, k, v, scale):
    s = jnp.einsum('bhgqd,bhkd->bhgqk', q, k).astype(jnp.float32) * scale
    p = jax.nn.softmax(s, axis=-1).astype(v.dtype)
    return jnp.einsum('bhgqk,bhkd->bhgqd', p, v)


def diff_attend(q, k, v, lam):
    s = jnp.einsum('bhmqd,bhmkd->bhmqk', q, k).astype(jnp.float32) * DIFF_SCALE
    p = jax.nn.softmax(s, axis=-1)
    a = (p[:, :, 0] - lam * p[:, :, 1]).astype(v.dtype)
    return jnp.einsum('bhqk,bhkd->bhqd', a, v)


def prefix_attention(attend, q_lat, k_lat, v_lat, q_ctx, k_ctx, v_ctx, compute_ctx):
    k_all = jnp.concatenate([k_ctx, k_lat], axis=-2)
    v_all = jnp.concatenate([v_ctx, v_lat], axis=-2)
    out_lat = blockwise(lambda qb: attend(qb, k_all, v_all), q_lat)
    out_ctx = attend(q_ctx, k_ctx, v_ctx) if compute_ctx else None
    return out_lat, out_ctx


def diff_gqa_mixer(h_lat, h_ctx, rope, w_in, w_out, diff_qk_norm, diff_lambda, diff_subln,
                   gqa_qk_norm, lam_init, compute_ctx):
    def project(h, rope_cs):
        b, n, _ = h.shape
        aq, ak, av, bq, bk, bv = split_cols(h @ w_in, AB_SPLITS)
        aq = rmsnorm(aq.reshape(b, n, DIFF_HEADS, 2, DIFF_QK_DIM).transpose(0, 2, 3, 1, 4), diff_qk_norm[0])
        ak = rmsnorm(ak.reshape(b, n, DIFF_HEADS, 2, DIFF_QK_DIM).transpose(0, 2, 3, 1, 4), diff_qk_norm[1])
        av = av.reshape(b, n, DIFF_HEADS, DIFF_V_DIM).transpose(0, 2, 1, 3)
        bq = rmsnorm(bq.reshape(b, n, GQA_KV_HEADS, GQA_GROUP, GQA_DIM).transpose(0, 2, 3, 1, 4), gqa_qk_norm[0])
        bk = rmsnorm(bk.reshape(b, n, GQA_KV_HEADS, GQA_DIM).transpose(0, 2, 1, 3), gqa_qk_norm[1])
        bv = bv.reshape(b, n, GQA_KV_HEADS, GQA_DIM).transpose(0, 2, 1, 3)
        if rope_cs is not None:
            cos, sin = rope_cs
            aq, ak, bq, bk = (apply_rope(t, cos, sin) for t in (aq, ak, bq, bk))
        return aq, ak, av, bq, bk, bv

    aq, ak, av, bq, bk, bv = project(h_lat, rope)
    caq, cak, cav, cbq, cbk, cbv = project(h_ctx, None)
    lq1, lk1, lq2, lk2 = diff_lambda.astype(jnp.float32)
    lam = jnp.exp(jnp.sum(lq1 * lk1)) - jnp.exp(jnp.sum(lq2 * lk2)) + lam_init
    a_lat, a_ctx = prefix_attention(lambda q, k, v: diff_attend(q, k, v, lam),
                                    aq, ak, av, caq, cak, cav, compute_ctx)
    b_lat, b_ctx = prefix_attention(lambda q, k, v: gqa_attend(q, k, v, GQA_SCALE),
                                    bq, bk, bv, cbq, cbk, cbv, compute_ctx)

    def merge(a, bo):
        bsz, _, n, _ = a.shape
        a = (rmsnorm(a, diff_subln) * (1.0 - lam_init)).transpose(0, 2, 1, 3).reshape(bsz, n, DIFF_HEADS * DIFF_V_DIM)
        bo = bo.transpose(0, 3, 1, 2, 4).reshape(bsz, n, GQA_Q_HEADS * GQA_DIM)
        return jnp.concatenate([a, bo], axis=-1) @ w_out

    y_ctx = merge(a_ctx, b_ctx) if compute_ctx else None
    return merge(a_lat, b_lat), y_ctx


def mla_mixer(h_lat, h_ctx, rope, w_in, q_norm, w_q_up, kv_norm, w_kv_up, qk_norm, w_out, compute_ctx):
    def project(h, rope_cs):
        b, n, _ = h.shape
        q_c, kv_c, k_r = split_cols(h @ w_in, MLA_SPLITS)
        q = (rmsnorm(q_c, q_norm) @ w_q_up).reshape(b, n, MLA_HEADS, MLA_QK_DIM).transpose(0, 2, 1, 3)
        kv = (rmsnorm(kv_c, kv_norm) @ w_kv_up).reshape(b, n, MLA_HEADS, MLA_NOPE + MLA_V).transpose(0, 2, 1, 3)
        k_nope, v = kv[..., :MLA_NOPE], kv[..., MLA_NOPE:]
        k_rope = jnp.broadcast_to(k_r[:, None], (b, MLA_HEADS, n, MLA_ROPE))
        k = jnp.concatenate([k_nope, k_rope], axis=-1)
        q = rmsnorm(q, qk_norm[0])
        k = rmsnorm(k, qk_norm[1])
        if rope_cs is not None:
            cos, sin = rope_cs
            q = jnp.concatenate([q[..., :MLA_NOPE], apply_rope(q[..., MLA_NOPE:], cos, sin)], axis=-1)
            k = jnp.concatenate([k[..., :MLA_NOPE], apply_rope(k[..., MLA_NOPE:], cos, sin)], axis=-1)
        return q[:, :, None], k, v

    q, k, v = project(h_lat, rope)
    cq, ck, cv = project(h_ctx, None)
    o_lat, o_ctx = prefix_attention(lambda qq, kk, vv: gqa_attend(qq, kk, vv, MLA_SCALE),
                                    q, k, v, cq, ck, cv, compute_ctx)

    def out(o):
        bsz, _, _, n, _ = o.shape
        return o[:, :, 0].transpose(0, 2, 1, 3).reshape(bsz, n, MLA_OUT_W) @ w_out

    y_ctx = out(o_ctx) if compute_ctx else None
    return out(o_lat), y_ctx


def sqrelu_mlp(h, w1, w2):
    return jnp.square(jax.nn.relu(h @ w1)) @ w2


def setup_inputs(seed: int = 0) -> dict:
    key = jax.random.key(seed)
    ks = jax.random.split(key, 23)
    f32 = jnp.float32

    def w(k, shape, fan_in, gain=1.0):
        return jax.random.normal(k, shape, f32) * (gain * fan_in ** -0.5)

    def g(k, shape):
        return 1.0 + 0.02 * jax.random.normal(k, shape, f32)

    return {
        'x': jax.random.normal(ks[0], (BATCH, SEQ, D_MODEL), f32),
        'c': jax.random.normal(ks[1], (BATCH, D_MODEL), f32),
        'ctx': jax.random.normal(ks[2], (BATCH, CTX_LEN, D_MODEL), f32),
        'c_ctx': jax.random.normal(ks[3], (D_MODEL,), f32),
        'ada_w': w(ks[4], (DEPTH, D_MODEL, N_MOD * D_MODEL), D_MODEL, 0.5),
        'ada_b': 0.02 * jax.random.normal(ks[5], (DEPTH, N_MOD * D_MODEL), f32),
        'norm_mix': g(ks[6], (DEPTH, D_MODEL)),
        'norm_mlp': g(ks[7], (DEPTH, D_MODEL)),
        'mlp_w1': w(ks[8], (DEPTH, D_MODEL, D_FF), D_MODEL),
        'mlp_w2': w(ks[9], (DEPTH, D_FF, D_MODEL), D_FF),
        'ab_w_in': w(ks[10], (N_EVEN, D_MODEL, AB_IN_W), D_MODEL),
        'ab_w_out': w(ks[11], (N_EVEN, AB_OUT_W, D_MODEL), AB_OUT_W),
        'diff_qk_norm': g(ks[12], (N_EVEN, 2, DIFF_QK_DIM)),
        'diff_lambda': 0.1 * jax.random.normal(ks[13], (N_EVEN, 4, DIFF_QK_DIM), f32),
        'diff_subln': g(ks[14], (N_EVEN, DIFF_V_DIM)),
        'gqa_qk_norm': g(ks[15], (N_EVEN, 2, GQA_DIM)),
        'mla_w_in': w(ks[16], (N_ODD, D_MODEL, MLA_IN_W), D_MODEL),
        'mla_q_norm': g(ks[17], (N_ODD, MLA_Q_RANK)),
        'mla_w_q_up': w(ks[18], (N_ODD, MLA_Q_RANK, MLA_HEADS * MLA_QK_DIM), MLA_Q_RANK),
        'mla_kv_norm': g(ks[19], (N_ODD, MLA_KV_RANK)),
        'mla_w_kv_up': w(ks[20], (N_ODD, MLA_KV_RANK, MLA_HEADS * (MLA_NOPE + MLA_V)), MLA_KV_RANK),
        'mla_qk_norm': g(ks[21], (N_ODD, 2, MLA_QK_DIM)),
        'mla_w_out': w(ks[22], (N_ODD, MLA_OUT_W, D_MODEL), MLA_OUT_W),
    }


def reference(x, c, ctx, c_ctx, ada_w, ada_b, norm_mix, norm_mlp, mlp_w1, mlp_w2,
              ab_w_in, ab_w_out, diff_qk_norm, diff_lambda, diff_subln, gqa_qk_norm,
              mla_w_in, mla_q_norm, mla_w_q_up, mla_kv_norm, mla_w_kv_up, mla_qk_norm, mla_w_out):
    n_lat = x.shape[1]
    rope_hd = axial_rope(n_lat, HEAD_DIM)
    rope_mla = axial_rope(n_lat, MLA_ROPE)
    silu_c = jax.nn.silu(c)
    silu_cc = jax.nn.silu(c_ctx)
    for layer in range(DEPTH):
        compute_ctx = layer < DEPTH - 1
        i = layer // 2
        mod_lat = (silu_c @ ada_w[layer] + ada_b[layer])[:, None, :]
        mod_ctx = silu_cc @ ada_w[layer] + ada_b[layer]
        sh1, sc1, g1, sh2, sc2, g2 = jnp.split(mod_lat, N_MOD, axis=-1)
        csh1, csc1, cg1, csh2, csc2, cg2 = jnp.split(mod_ctx, N_MOD, axis=-1)
        h_lat = modulate(rmsnorm(x, norm_mix[layer]), sh1, sc1)
        h_ctx = modulate(rmsnorm(ctx, norm_mix[layer]), csh1, csc1)
        if layer % 2 == 0:
            y_lat, y_ctx = diff_gqa_mixer(h_lat, h_ctx, rope_hd, ab_w_in[i], ab_w_out[i], diff_qk_norm[i],
                                          diff_lambda[i], diff_subln[i], gqa_qk_norm[i],
                                          lambda_init(layer), compute_ctx)
        else:
            y_lat, y_ctx = mla_mixer(h_lat, h_ctx, rope_mla, mla_w_in[i], mla_q_norm[i], mla_w_q_up[i],
                                     mla_kv_norm[i], mla_w_kv_up[i], mla_qk_norm[i], mla_w_out[i],
                                     compute_ctx)
        x = x + g1 * y_lat
        x = x + g2 * sqrelu_mlp(modulate(rmsnorm(x, norm_mlp[layer]), sh2, sc2), mlp_w1[layer], mlp_w2[layer])
        if compute_ctx:
            ctx = ctx + cg1 * y_ctx
            ctx = ctx + cg2 * sqrelu_mlp(modulate(rmsnorm(ctx, norm_mlp[layer]), csh2, csc2),
                                         mlp_w1[layer], mlp_w2[layer])
    return x
```

```cpp
#include <hip/hip_runtime.h>
#include <hip/hip_cooperative_groups.h>
#include <cstdio>
#include <cstdint>
#include <cmath>
namespace cg = cooperative_groups;
__device__ __forceinline__ int fresh_lane() { int m1 = -1; asm volatile("" : "+s"(m1)); return __builtin_amdgcn_mbcnt_hi(m1, __builtin_amdgcn_mbcnt_lo(m1, 0)); }
namespace pg8 {
#define PG8_LAS __attribute__((address_space(3)))
typedef unsigned short bf16_t;
typedef short bf16x8 __attribute__((ext_vector_type(8)));
typedef float f32x4 __attribute__((ext_vector_type(4)));
typedef unsigned u32x4 __attribute__((ext_vector_type(4)));
constexpr int BM = 256, BK = 64, HALF = 128, HTB = HALF * BK * 2  , STAGE_BYTES = 8 * HTB, NXCD = 8, WGM = 8;

__host__ __device__ __forceinline__ int lds_byte(int r, int c) { const int st = (r >> 4) * 2 + (c >> 5), rr = r & 15, cc = c & 31, ob = rr * 64 + cc * 2; return st * 1024 + (ob ^ (((ob >> 9) & 1) << 5)); }
__host__ __device__ __forceinline__ void stage_rc(int b, int& R, int& C) { const int st = b / 1024, sb = b % 1024, swz = sb ^ (((sb >> 9) & 1) << 5); R = (st >> 1) * 16 + swz / 64; C = (st & 1) * 32 + (swz % 64) / 2; }
__host__ __device__ __forceinline__ int perm32(int rho) { const int n = rho >> 4, i = rho & 15; return 8 * (i >> 2) + 4 * n + (i & 3); }

struct Unit { int pm, pn; };
struct Gemm { const bf16_t* A; const bf16_t* Bt; int M, N, K; };

struct StaticOrder {
    int nM, nN, nwg, G, c;
    __host__ __device__ void init(int M, int N, int G_, int c_) { nM = M / BM; nN = N / BM; nwg = nM * nN; G = G_; c = c_; }
    __host__ __device__ bool next(int i, Unit& u) const {
        const long L = (long)i * G + c; if (L >= nwg) return false;
        int wgid = (int)L; { const int q = nwg / NXCD, r = nwg % NXCD, xcd = wgid % NXCD, off = wgid / NXCD; wgid = (xcd < r ? xcd * (q + 1) : r * (q + 1) + (xcd - r) * q) + off; }
        const int nig = WGM * nN, gid = wgid / nig, fm = gid * WGM, gsz = (nM - fm) < WGM ? (nM - fm) : WGM;
        u.pm = fm + ((wgid % nig) % gsz); u.pn = (wgid % nig) / gsz; return true;
    }
    __device__ __forceinline__ void a_ready(const Unit&) const {}
    __device__ __forceinline__ void done(const Unit&) const {}
};

__device__ __forceinline__ unsigned cvt_pk_bf16(float lo, float hi) { unsigned r; asm volatile("v_cvt_pk_bf16_f32 %0, %1, %2" : "=v"(r) : "v"(lo), "v"(hi)); return r; }
typedef float f32x2 __attribute__((ext_vector_type(2)));
typedef unsigned u32x2 __attribute__((ext_vector_type(2)));
__device__ __forceinline__ float rinv_of(float ssq, float invn) { return 1.0f / sqrtf(ssq * invn + 1e-6f); }
__device__ __forceinline__ int mi_of_tile(int r0) { return r0 < 65536 ? (r0 >> 11) : 32; }
template <int ACT, int HEADMAP, bool NORM> struct EpiStore {
    static constexpr bool PERM = true, AFTER_DRAIN = false, HEAD64 = false;
    bf16_t* O; int ldc; const float* ssq; const float* shw; int ldshw; float invn;
    __device__ __forceinline__ void operator()(const f32x4 (&acc)[2][2][4][2], const Unit& u, int wr, int wc, int fr, int fq) const {
        { const int t_ = fresh_lane(); fr = t_ & 15; fq = (t_ >> 4) & 3; }
        const int row0 = u.pm * BM + wr * 64 + fr; const int colb = u.pn * BM + wc * 32 + 8 * fq;
        f32x4 sw[2][2];
        if (NORM) { const float* sp = shw + (size_t)mi_of_tile(u.pm * BM) * ldshw + colb;
#pragma unroll
            for (int bj = 0; bj < 2; ++bj) { sw[bj][0] = *(const f32x4*)(sp + bj * HALF); sw[bj][1] = *(const f32x4*)(sp + bj * HALF + 4); } }
        float riv[2][4];
#pragma unroll
        for (int ai = 0; ai < 2; ++ai)
#pragma unroll
            for (int m = 0; m < 4; ++m) riv[ai][m] = NORM ? ssq[row0 + ai * HALF + m * 16] : 0.f;
#pragma unroll
        for (int ai = 0; ai < 2; ++ai)
#pragma unroll
            for (int m = 0; m < 4; ++m) { const int row = row0 + ai * HALF + m * 16; bf16_t* rowp = O + (size_t)row * ldc;
                float ri = 1.0f; if (NORM) ri = rinv_of(riv[ai][m], invn);
#pragma unroll
                for (int bj = 0; bj < 2; ++bj) { const int c = colb + bj * HALF; const int dc = HEADMAP ? ((c >> 6) * 96 + (c & 63)) : c;
                    f32x4 v0 = acc[ai][bj][m][0], v1 = acc[ai][bj][m][1];
                    if (NORM) { v0 = v0 * ri + sw[bj][0]; v1 = v1 * ri + sw[bj][1]; }
                    if (ACT == 1) {
#pragma unroll
                        for (int e = 0; e < 4; ++e) { float a = v0[e] > 0.f ? v0[e] : 0.f; v0[e] = a * a; float b = v1[e] > 0.f ? v1[e] : 0.f; v1[e] = b * b; } }
                    u32x4 w; w.x = cvt_pk_bf16(v0[0], v0[1]); w.y = cvt_pk_bf16(v0[2], v0[3]); w.z = cvt_pk_bf16(v1[0], v1[1]); w.w = cvt_pk_bf16(v1[2], v1[3]);
                    *(u32x4*)(rowp + dc) = w; } }
    }
};
template <bool NORM> struct EpiVT {
    static constexpr bool PERM = true, AFTER_DRAIN = false, HEAD64 = false;
    bf16_t* VT; int NF; const float* ssq; const float* shw; int ldshw; float invn;
    __device__ __forceinline__ void operator()(const f32x4 (&acc)[2][2][4][2], const Unit& u, int wr, int wc, int fr, int fq) const {
        { const int t_ = fresh_lane(); fr = t_ & 15; fq = (t_ >> 4) & 3; }
        const int r0 = u.pn * BM; int b, kv0; if (r0 < 65536) { b = r0 >> 11; kv0 = 256 + (r0 & 2047); } else { b = (r0 - 65536) >> 8; kv0 = 0; }
        const int f0 = u.pm * BM + wr * 64 + fr;
        f32x4 ri[2][2];
        if (NORM) {
#pragma unroll
            for (int bj = 0; bj < 2; ++bj)
#pragma unroll
                for (int n = 0; n < 2; ++n) { const f32x4 s = *(const f32x4*)(ssq + r0 + bj * HALF + wc * 32 + 8 * fq + 4 * n); ri[bj][n] = (f32x4){rinv_of(s.x, invn), rinv_of(s.y, invn), rinv_of(s.z, invn), rinv_of(s.w, invn)}; } }
        const float* sp = NORM ? shw + (size_t)mi_of_tile(r0) * ldshw : nullptr;
        float shv[2][4];
#pragma unroll
        for (int ai = 0; ai < 2; ++ai)
#pragma unroll
            for (int m = 0; m < 4; ++m) shv[ai][m] = NORM ? sp[f0 + ai * HALF + m * 16] : 0.f;
#pragma unroll
        for (int ai = 0; ai < 2; ++ai)
#pragma unroll
            for (int m = 0; m < 4; ++m) { const int f = f0 + ai * HALF + m * 16; bf16_t* rowp = VT + ((size_t)b * NF + f) * 2304 + kv0;
                const float sh = shv[ai][m];
#pragma unroll
                for (int bj = 0; bj < 2; ++bj) { const int cw = bj * HALF + wc * 32 + 8 * fq; const int gb = cw & ~15, o = cw & 15;
#pragma unroll
                    for (int n = 0; n < 2; ++n) { const int o4 = o + 4 * n; const int pos = (o4 & 3) | (((o4 >> 2) & 1) << 3) | (((o4 >> 3) & 1) << 2);
                        f32x4 v = acc[ai][bj][m][n]; if (NORM) v = v * ri[bj][n] + sh;
                        u32x2 w; w.x = cvt_pk_bf16(v[0], v[1]); w.y = cvt_pk_bf16(v[2], v[3]);
                        *(u32x2*)(rowp + gb + pos) = w; } } }
    }
};
struct EpiMlaIn {
    static constexpr bool PERM = true, AFTER_DRAIN = false, HEAD64 = false;
    const float* ssq; const float* shw; bf16_t* QCg; bf16_t* KVCg; bf16_t* KR; const float* gq; const float* gkv; float* ssq_q; float* ssq_kv;
    __device__ __forceinline__ void operator()(const f32x4 (&acc)[2][2][4][2], const Unit& u, int wr, int wc, int fr, int fq) const {
        const int ln_ = fresh_lane(); fr = ln_ & 15; fq = (ln_ >> 4) & 3;
        const int row0 = u.pm * BM + wr * 64 + fr; const int colb = u.pn * BM + wc * 32 + 8 * fq;
        const float* sp = shw + (size_t)mi_of_tile(u.pm * BM) * 1024 + colb;
        f32x4 sw[2][2], gg[2][2];
#pragma unroll
        for (int bj = 0; bj < 2; ++bj) { sw[bj][0] = *(const f32x4*)(sp + bj * HALF); sw[bj][1] = *(const f32x4*)(sp + bj * HALF + 4);
            const int c = colb + bj * HALF;
            if (u.pn < 2) { gg[bj][0] = *(const f32x4*)(gq + c); gg[bj][1] = *(const f32x4*)(gq + c + 4); }
            else if (u.pn == 2) { gg[bj][0] = *(const f32x4*)(gkv + c - 512); gg[bj][1] = *(const f32x4*)(gkv + c - 508); }
            else { gg[bj][0] = (f32x4){1.f, 1.f, 1.f, 1.f}; gg[bj][1] = gg[bj][0]; } }
        float riv[2][4];
#pragma unroll
        for (int ai = 0; ai < 2; ++ai)
#pragma unroll
            for (int m = 0; m < 4; ++m) riv[ai][m] = ssq[row0 + ai * HALF + m * 16];
#pragma unroll
        for (int ai = 0; ai < 2; ++ai)
#pragma unroll
            for (int m = 0; m < 4; ++m) { const int row = row0 + ai * HALF + m * 16; const float ri = rinv_of(riv[ai][m], 1.0f / 1024.0f); float ps = 0.f;
#pragma unroll
                for (int bj = 0; bj < 2; ++bj) { const int c = colb + bj * HALF;
                    const f32x4 v0 = acc[ai][bj][m][0] * ri + sw[bj][0], v1 = acc[ai][bj][m][1] * ri + sw[bj][1];
                    ps += ((v0[0] * v0[0] + v0[1] * v0[1]) + (v0[2] * v0[2] + v0[3] * v0[3])) + ((v1[0] * v1[0] + v1[1] * v1[1]) + (v1[2] * v1[2] + v1[3] * v1[3]));
                    const f32x4 a0 = v0 * gg[bj][0], a1 = v1 * gg[bj][1];
                    u32x4 w; w.x = cvt_pk_bf16(a0[0], a0[1]); w.y = cvt_pk_bf16(a0[2], a0[3]); w.z = cvt_pk_bf16(a1[0], a1[1]); w.w = cvt_pk_bf16(a1[2], a1[3]);
                    if (u.pn < 2) *(u32x4*)(QCg + (size_t)row * 512 + c) = w;
                    else if (u.pn == 2) *(u32x4*)(KVCg + (size_t)row * 256 + (c - 512)) = w;
                    else if (c < 800) *(u32x4*)(KR + (size_t)row * 32 + (c - 768)) = w; }
                if (u.pn < 3) {
                    ps += __builtin_bit_cast(float, __builtin_amdgcn_ds_bpermute((ln_ ^ 16) << 2, __builtin_bit_cast(int, ps)));
                    ps += __builtin_bit_cast(float, __builtin_amdgcn_ds_bpermute((ln_ ^ 32) << 2, __builtin_bit_cast(int, ps)));
                    if (fq == 0) atomicAdd((u.pn < 2 ? ssq_q : ssq_kv) + row, ps); } }
    }
};
__device__ __forceinline__ void cs_rev(float a, float& c, float& s) {
    double rev = (double)a * 0.15915494309189535; rev -= floor(rev); const float rf = (float)rev; c = __builtin_amdgcn_cosf(rf); s = __builtin_amdgcn_sinf(rf); }
__device__ __forceinline__ float shx32(float v, int o, int lane) { return __builtin_bit_cast(float, __builtin_amdgcn_ds_bpermute((lane ^ o) << 2, __builtin_bit_cast(int, v))); }
struct EpiEvenIn {
    static constexpr bool PERM = true, AFTER_DRAIN = false, HEAD64 = true;
    bf16_t* O; const float* ssq; const float* shw; const float* gdk; const float* ggk;
    __device__ __forceinline__ void operator()(const f32x4 (&acc)[2][2][4][2], const Unit& u, int wr, int wc, int fr, int fq) const {
        const int ln_ = fresh_lane(); fr = ln_ & 15; fq = (ln_ >> 4) & 3;
        const int rt = u.pm * BM; const int row0 = rt + wr * 64 + fr; const int colb = u.pn * BM + wc * 64 + 8 * fq;
        const bool isk = (u.pn == 2) || (u.pn == 3) || (u.pn == 6 && wc < 2); const bool isl = rt < 65536;
        const float* sp = shw + (size_t)mi_of_tile(rt) * 2560 + colb;
        f32x4 sw[2][2], gg[2][2]; float invf[8];
#pragma unroll
        for (int bj = 0; bj < 2; ++bj)
#pragma unroll
            for (int n = 0; n < 2; ++n) { sw[bj][n] = *(const f32x4*)(sp + 32 * bj + 4 * n); gg[bj][n] = (f32x4){1.f, 1.f, 1.f, 1.f}; }
        if (isk) { const float* g = (u.pn == 6) ? ggk : gdk;
#pragma unroll
            for (int bj = 0; bj < 2; ++bj)
#pragma unroll
                for (int n = 0; n < 2; ++n) gg[bj][n] = *(const f32x4*)(g + 32 * bj + 8 * fq + 4 * n);
#pragma unroll
            for (int j = 0; j < 8; ++j) invf[j] = exp2f(-(float)((8 * fq + j) & 15) * (13.287712379549449f / 16.0f)); }
        float riv[2][4];
#pragma unroll
        for (int ai = 0; ai < 2; ++ai)
#pragma unroll
            for (int m = 0; m < 4; ++m) riv[ai][m] = ssq[row0 + ai * HALF + m * 16];
#pragma unroll
        for (int ai = 0; ai < 2; ++ai)
#pragma unroll
            for (int m = 0; m < 4; ++m) { const int row = row0 + ai * HALF + m * 16; const float ri = rinv_of(riv[ai][m], 1.0f / 1024.0f);
                f32x4 v[2][2];
#pragma unroll
                for (int bj = 0; bj < 2; ++bj)
#pragma unroll
                    for (int n = 0; n < 2; ++n) v[bj][n] = acc[ai][bj][m][n] * ri + sw[bj][n];
                if (isk) { float ss = 0.f;
#pragma unroll
                    for (int bj = 0; bj < 2; ++bj)
#pragma unroll
                        for (int n = 0; n < 2; ++n) ss += (v[bj][n][0] * v[bj][n][0] + v[bj][n][1] * v[bj][n][1]) + (v[bj][n][2] * v[bj][n][2] + v[bj][n][3] * v[bj][n][3]);
                    ss += shx32(ss, 16, ln_); ss += shx32(ss, 32, ln_);
                    const float rh = 1.0f / sqrtf(ss * (1.0f / 64.0f) + 1e-6f);
#pragma unroll
                    for (int bj = 0; bj < 2; ++bj)
#pragma unroll
                        for (int n = 0; n < 2; ++n) v[bj][n] = v[bj][n] * rh * gg[bj][n];
                    if (isl) { const int t = row & 2047; const float pos = (fq < 2) ? (float)(t >> 6) : (float)(t & 63);
#pragma unroll
                        for (int n = 0; n < 2; ++n)
#pragma unroll
                            for (int e = 0; e < 4; ++e) { float c, s; cs_rev(pos * invf[4 * n + e], c, s); const float x1 = v[0][n][e], x2 = v[1][n][e]; v[0][n][e] = x1 * c - x2 * s; v[1][n][e] = x2 * c + x1 * s; } } }
#pragma unroll
                for (int bj = 0; bj < 2; ++bj) { u32x4 w; w.x = cvt_pk_bf16(v[bj][0][0], v[bj][0][1]); w.y = cvt_pk_bf16(v[bj][0][2], v[bj][0][3]); w.z = cvt_pk_bf16(v[bj][1][0], v[bj][1][1]); w.w = cvt_pk_bf16(v[bj][1][2], v[bj][1][3]);
                    *(u32x4*)(O + (size_t)row * 1792 + colb + 32 * bj) = w; } }
    }
};
struct EpiMlaKn {
    static constexpr bool PERM = true, AFTER_DRAIN = false, HEAD64 = true;
    bf16_t* K; const float* ssq_kv; const bf16_t* KR; const float* gk;
    __device__ __forceinline__ void operator()(const f32x4 (&acc)[2][2][4][2], const Unit& u, int wr, int wc, int fr, int fq) const {
        const int ln_ = fresh_lane(); fr = ln_ & 15; fq = (ln_ >> 4) & 3;
        const int rt = u.pm * BM; const int row0 = rt + wr * 64 + fr; const int h = 4 * u.pn + wc; const bool isl = rt < 65536;
        f32x4 gg[2][2], gr[2]; float invf[8];
#pragma unroll
        for (int bj = 0; bj < 2; ++bj)
#pragma unroll
            for (int n = 0; n < 2; ++n) gg[bj][n] = *(const f32x4*)(gk + 32 * bj + 8 * fq + 4 * n);
        gr[0] = *(const f32x4*)(gk + 64 + 8 * fq); gr[1] = *(const f32x4*)(gk + 64 + 8 * fq + 4);
#pragma unroll
        for (int j = 0; j < 8; ++j) invf[j] = exp2f(-(float)j * (13.287712379549449f / 8.0f));
        float riv[2][4];
#pragma unroll
        for (int ai = 0; ai < 2; ++ai)
#pragma unroll
            for (int m = 0; m < 4; ++m) riv[ai][m] = ssq_kv[row0 + ai * HALF + m * 16];
        u32x4 kwn = *(const u32x4*)(KR + (size_t)row0 * 32 + 8 * fq);
#pragma unroll
        for (int ai = 0; ai < 2; ++ai)
#pragma unroll
            for (int m = 0; m < 4; ++m) { const int row = row0 + ai * HALF + m * 16; const float ri = rinv_of(riv[ai][m], 1.0f / 256.0f);
                const u32x4 kw = kwn; { const int nx = ai * 4 + m + 1; if (nx < 8) kwn = *(const u32x4*)(KR + (size_t)(row0 + (nx >> 2) * HALF + (nx & 3) * 16) * 32 + 8 * fq); }
                float r[8] = {__builtin_bit_cast(float, kw.x << 16), __builtin_bit_cast(float, kw.x & 0xffff0000u), __builtin_bit_cast(float, kw.y << 16), __builtin_bit_cast(float, kw.y & 0xffff0000u),
                              __builtin_bit_cast(float, kw.z << 16), __builtin_bit_cast(float, kw.z & 0xffff0000u), __builtin_bit_cast(float, kw.w << 16), __builtin_bit_cast(float, kw.w & 0xffff0000u)};
                f32x4 v[2][2]; float ss = 0.f;
#pragma unroll
                for (int bj = 0; bj < 2; ++bj)
#pragma unroll
                    for (int n = 0; n < 2; ++n) { v[bj][n] = acc[ai][bj][m][n] * ri; ss += (v[bj][n][0] * v[bj][n][0] + v[bj][n][1] * v[bj][n][1]) + (v[bj][n][2] * v[bj][n][2] + v[bj][n][3] * v[bj][n][3]); }
#pragma unroll
                for (int j = 0; j < 8; ++j) ss += r[j] * r[j];
                ss += shx32(ss, 16, ln_); ss += shx32(ss, 32, ln_);
                const float rh = 1.0f / sqrtf(ss * (1.0f / 96.0f) + 1e-6f);
#pragma unroll
                for (int bj = 0; bj < 2; ++bj)
#pragma unroll
                    for (int n = 0; n < 2; ++n) v[bj][n] = v[bj][n] * rh * gg[bj][n];
#pragma unroll
                for (int j = 0; j < 8; ++j) r[j] *= rh * gr[j >> 2][j & 3];
                if (isl) { const int t = row & 2047; const float pos = (fq & 1) ? (float)(t & 63) : (float)(t >> 6);
#pragma unroll
                    for (int j = 0; j < 8; ++j) { const float pr = shx32(r[j], 32, ln_); float c, s; cs_rev(pos * invf[j], c, s); r[j] = (fq < 2) ? (r[j] * c - pr * s) : (r[j] * c + pr * s); } }
                bf16_t* kp = K + (size_t)row * 1536 + h * 96 + 8 * fq;
#pragma unroll
                for (int bj = 0; bj < 2; ++bj) { u32x4 w; w.x = cvt_pk_bf16(v[bj][0][0], v[bj][0][1]); w.y = cvt_pk_bf16(v[bj][0][2], v[bj][0][3]); w.z = cvt_pk_bf16(v[bj][1][0], v[bj][1][1]); w.w = cvt_pk_bf16(v[bj][1][2], v[bj][1][3]);
                    *(u32x4*)(kp + 32 * bj) = w; }
                { u32x4 w; w.x = cvt_pk_bf16(r[0], r[1]); w.y = cvt_pk_bf16(r[2], r[3]); w.z = cvt_pk_bf16(r[4], r[5]); w.w = cvt_pk_bf16(r[6], r[7]); *(u32x4*)(kp + 64) = w; } }
    }
};
struct EpiResid {
    static constexpr bool PERM = true, AFTER_DRAIN = false, HEAD64 = false;
    const float* base_lat; const float* base_ctx; float* out_lat; float* out_ctx; const float* gate;
    bf16_t* AP; const float* gn; const float* scn; float* ssq;
    __device__ __forceinline__ void operator()(const f32x4 (&acc)[2][2][4][2], const Unit& u, int wr, int wc, int fr, int fq) const {
        const int ln_ = fresh_lane(); fr = ln_ & 15; fq = (ln_ >> 4) & 3;
        const int rt = u.pm * BM; const bool isl = rt < 65536; const int mi = isl ? (rt >> 11) : 32;
        const float* bp = isl ? base_lat + (size_t)rt * 1024 : base_ctx + (size_t)(rt - 65536) * 1024;
        float* op = isl ? out_lat + (size_t)rt * 1024 : out_ctx + (size_t)(rt - 65536) * 1024;
        bf16_t* ap = AP + (size_t)rt * 1024;
        const int col0 = u.pn * BM + wc * 32 + 8 * fq; const float* gp = gate + mi * 6144 + col0; const float* sp = scn + mi * 6144 + col0; const float* gnp = gn + col0;
        float ps[2][4];
#pragma unroll
        for (int ai = 0; ai < 2; ++ai)
#pragma unroll
            for (int m = 0; m < 4; ++m) ps[ai][m] = 0.f;
#pragma unroll
        for (int bj = 0; bj < 2; ++bj) { const int co = bj * HALF;
            const f32x4 gv0 = *(const f32x4*)(gp + co), gv1 = *(const f32x4*)(gp + co + 4);
            const f32x4 gs0 = *(const f32x4*)(gnp + co) * (*(const f32x4*)(sp + co) + 1.0f), gs1 = *(const f32x4*)(gnp + co + 4) * (*(const f32x4*)(sp + co + 4) + 1.0f);
#pragma unroll
            for (int ai = 0; ai < 2; ++ai) {
                f32x4 b0[4], b1[4];
#pragma unroll
                for (int m = 0; m < 4; ++m) { const size_t off = (size_t)(ai * HALF + wr * 64 + m * 16 + fr) * 1024 + col0 + co; b0[m] = *(const f32x4*)(bp + off); b1[m] = *(const f32x4*)(bp + off + 4); }
#pragma unroll
                for (int m = 0; m < 4; ++m) { const size_t off = (size_t)(ai * HALF + wr * 64 + m * 16 + fr) * 1024 + col0 + co;
                    const f32x4 o0 = b0[m] + gv0 * acc[ai][bj][m][0], o1 = b1[m] + gv1 * acc[ai][bj][m][1];
                    *(f32x4*)(op + off) = o0; *(f32x4*)(op + off + 4) = o1;
                    const f32x4 a0 = o0 * gs0, a1 = o1 * gs1; u32x4 w; w.x = cvt_pk_bf16(a0[0], a0[1]); w.y = cvt_pk_bf16(a0[2], a0[3]); w.z = cvt_pk_bf16(a1[0], a1[1]); w.w = cvt_pk_bf16(a1[2], a1[3]);
                    *(u32x4*)(ap + off) = w;
                    ps[ai][m] += ((o0[0] * o0[0] + o0[1] * o0[1]) + (o0[2] * o0[2] + o0[3] * o0[3])) + ((o1[0] * o1[0] + o1[1] * o1[1]) + (o1[2] * o1[2] + o1[3] * o1[3])); }
                asm volatile("" ::: "memory"); } }
#pragma unroll
        for (int ai = 0; ai < 2; ++ai)
#pragma unroll
            for (int m = 0; m < 4; ++m) { float s = ps[ai][m];
                s += __builtin_bit_cast(float, __builtin_amdgcn_ds_bpermute((ln_ ^ 16) << 2, __builtin_bit_cast(int, s)));
                s += __builtin_bit_cast(float, __builtin_amdgcn_ds_bpermute((ln_ ^ 32) << 2, __builtin_bit_cast(int, s)));
                if (fq == 0) atomicAdd(ssq + rt + ai * HALF + wr * 64 + m * 16 + fr, s); }
    }
};
struct EpiShw {
    static constexpr bool PERM = false, AFTER_DRAIN = false, HEAD64 = false;
    float* SHW;
    __device__ __forceinline__ void operator()(const f32x4 (&acc)[2][2][4][2], const Unit& u, int wr, int wc, int fr, int fq) const {
        { const int t_ = fresh_lane(); fr = t_ & 15; fq = (t_ >> 4) & 3; }
        if (wr != 0) return;
        const int L = u.pm >> 1, w = u.pm & 1; const int i2 = L >> 1;
        const int t0 = w ? (64 + L * 32) : ((L & 1) ? (32 + i2 * 16) : (i2 * 16));
        const int ld = w ? 4096 : ((L & 1) ? 1024 : 2560);
        float* dst = SHW + (size_t)L * 33 * 8192 + (w ? 33 * 4096 : 0) + (u.pn - t0) * 256 + wc * 32 + 4 * fq;
#pragma unroll
        for (int m = 0; m < 3; ++m) { const int row = m * 16 + fr; if (row < 33) {
#pragma unroll
                for (int bj = 0; bj < 2; ++bj)
#pragma unroll
                    for (int n = 0; n < 2; ++n) *(f32x4*)(dst + (size_t)row * ld + bj * HALF + n * 16) = acc[0][bj][m][n]; } }
    }
};
struct ShwOrder {
    int G, c;
    __device__ __forceinline__ bool next(int i, Unit& u) const {
        int j = i * G + c; if (j >= 92) return false;
        int L = 0; if (j >= 26) { j -= 26; L = 1; if (j >= 20) { j -= 20; L = 2; if (j >= 26) { j -= 26; L = 3; } } }
        const int nin = (L & 1) ? 4 : 10; const int i2 = L >> 1;
        if (j < nin) { u.pm = 2 * L; u.pn = ((L & 1) ? (32 + i2 * 16) : (i2 * 16)) + j; }
        else { u.pm = 2 * L + 1; u.pn = 64 + L * 32 + (j - nin); }
        return true;
    }
    __device__ __forceinline__ void a_ready(const Unit&) const {}
    __device__ __forceinline__ void done(const Unit&) const {}
};
template <class Epi, class Sched, bool ALIGN_EPI = false, bool SP2 = false>
__device__ __forceinline__ void gemm_phase(PG8_LAS unsigned char* lds, const Gemm g, const Sched& S, const Epi& E, const int wave_s) {
    int tid_ = wave_s * 64 + fresh_lane();
    const int tid = tid_, wid = __builtin_amdgcn_readfirstlane(tid >> 6), lane = tid & 63, wr = wid >> 2, wc = wid & 3, fr = lane & 15, fq = lane >> 4;
    const int K = g.K, nt = K / BK;
    unsigned voffA[2], voffB[2];
#pragma unroll
    for (int i = 0; i < 2; ++i) { int R, C; stage_rc(tid * 16 + i * 8192, R, C); const int Rb = Epi::HEAD64 ? (64 * (R >> 5) + perm32(R & 31)) : (Epi::PERM ? ((R & ~31) + perm32(R & 31)) : R);
        voffA[i] = (unsigned)(R * K + C) * 2u; voffB[i] = (unsigned)(Rb * K + C) * 2u; }
    const size_t kstep = (size_t)(BK * 2);
    const size_t hstep = (size_t)HALF * K * 2;
    const size_t hstepB = Epi::HEAD64 ? (size_t)32 * K * 2 : hstep;
    const size_t tstep = 2 * hstep;
    const unsigned ldsw = (unsigned)wid * 1024u;
    const int aoff = lds_byte(wr * 64 + fr, fq * 8), boff = lds_byte(wc * 32 + fr, fq * 8);
#define PG8_SA(b, h) (((b) * 2 + (h)) * HTB)
#define PG8_SB(b, h) ((4 + (b) * 2 + (h)) * HTB)
#define PG8_STAGE(bufoff, gbase, voff) do { _Pragma("unroll") for (int _i = 0; _i < 2; ++_i) \
        __builtin_amdgcn_global_load_lds((const unsigned*)((const char*)(gbase) + (voff)[_i]), (PG8_LAS unsigned*)(lds + (bufoff) + ldsw + _i * 8192), 16, 0, 0); } while (0)
#define PG8_LDA(dst, b, h) do { _Pragma("unroll") for (int m = 0; m < 4; ++m) _Pragma("unroll") for (int k = 0; k < 2; ++k) dst[m][k] = *(const PG8_LAS bf16x8*)(lds + PG8_SA(b, h) + aoff + m * 2048 + k * 1024); } while (0)
#define PG8_LDB(dst, b, h) do { _Pragma("unroll") for (int n = 0; n < 2; ++n) _Pragma("unroll") for (int k = 0; k < 2; ++k) dst[n][k] = *(const PG8_LAS bf16x8*)(lds + PG8_SB(b, h) + boff + n * 2048 + k * 1024); } while (0)
#define PG8_MMA(ai, bj, At, Bt) do { __builtin_amdgcn_s_setprio(1); _Pragma("unroll") for (int m = 0; m < 4; ++m) _Pragma("unroll") for (int n = 0; n < 2; ++n) _Pragma("unroll") for (int k = 0; k < 2; ++k) \
        acc[ai][bj][m][n] = __builtin_amdgcn_mfma_f32_16x16x32_bf16(Bt[n][k], At[m][k], acc[ai][bj][m][n], 0, 0, 0); __builtin_amdgcn_s_setprio(0); } while (0)
#define PG8_WAIT_V(n) asm volatile("s_waitcnt vmcnt(" #n ")" ::: "memory")
#define PG8_WAIT_L(n) asm volatile("s_waitcnt lgkmcnt(" #n ")" ::: "memory")
#define PG8_BAR __builtin_amdgcn_s_barrier()
#define PG8_SCHED __builtin_amdgcn_sched_barrier(0)
    Unit cur, nxt; int ui = 0;
    if (!S.next(0, cur)) return;
    f32x4 acc[2][2][4][2];
#pragma unroll
    for (int a = 0; a < 2; ++a)
#pragma unroll
        for (int b = 0; b < 2; ++b)
#pragma unroll
            for (int m = 0; m < 4; ++m)
#pragma unroll
                for (int n = 0; n < 2; ++n) acc[a][b][m][n] = (f32x4){0.f, 0.f, 0.f, 0.f};
    bf16x8 At[4][2], B0[2][2], B1[2][2];
    const char* cA = (const char*)g.A + (size_t)cur.pm * tstep; const char* cB = (const char*)g.Bt + (size_t)cur.pn * tstep;
    S.a_ready(cur);
    if constexpr (SP2) {
        PG8_STAGE(PG8_SB(0, 0), cB, voffB); PG8_STAGE(PG8_SB(0, 1), cB + hstepB, voffB); PG8_STAGE(PG8_SA(0, 0), cA, voffA); PG8_STAGE(PG8_SA(0, 1), cA + hstep, voffA);
        if (wr == 1) PG8_BAR;
        PG8_WAIT_V(2); PG8_BAR;
        PG8_STAGE(PG8_SB(1, 0), cB + kstep, voffB); PG8_STAGE(PG8_SA(1, 0), cA + kstep, voffA); PG8_STAGE(PG8_SB(1, 1), cB + hstepB + kstep, voffB);
        PG8_WAIT_V(6); PG8_BAR;
    } else {
        PG8_STAGE(PG8_SB(0, 0), cB, voffB); PG8_STAGE(PG8_SA(0, 0), cA, voffA); PG8_STAGE(PG8_SB(0, 1), cB + hstepB, voffB); PG8_STAGE(PG8_SA(0, 1), cA + hstep, voffA);
        if (wr == 1) PG8_BAR;
        PG8_WAIT_V(4); PG8_BAR;
        PG8_STAGE(PG8_SB(1, 0), cB + kstep, voffB); PG8_STAGE(PG8_SA(1, 0), cA + kstep, voffA); PG8_STAGE(PG8_SB(1, 1), cB + hstepB + kstep, voffB);
        PG8_WAIT_V(6); PG8_BAR;
    }
    for (;;) {
        const bool has_next = S.next(ui + 1, nxt);
        const char* nA = has_next ? (const char*)g.A + (size_t)nxt.pm * tstep : cA; const char* nB = has_next ? (const char*)g.Bt + (size_t)nxt.pn * tstep : cB;
        for (int t = 0; t < nt; t += 2) {
            const bool last = (t == nt - 2);
            const char* a1 = cA + (size_t)(t + 1) * kstep;
            const char* a2 = last ? nA : cA + (size_t)(t + 2) * kstep; const char* b2 = last ? nB : cB + (size_t)(t + 2) * kstep;
            const char* a3 = a2 + kstep; const char* b3 = b2 + kstep;
            if (last && has_next) S.a_ready(nxt);
            if constexpr (SP2) {
            PG8_LDB(B0, 0, 0); PG8_LDB(B1, 0, 1); PG8_SCHED; PG8_LDA(At, 0, 0); PG8_STAGE(PG8_SA(1, 1), a1 + hstep, voffA);
            PG8_WAIT_V(8); PG8_WAIT_L(0); PG8_BAR; PG8_MMA(0, 0, At, B0); PG8_MMA(0, 1, At, B1); PG8_BAR; PG8_SCHED;
            PG8_LDA(At, 0, 1); PG8_STAGE(PG8_SB(0, 0), b2, voffB); PG8_STAGE(PG8_SB(0, 1), b2 + hstepB, voffB); PG8_STAGE(PG8_SA(0, 0), a2, voffA);
            PG8_WAIT_V(8); PG8_WAIT_L(0); PG8_BAR; PG8_MMA(1, 0, At, B0); PG8_MMA(1, 1, At, B1); PG8_BAR; PG8_SCHED;
            PG8_LDB(B0, 1, 0); PG8_LDB(B1, 1, 1); PG8_SCHED; PG8_LDA(At, 1, 0); PG8_STAGE(PG8_SA(0, 1), a2 + hstep, voffA);
            PG8_WAIT_V(8); PG8_WAIT_L(0); PG8_BAR; PG8_MMA(0, 0, At, B0); PG8_MMA(0, 1, At, B1); PG8_BAR; PG8_SCHED;
            PG8_LDA(At, 1, 1); PG8_STAGE(PG8_SB(1, 0), b3, voffB); PG8_STAGE(PG8_SB(1, 1), b3 + hstepB, voffB); PG8_STAGE(PG8_SA(1, 0), a3, voffA);
            PG8_WAIT_V(8); PG8_WAIT_L(0); PG8_BAR; PG8_MMA(1, 0, At, B0); PG8_MMA(1, 1, At, B1); PG8_BAR; PG8_SCHED;
            } else {
            PG8_LDB(B0, 0, 0); PG8_SCHED; PG8_LDA(At, 0, 0); PG8_STAGE(PG8_SA(1, 1), a1 + hstep, voffA);
            PG8_WAIT_L(8); PG8_BAR; PG8_WAIT_L(0); PG8_MMA(0, 0, At, B0); PG8_BAR; PG8_SCHED;
            PG8_LDB(B1, 0, 1); PG8_STAGE(PG8_SB(0, 0), b2, voffB);
            PG8_BAR; PG8_WAIT_L(0); PG8_MMA(0, 1, At, B1); PG8_BAR;
            PG8_LDA(At, 0, 1); PG8_STAGE(PG8_SA(0, 0), a2, voffA);
            PG8_BAR; PG8_WAIT_L(0); PG8_MMA(1, 0, At, B0); PG8_BAR; PG8_SCHED;
            PG8_STAGE(PG8_SB(0, 1), b2 + hstepB, voffB);
            PG8_WAIT_V(6); PG8_BAR; PG8_MMA(1, 1, At, B1); PG8_BAR;
            PG8_LDB(B0, 1, 0); PG8_SCHED; PG8_LDA(At, 1, 0); PG8_STAGE(PG8_SA(0, 1), a2 + hstep, voffA);
            PG8_WAIT_L(8); PG8_BAR; PG8_WAIT_L(0); PG8_MMA(0, 0, At, B0); PG8_BAR; PG8_SCHED;
            PG8_LDB(B1, 1, 1); PG8_STAGE(PG8_SB(1, 0), b3, voffB);
            PG8_BAR; PG8_WAIT_L(0); PG8_MMA(0, 1, At, B1); PG8_BAR;
            PG8_LDA(At, 1, 1); PG8_STAGE(PG8_SA(1, 0), a3, voffA);
            PG8_BAR; PG8_WAIT_L(0); PG8_MMA(1, 0, At, B0); PG8_BAR; PG8_SCHED;
            PG8_STAGE(PG8_SB(1, 1), b3 + hstepB, voffB);
            PG8_WAIT_V(6); PG8_BAR; PG8_MMA(1, 1, At, B1); PG8_BAR;
            }
        }
        if constexpr (ALIGN_EPI) { if (wr == 0) PG8_BAR; }
        if constexpr (!Epi::AFTER_DRAIN) { E(acc, cur, wr, wc, fr, fq); S.done(cur); }
        if (!has_next) break;
#pragma unroll
        for (int a = 0; a < 2; ++a)
#pragma unroll
            for (int b = 0; b < 2; ++b)
#pragma unroll
                for (int m = 0; m < 4; ++m)
#pragma unroll
                    for (int n = 0; n < 2; ++n) acc[a][b][m][n] = (f32x4){0.f, 0.f, 0.f, 0.f};
        cur = nxt; cA = nA; cB = nB; ++ui;
        if constexpr (ALIGN_EPI) { if (wr == 1) PG8_BAR; }
    }
    PG8_WAIT_V(0);
    if constexpr (!ALIGN_EPI) { if (wr == 0) PG8_BAR; }
    PG8_BAR;
    if constexpr (Epi::AFTER_DRAIN) { E.fused(acc, cur, wr, wc, fr, fq, lds, wid, lane); S.done(cur); }
#undef PG8_SA
#undef PG8_SB
#undef PG8_STAGE
#undef PG8_LDA
#undef PG8_LDB
#undef PG8_MMA
#undef PG8_WAIT_V
#undef PG8_WAIT_L
#undef PG8_BAR
#undef PG8_SCHED
}
}

#define LAS __attribute__((address_space(3)))
typedef unsigned short bf16;
typedef short bf16x8 __attribute__((ext_vector_type(8)));
typedef float f32x4 __attribute__((ext_vector_type(4)));
typedef float f32x2 __attribute__((ext_vector_type(2)));
typedef float f32x16 __attribute__((ext_vector_type(16)));
typedef unsigned u32x4 __attribute__((ext_vector_type(4)));
typedef unsigned u32x2 __attribute__((ext_vector_type(2)));

constexpr int NWAVES = 8, NTHR = 512;
constexpr int NLAT = 65536, NCTX = 8192, R = NLAT + NCTX;
constexpr int D = 1024, FF = 4096, KV = 2304;
constexpr float EPS = 1e-6f, LOG2E = 1.4426950408889634f;
constexpr size_t MiB = 1u << 20;
constexpr size_t WS_MOD = 0, WS_W = 4 * MiB, WS_XCTX = 100 * MiB, WS_H = 132 * MiB, WS_R = 276 * MiB, WS_CTL = 996 * MiB, WS_SSQ = 997 * MiB, WS_SHB = 998 * MiB, WS_SHW = 1002 * MiB, WS_SSQM = 1007 * MiB, WS_END = 1008 * MiB;
constexpr size_t CTL_BYTES = 16384;
constexpr int MISC_OFF = 147456 - 64;
constexpr int LDS_BYTES = 147456;
constexpr int RAWP = 1792;
constexpr int MQP = 1536;

__device__ __forceinline__ unsigned f2bf(float f) { unsigned u = __builtin_bit_cast(unsigned, f); return (u + 0x7fffu + ((u >> 16) & 1u)) >> 16; }
__device__ __forceinline__ unsigned pk2(float lo, float hi) { return f2bf(lo) | (f2bf(hi) << 16); }
typedef __bf16 bf16x2_t __attribute__((ext_vector_type(2)));
__device__ __forceinline__ unsigned cvtpk_nv(float lo, float hi) { f32x2 v = {lo, hi}; bf16x2_t b = __builtin_convertvector(v, bf16x2_t); return __builtin_bit_cast(unsigned, b); }
__device__ __forceinline__ float bflo(unsigned u) { return __builtin_bit_cast(float, u << 16); }
__device__ __forceinline__ float bfhi(unsigned u) { return __builtin_bit_cast(float, u & 0xffff0000u); }
__device__ __forceinline__ float shx(float v, int o, int lane) { return __builtin_bit_cast(float, __builtin_amdgcn_ds_bpermute((lane ^ o) << 2, __builtin_bit_cast(int, v))); }
__device__ __forceinline__ float wave_sum(float v, int lane) {
#pragma unroll
    for (int o = 1; o < 64; o <<= 1) v += shx(v, o, lane);
    return v;
}
__device__ __forceinline__ float wave_max(float v, int lane) {
#pragma unroll
    for (int o = 1; o < 64; o <<= 1) v = fmaxf(v, shx(v, o, lane));
    return v;
}
__device__ __forceinline__ void cs_of(float a, float& c, float& s) {
    double rev = (double)a * 0.15915494309189535; rev -= floor(rev); const float rf = (float)rev;
    c = __builtin_amdgcn_cosf(rf); s = __builtin_amdgcn_sinf(rf);
}

__device__ __forceinline__ void xpose_item(const float* W, int srcN, int scol, bf16* WT, int K, int drow, LAS float* scr, int k0, int lane) {
#pragma unroll 8
    for (int i = 0; i < 32; ++i) { const int kk = 2 * i + (lane >> 5); scr[kk * 33 + (lane & 31)] = W[(size_t)(k0 + kk) * srcN + scol + (lane & 31)]; }
    asm volatile("s_waitcnt lgkmcnt(0)" ::: "memory");
    const int c = lane & 7;
#pragma unroll
    for (int j = 0; j < 4; ++j) { const int n = (lane >> 3) + 8 * j; const LAS float* s = scr + (8 * c) * 33 + n;
        u32x4 o; o.x = pk2(s[0 * 33], s[1 * 33]); o.y = pk2(s[2 * 33], s[3 * 33]); o.z = pk2(s[4 * 33], s[5 * 33]); o.w = pk2(s[6 * 33], s[7 * 33]);
        *(u32x4*)(WT + (size_t)(drow + n) * K + k0 + 8 * c) = o; }
    asm volatile("s_waitcnt lgkmcnt(0)" ::: "memory");
}
__device__ __forceinline__ void xpose_seg(const float* W, int K, int srcN, int scol0, int ncols, bool hs, bf16* WT, int drow0, LAS float* scr, int gw, int NGW, int& cur, int lane) {
    const int nblk = ncols / 32, nit = (K / 64) * nblk;
    int it = gw - cur; if (it < 0) it += NGW;
    for (; it < nit; it += NGW) { const int kb = it / nblk, nb = it % nblk; const int sc = scol0 + (hs ? ((nb >> 1) * 128 + (nb & 1) * 32) : nb * 32);
        xpose_item(W, srcN, sc, WT, K, drow0 + nb * 32, scr, kb * 64, lane); }
    cur = (cur + nit) % NGW;
}
__device__ __forceinline__ void zero_rows(bf16* WT, int K, int row0, int nrows, int gw, int NGW, int lane) {
    const int n16 = nrows * K / 8; u32x4* p = (u32x4*)(WT + (size_t)row0 * K); const u32x4 z = {0u, 0u, 0u, 0u};
    for (int i = gw * 64 + lane; i < n16; i += NGW * 64) p[i] = z;
}

__device__ __forceinline__ void norm_phase(const float* xlat, const float* xctx, const float* g, const float* modl, int sh_off, int sc_off, bf16* H, int vcu, int NGW, int wave_s) {
    const int lane = fresh_lane(); const int gw = vcu * NWAVES + wave_s;
    f32x4 g4[4];
#pragma unroll
    for (int j = 0; j < 4; ++j) g4[j] = *(const f32x4*)(g + 256 * j + 4 * lane);
    for (int r0 = gw; r0 < R; r0 += 2 * NGW) {
        const int r1 = r0 + NGW; const bool has1 = r1 < R;
        const float* xr0 = (r0 < NLAT) ? xlat + (size_t)r0 * D : xctx + (size_t)(r0 - NLAT) * D;
        const float* xr1 = has1 ? ((r1 < NLAT) ? xlat + (size_t)r1 * D : xctx + (size_t)(r1 - NLAT) * D) : xr0;
        f32x4 v0[4], v1[4]; float s0 = 0.f, s1 = 0.f;
#pragma unroll
        for (int j = 0; j < 4; ++j) { v0[j] = *(const f32x4*)(xr0 + 256 * j + 4 * lane); v1[j] = *(const f32x4*)(xr1 + 256 * j + 4 * lane); }
#pragma unroll
        for (int j = 0; j < 4; ++j) { s0 += (v0[j].x * v0[j].x + v0[j].y * v0[j].y) + (v0[j].z * v0[j].z + v0[j].w * v0[j].w); s1 += (v1[j].x * v1[j].x + v1[j].y * v1[j].y) + (v1[j].z * v1[j].z + v1[j].w * v1[j].w); }
        const float ri0 = 1.0f / sqrtf(wave_sum(s0, lane) * (1.0f / D) + EPS), ri1 = 1.0f / sqrtf(wave_sum(s1, lane) * (1.0f / D) + EPS);
        const float* mp0 = modl + ((r0 < NLAT) ? (r0 >> 11) : 32) * 6144; const float* mp1 = modl + ((r1 < NLAT) ? (r1 >> 11) : 32) * 6144;
#pragma unroll
        for (int j = 0; j < 4; ++j) { const int c = 256 * j + 4 * lane; const f32x4 sc = *(const f32x4*)(mp0 + sc_off + c), sh = *(const f32x4*)(mp0 + sh_off + c);
            const f32x4 y = (v0[j] * ri0 * g4[j]) * (sc + 1.0f) + sh; u32x2 w; w.x = pk2(y.x, y.y); w.y = pk2(y.z, y.w);
            *(u32x2*)(H + (size_t)r0 * D + c) = w; }
        if (has1) {
#pragma unroll
            for (int j = 0; j < 4; ++j) { const int c = 256 * j + 4 * lane; const f32x4 sc = *(const f32x4*)(mp1 + sc_off + c), sh = *(const f32x4*)(mp1 + sh_off + c);
                const f32x4 y = (v1[j] * ri1 * g4[j]) * (sc + 1.0f) + sh; u32x2 w; w.x = pk2(y.x, y.y); w.y = pk2(y.z, y.w);
                *(u32x2*)(H + (size_t)r1 * D + c) = w; }
        }
    }
}
__device__ __forceinline__ void prep_phase(const float* xlat, const float* xctx, const float* g, const float* modl, int sc_off, bf16* AP, float* ssq, int vcu, int NGW, int wave_s) {
    const int lane = fresh_lane(); const int gw = vcu * NWAVES + wave_s;
    f32x4 g4[4];
#pragma unroll
    for (int j = 0; j < 4; ++j) g4[j] = *(const f32x4*)(g + 256 * j + 4 * lane);
    for (int r0 = gw; r0 < R; r0 += 2 * NGW) {
        const int r1 = r0 + NGW; const bool has1 = r1 < R;
        const float* xr0 = (r0 < NLAT) ? xlat + (size_t)r0 * D : xctx + (size_t)(r0 - NLAT) * D;
        const float* xr1 = has1 ? ((r1 < NLAT) ? xlat + (size_t)r1 * D : xctx + (size_t)(r1 - NLAT) * D) : xr0;
        f32x4 v0[4], v1[4]; float s0 = 0.f, s1 = 0.f;
#pragma unroll
        for (int j = 0; j < 4; ++j) { v0[j] = *(const f32x4*)(xr0 + 256 * j + 4 * lane); v1[j] = *(const f32x4*)(xr1 + 256 * j + 4 * lane); }
#pragma unroll
        for (int j = 0; j < 4; ++j) { s0 += (v0[j].x * v0[j].x + v0[j].y * v0[j].y) + (v0[j].z * v0[j].z + v0[j].w * v0[j].w); s1 += (v1[j].x * v1[j].x + v1[j].y * v1[j].y) + (v1[j].z * v1[j].z + v1[j].w * v1[j].w); }
        s0 = wave_sum(s0, lane); s1 = wave_sum(s1, lane);
        const float* mp0 = modl + ((r0 < NLAT) ? (r0 >> 11) : 32) * 6144; const float* mp1 = modl + ((r1 < NLAT) ? (r1 >> 11) : 32) * 6144;
#pragma unroll
        for (int j = 0; j < 4; ++j) { const int c = 256 * j + 4 * lane; const f32x4 sc = *(const f32x4*)(mp0 + sc_off + c);
            const f32x4 y = (v0[j] * g4[j]) * (sc + 1.0f); u32x2 w; w.x = pk2(y.x, y.y); w.y = pk2(y.z, y.w);
            *(u32x2*)(AP + (size_t)r0 * D + c) = w; }
        if (lane == 0) ssq[r0] = s0;
        if (has1) {
#pragma unroll
            for (int j = 0; j < 4; ++j) { const int c = 256 * j + 4 * lane; const f32x4 sc = *(const f32x4*)(mp1 + sc_off + c);
                const f32x4 y = (v1[j] * g4[j]) * (sc + 1.0f); u32x2 w; w.x = pk2(y.x, y.y); w.y = pk2(y.z, y.w);
                *(u32x2*)(AP + (size_t)r1 * D + c) = w; }
            if (lane == 0) ssq[r1] = s1;
        }
    }
}
__device__ __forceinline__ void zero_f32(float* p, int n, int vcu, int NGW, int wave_s) {
    const int lane = fresh_lane(); const int gw = vcu * NWAVES + wave_s;
    for (int i = gw * 64 + lane; i < n; i += NGW * 64) p[i] = 0.f;
}
__device__ __forceinline__ void mlanorm_phase(const bf16* MRAW, const float* gq, const float* gkv, bf16* QCn, bf16* KVCn, int vcu, int NGW, int wave_s) {
    const int lane = fresh_lane(); const int gw = vcu * NWAVES + wave_s;
    u32x4 na = {0u, 0u, 0u, 0u}; u32x2 nb = {0u, 0u};
    if (gw < R) { na = *(const u32x4*)(MRAW + (size_t)gw * 1024 + 8 * lane); nb = *(const u32x2*)(MRAW + (size_t)gw * 1024 + 512 + 4 * lane); }
    for (int r = gw; r < R; r += NGW) {
        const bf16* row = MRAW + (size_t)r * 1024;
        const u32x4 a = na; const u32x2 b = nb;
        if (r + NGW < R) { na = *(const u32x4*)(row + (size_t)NGW * 1024 + 8 * lane); nb = *(const u32x2*)(row + (size_t)NGW * 1024 + 512 + 4 * lane); }
        float x[8] = {bflo(a.x), bfhi(a.x), bflo(a.y), bfhi(a.y), bflo(a.z), bfhi(a.z), bflo(a.w), bfhi(a.w)}; float y[4] = {bflo(b.x), bfhi(b.x), bflo(b.y), bfhi(b.y)};
        float s1 = 0.f, s2 = 0.f;
#pragma unroll
        for (int e = 0; e < 8; ++e) s1 += x[e] * x[e];
#pragma unroll
        for (int e = 0; e < 4; ++e) s2 += y[e] * y[e];
        const float r1 = 1.0f / sqrtf(wave_sum(s1, lane) * (1.0f / 512) + EPS), r2 = 1.0f / sqrtf(wave_sum(s2, lane) * (1.0f / 256) + EPS);
        const f32x4 g0 = *(const f32x4*)(gq + 8 * lane), g1 = *(const f32x4*)(gq + 8 * lane + 4), g2 = *(const f32x4*)(gkv + 4 * lane);
        u32x4 o; o.x = pk2(x[0] * r1 * g0.x, x[1] * r1 * g0.y); o.y = pk2(x[2] * r1 * g0.z, x[3] * r1 * g0.w); o.z = pk2(x[4] * r1 * g1.x, x[5] * r1 * g1.y); o.w = pk2(x[6] * r1 * g1.z, x[7] * r1 * g1.w);
        *(u32x4*)(QCn + (size_t)r * 512 + 8 * lane) = o;
        u32x2 p; p.x = pk2(y[0] * r2 * g2.x, y[1] * r2 * g2.y); p.y = pk2(y[2] * r2 * g2.z, y[3] * r2 * g2.w);
        *(u32x2*)(KVCn + (size_t)r * 256 + 4 * lane) = p;
    }
}
__device__ __forceinline__ void post_even(bf16* RAW, const float* gdq, const float* gdk, const float* ggq, const float* ggk, int vcu, int NGW, int wave_s) {
    const int lane = fresh_lane(); const int gw = vcu * NWAVES + wave_s;
    const int sub = lane & 15; const float L2T = 13.287712379549449f;
    float invf[4];
#pragma unroll
    for (int e = 0; e < 4; ++e) { const int jj = 4 * (sub & 7) + e; invf[e] = exp2f(-(float)(jj & 15) * (1.0f / 16.0f) * L2T); }
    f32x4 G[4]; G[0] = *(const f32x4*)(gdq + 4 * sub); G[1] = *(const f32x4*)(gdk + 4 * sub); G[2] = *(const f32x4*)(ggq + 4 * sub); G[3] = *(const f32x4*)(ggk + 4 * sub);
    u32x2 nx[7];
    if (gw < R) {
#pragma unroll
        for (int c = 0; c < 7; ++c) if (c == 2 || c == 3 || c == 6) nx[c] = *(const u32x2*)(RAW + (size_t)gw * RAWP + 256 * c + 4 * lane); }
    for (int r = gw; r < R; r += NGW) {
        const bool isl = r < NLAT; const int t = r & 2047; const float prow = (float)(t >> 6), pcol = (float)(t & 63);
        float cs[4], sn[4];
#pragma unroll
        for (int e = 0; e < 4; ++e) { if (isl) { const int jj = 4 * (sub & 7) + e; cs_of((jj < 16 ? prow : pcol) * invf[e], cs[e], sn[e]); } else { cs[e] = 1.f; sn[e] = 0.f; } }
        bf16* row = RAW + (size_t)r * RAWP;
        u32x2 av[7];
#pragma unroll
        for (int c = 0; c < 7; ++c) if (c == 2 || c == 3 || c == 6) av[c] = nx[c];
        if (r + NGW < R) {
#pragma unroll
            for (int c = 0; c < 7; ++c) if (c == 2 || c == 3 || c == 6) nx[c] = *(const u32x2*)(row + (size_t)NGW * RAWP + 256 * c + 4 * lane); }
#pragma unroll
        for (int c = 0; c < 7; ++c) { if (!(c == 2 || c == 3 || c == 6)) continue;
            const u32x2 a = av[c];
            float x[4] = {bflo(a.x), bfhi(a.x), bflo(a.y), bfhi(a.y)};
            float ss = (x[0] * x[0] + x[1] * x[1]) + (x[2] * x[2] + x[3] * x[3]);
            ss += shx(ss, 1, lane); ss += shx(ss, 2, lane); ss += shx(ss, 4, lane); ss += shx(ss, 8, lane);
            const float rinv = 1.0f / sqrtf(ss * (1.0f / 64) + EPS);
            const f32x4 g4 = G[c < 2 ? 0 : (c < 4 ? 1 : (c < 6 ? 2 : 3))];
            const float qs = (c < 2 || c == 4 || c == 5) ? 0.125f * LOG2E : 1.0f;
            float y[4] = {x[0] * rinv * g4.x, x[1] * rinv * g4.y, x[2] * rinv * g4.z, x[3] * rinv * g4.w}; float o[4];
#pragma unroll
            for (int e = 0; e < 4; ++e) { const float py = shx(y[e], 8, lane); o[e] = ((sub < 8) ? (y[e] * cs[e] - py * sn[e]) : (y[e] * cs[e] + py * sn[e])) * qs; }
            u32x2 w; w.x = pk2(o[0], o[1]); w.y = pk2(o[2], o[3]);
            *(u32x2*)(row + 256 * c + 4 * lane) = w;
        }
    }
}
__device__ __forceinline__ void post_mla(bf16* Q, bf16* Kb, const bf16* MRAW, const float* gq, const float* gk, int vcu, int NGW, int wave_s) {
    const int lane = fresh_lane(); const int gw = vcu * NWAVES + wave_s;
    const int i = lane & 31, half = lane >> 5; const float L2T = 13.287712379549449f;
    float invf[2];
#pragma unroll
    for (int e = 0; e < 2; ++e) { const int jj = (2 * i + e) & 15; invf[e] = exp2f(-(float)(jj & 7) * (1.0f / 8.0f) * L2T); }
    const f32x2 gqa = *(const f32x2*)(gq + 2 * i), gqb = *(const f32x2*)(gq + 64 + 2 * (i & 15)), gka = *(const f32x2*)(gk + 2 * i), gkb = *(const f32x2*)(gk + 64 + 2 * (i & 15));
    const float qs = 0.10206207261596577f * LOG2E;
    unsigned na[2][8], nb[8], nkr = 0u;
#define MLA_LOAD(rr) do { _Pragma("unroll") for (int p = 0; p < 8; ++p) { na[0][p] = 0u; na[1][p] = *(const unsigned*)(Kb + (size_t)(rr) * MQP + (2 * p + half) * 96 + 2 * i); nb[p] = 0u; } \
        nkr = (i < 16) ? *(const unsigned*)(MRAW + (size_t)(rr) * 32 + 2 * i) : 0u; } while (0)
    if (gw < R) MLA_LOAD(gw);
    for (int r = gw; r < R; r += NGW) {
        const bool isl = r < NLAT; const int t = r & 2047; const float prow = (float)(t >> 6), pcol = (float)(t & 63);
        float cs[2], sn[2];
#pragma unroll
        for (int e = 0; e < 2; ++e) { if (isl) { const int jj = (2 * i + e) & 15; cs_of((jj < 8 ? prow : pcol) * invf[e], cs[e], sn[e]); } else { cs[e] = 1.f; sn[e] = 0.f; } }
        unsigned la[2][8], lb[8];
#pragma unroll
        for (int p = 0; p < 8; ++p) { la[0][p] = na[0][p]; la[1][p] = na[1][p]; lb[p] = nb[p]; }
        const unsigned krw = nkr;
        if (r + NGW < R) { const int rn = r + NGW; MLA_LOAD(rn); }
#pragma unroll
        for (int isk = 1; isk < 2; ++isk) {
            bf16* base = (isk ? Kb : Q) + (size_t)r * MQP; const f32x2 ga = isk ? gka : gqa, gb = isk ? gkb : gqb; const float sc = isk ? 1.0f : qs;
#pragma unroll
            for (int p = 0; p < 8; ++p) {
                bf16* hp = base + (2 * p + half) * 96;
                const unsigned a = la[isk][p];
                const unsigned b = isk ? krw : lb[p];
                const float a0 = bflo(a), a1 = bfhi(a), b0 = bflo(b), b1 = bfhi(b);
                float ss = (a0 * a0 + a1 * a1) + (b0 * b0 + b1 * b1);
                ss += shx(ss, 1, lane); ss += shx(ss, 2, lane); ss += shx(ss, 4, lane); ss += shx(ss, 8, lane); ss += shx(ss, 16, lane);
                const float rinv = 1.0f / sqrtf(ss * (1.0f / 96) + EPS);
                const float y0 = b0 * rinv * gb.x, y1 = b1 * rinv * gb.y; const float p0 = shx(y0, 8, lane), p1 = shx(y1, 8, lane);
                const float o0 = (i < 8) ? (y0 * cs[0] - p0 * sn[0]) : (y0 * cs[0] + p0 * sn[0]);
                const float o1 = (i < 8) ? (y1 * cs[1] - p1 * sn[1]) : (y1 * cs[1] + p1 * sn[1]);
                *(unsigned*)(hp + 2 * i) = pk2(a0 * rinv * ga.x * sc, a1 * rinv * ga.y * sc);
                if (i < 16) *(unsigned*)(hp + 64 + 2 * i) = pk2(o0 * sc, o1 * sc);
            }
        }
    }
}

#undef MLA_LOAD
template <int DQK>
__device__ __forceinline__ void q_prep(bf16x8 (&qf)[DQK / 16], const float* gq, int row, float qs, int lane) {
    constexpr int NKS = DQK / 16; const int hh = lane >> 5; const float L2T = 13.287712379549449f;
    float x[NKS][8]; float ss = 0.f;
#pragma unroll
    for (int ks = 0; ks < NKS; ++ks)
#pragma unroll
        for (int e = 0; e < 8; ++e) { x[ks][e] = __builtin_bit_cast(float, ((unsigned)(unsigned short)qf[ks][e]) << 16); ss += x[ks][e] * x[ks][e]; }
    ss += shx(ss, 32, lane);
    const float rinv = 1.0f / sqrtf(ss * (1.0f / DQK) + EPS);
#pragma unroll
    for (int ks = 0; ks < NKS; ++ks) { const f32x4 g0 = *(const f32x4*)(gq + 16 * ks + 8 * hh), g1 = *(const f32x4*)(gq + 16 * ks + 8 * hh + 4);
        x[ks][0] *= rinv * g0.x; x[ks][1] *= rinv * g0.y; x[ks][2] *= rinv * g0.z; x[ks][3] *= rinv * g0.w; x[ks][4] *= rinv * g1.x; x[ks][5] *= rinv * g1.y; x[ks][6] *= rinv * g1.z; x[ks][7] *= rinv * g1.w; }
    if (row < NLAT) { const int t = row & 2047; const float prow = (float)(t >> 6), pcol = (float)(t & 63);
        if (DQK == 64) {
#pragma unroll
            for (int e = 0; e < 8; ++e) { const float invf = exp2f(-(float)(8 * hh + e) * (1.0f / 16.0f) * L2T); float c0, s0, c1, s1; cs_of(prow * invf, c0, s0); cs_of(pcol * invf, c1, s1);
                const float a0 = x[0][e], b0 = x[2][e], a1 = x[1][e], b1 = x[3][e];
                x[0][e] = a0 * c0 - b0 * s0; x[2][e] = b0 * c0 + a0 * s0; x[1][e] = a1 * c1 - b1 * s1; x[3][e] = b1 * c1 + a1 * s1; }
        } else {
#pragma unroll
            for (int e = 0; e < 8; ++e) { const float invf = exp2f(-(float)e * (1.0f / 8.0f) * L2T); float c, s; cs_of((hh ? pcol : prow) * invf, c, s);
                const float a = x[NKS - 2][e], b = x[NKS - 1][e]; x[NKS - 2][e] = a * c - b * s; x[NKS - 1][e] = b * c + a * s; }
        } }
#pragma unroll
    for (int ks = 0; ks < NKS; ++ks) { u32x4 w; w.x = pk2(x[ks][0] * qs, x[ks][1] * qs); w.y = pk2(x[ks][2] * qs, x[ks][3] * qs); w.z = pk2(x[ks][4] * qs, x[ks][5] * qs); w.w = pk2(x[ks][6] * qs, x[ks][7] * qs);
        qf[ks] = __builtin_bit_cast(bf16x8, w); }
}
template <int DQK, int DV, bool PIPE>
__device__ __forceinline__ void attn_pass(LAS unsigned char* lds, const bf16* Qw, int qpitch, const bf16* Kctx, const bf16* Klat, int kpitch, const bf16* VT, int ntiles, const float* gq, int qrow0, float qs,
                                          f32x16 (&o)[DV / 32], float& lsum, const int wave_s) {
    constexpr int KSTR = DQK * 2 + 16, VSTR = 144, KBYTES = 64 * KSTR, VBYTES = DV * VSTR, KC = DQK / 8, NKS = DQK / 16, NDB = DV / 32, NV = 4 * NDB;
    const int lane = fresh_lane(), tid = wave_s * 64 + lane, i = lane & 31, hh = lane >> 5;
    bf16x8 qf[NKS];
#pragma unroll
    for (int ks = 0; ks < NKS; ++ks) qf[ks] = *(const bf16x8*)(Qw + (size_t)i * qpitch + 16 * ks + 8 * hh);
    q_prep<DQK>(qf, gq, qrow0 + i, qs, lane);
#pragma unroll
    for (int db = 0; db < NDB; ++db)
#pragma unroll
        for (int r = 0; r < 16; ++r) o[db][r] = 0.f;
    lsum = 0.f;
    const int kc0 = tid, kc1 = tid + 512; const bool k2 = (DQK == 96) && (tid < 256);
    const int kr0 = kc0 / KC, kcc0 = kc0 % KC, kr1 = kc1 / KC, kcc1 = kc1 % KC;
    const int vd0 = tid >> 3, vc0 = tid & 7;
    u32x4 kreg0, kreg1 = {0u, 0u, 0u, 0u}, vreg0, vreg1 = {0u, 0u, 0u, 0u};
    constexpr bool TPB2 = (!PIPE) && (NV == 8);
    LAS unsigned char* const Kl = lds; LAS unsigned char* const Vl = lds + (TPB2 ? 4 : 2) * KBYTES;
    const int kfo = i * KSTR + 16 * hh, vfo = i * VSTR + 16 * hh;
    const unsigned koff0 = (unsigned)(kr0 * kpitch + 8 * kcc0) * 2u, koff1 = (unsigned)(kr1 * kpitch + 8 * kcc1) * 2u;
    const unsigned voff0 = (unsigned)(vd0 * KV + 8 * vc0) * 2u, voff1 = (unsigned)((vd0 + 64) * KV + 8 * vc0) * 2u;
#define AT_LOADK(t) do { const char* kt = (const char*)(((t) < 4) ? Kctx + (size_t)(64 * (t)) * kpitch : Klat + (size_t)(64 * ((t) - 4)) * kpitch); \
        kreg0 = *(const u32x4*)(kt + koff0); if (k2) kreg1 = *(const u32x4*)(kt + koff1); } while (0)
#define AT_LOADV(t) do { const char* vt_ = (const char*)(VT + 64 * (t)); vreg0 = *(const u32x4*)(vt_ + voff0); if (DV == 128) vreg1 = *(const u32x4*)(vt_ + voff1); } while (0)
#define AT_WRITEK(bufi) do { LAS unsigned char* kb_ = Kl + (bufi) * KBYTES; *(LAS u32x4*)(kb_ + kr0 * KSTR + 16 * kcc0) = kreg0; if (k2) *(LAS u32x4*)(kb_ + kr1 * KSTR + 16 * kcc1) = kreg1; } while (0)
#define AT_WRITEV(bufi) do { LAS unsigned char* vb_ = Vl + (bufi) * VBYTES; *(LAS u32x4*)(vb_ + vd0 * VSTR + 16 * vc0) = vreg0; if (DV == 128) *(LAS u32x4*)(vb_ + (vd0 + 64) * VSTR + 16 * vc0) = vreg1; } while (0)
    u32x4 kregB0, kregB1 = {0u, 0u, 0u, 0u}, vregB0;
#define AT_LOADKB(t) do { const char* kt = (const char*)(((t) < 4) ? Kctx + (size_t)(64 * (t)) * kpitch : Klat + (size_t)(64 * ((t) - 4)) * kpitch); \
        kregB0 = *(const u32x4*)(kt + koff0); if (k2) kregB1 = *(const u32x4*)(kt + koff1); } while (0)
#define AT_LOADVB(t) do { const char* vt_ = (const char*)(VT + 64 * (t)); vregB0 = *(const u32x4*)(vt_ + voff0); } while (0)
#define AT_WRITEKB(bufi) do { LAS unsigned char* kb_ = Kl + (bufi) * KBYTES; *(LAS u32x4*)(kb_ + kr0 * KSTR + 16 * kcc0) = kregB0; if (k2) *(LAS u32x4*)(kb_ + kr1 * KSTR + 16 * kcc1) = kregB1; } while (0)
#define AT_WRITEVB(bufi) do { LAS unsigned char* vb_ = Vl + (bufi) * VBYTES; *(LAS u32x4*)(vb_ + vd0 * VSTR + 16 * vc0) = vregB0; } while (0)
#define AT_KFRAGS(bufi) do { const LAS unsigned char* Kb = Kl + (bufi) * KBYTES + kfo; \
        _Pragma("unroll") for (int ks = 0; ks < NKS; ++ks) { kf[2 * ks] = *(const LAS bf16x8*)(Kb + 32 * ks); kf[2 * ks + 1] = *(const LAS bf16x8*)(Kb + 32 * KSTR + 32 * ks); } } while (0)
#define AT_QKM(P0, P1) do { _Pragma("unroll") for (int r = 0; r < 16; ++r) { P0[r] = 0.f; P1[r] = 0.f; } \
        _Pragma("unroll") for (int ks = 0; ks < NKS; ++ks) { P0 = __builtin_amdgcn_mfma_f32_32x32x16_bf16(kf[2 * ks], qf[ks], P0, 0, 0, 0); \
            P1 = __builtin_amdgcn_mfma_f32_32x32x16_bf16(kf[2 * ks + 1], qf[ks], P1, 0, 0, 0); } } while (0)
#define AT_VFRAGS(dst, m0, bufi) do { const LAS unsigned char* Vb = Vl + (bufi) * VBYTES + vfo; \
        _Pragma("unroll") for (int m = 0; m < 8; ++m) { const int s_ = ((m0) + m) / NDB, db_ = ((m0) + m) % NDB; dst[m] = *(const LAS bf16x8*)(Vb + 32 * db_ * VSTR + 32 * s_); } } while (0)
#define AT_PVM(src, m0) do { _Pragma("unroll") for (int m = 0; m < 8; ++m) { const int s_ = ((m0) + m) / NDB, db_ = ((m0) + m) % NDB; \
        o[db_] = __builtin_amdgcn_mfma_f32_32x32x16_bf16(src[m], pf[s_], o[db_], 0, 0, 0); } } while (0)
    f32x16 p0, p1, n0, n1; bf16x8 kf[2 * NKS], vfa[8], pf[4];
    if (PIPE) {
        AT_LOADK(0); AT_LOADV(0); AT_WRITEK(0); AT_WRITEV(0);
        AT_LOADK(1);
        __syncthreads();
        AT_KFRAGS(0); AT_QKM(p0, p1);
        AT_WRITEK(1);
        if (2 < ntiles) AT_LOADK(2);
        AT_LOADV(1);
        __syncthreads();
    } else if (TPB2) {
        AT_LOADK(0); AT_LOADV(0); AT_LOADKB(1); AT_LOADVB(1); AT_WRITEK(0); AT_WRITEV(0); AT_WRITEKB(1); AT_WRITEVB(1);
        AT_LOADK(2); AT_LOADV(2); AT_LOADKB(3); AT_LOADVB(3);
        __syncthreads();
    } else {
        AT_LOADK(0); AT_LOADV(0); AT_WRITEK(0); AT_WRITEV(0);
        AT_LOADK(1); AT_LOADV(1);
        __syncthreads();
    }
#define AT_BODY(HASNEXT, C0, C1, N0, N1, TT) do { const int t = (TT); \
        if (PIPE) { if (HASNEXT) AT_KFRAGS((t + 1) & 1); } else AT_KFRAGS(t & 1); \
        AT_VFRAGS(vfa, 0, t & 1); \
        __builtin_amdgcn_sched_barrier(0); \
        if (!PIPE) AT_QKM(C0, C1); \
        float ls = 0.f; \
        _Pragma("unroll") for (int r = 0; r < 16; ++r) { C0[r] = __builtin_amdgcn_exp2f(C0[r]); C1[r] = __builtin_amdgcn_exp2f(C1[r]); ls += C0[r] + C1[r]; } \
        lsum += ls; \
        { u32x4 w; \
          w.x = cvtpk_nv(C0[0], C0[1]); w.y = cvtpk_nv(C0[2], C0[3]); w.z = cvtpk_nv(C0[4], C0[5]); w.w = cvtpk_nv(C0[6], C0[7]); pf[0] = __builtin_bit_cast(bf16x8, w); \
          w.x = cvtpk_nv(C0[8], C0[9]); w.y = cvtpk_nv(C0[10], C0[11]); w.z = cvtpk_nv(C0[12], C0[13]); w.w = cvtpk_nv(C0[14], C0[15]); pf[1] = __builtin_bit_cast(bf16x8, w); \
          w.x = cvtpk_nv(C1[0], C1[1]); w.y = cvtpk_nv(C1[2], C1[3]); w.z = cvtpk_nv(C1[4], C1[5]); w.w = cvtpk_nv(C1[6], C1[7]); pf[2] = __builtin_bit_cast(bf16x8, w); \
          w.x = cvtpk_nv(C1[8], C1[9]); w.y = cvtpk_nv(C1[10], C1[11]); w.z = cvtpk_nv(C1[12], C1[13]); w.w = cvtpk_nv(C1[14], C1[15]); pf[3] = __builtin_bit_cast(bf16x8, w); } \
        if (PIPE && (HASNEXT)) AT_QKM(N0, N1); \
        if (NV == 16) { __builtin_amdgcn_sched_barrier(0); AT_VFRAGS(kf, 8, t & 1); __builtin_amdgcn_sched_barrier(0); __builtin_amdgcn_s_setprio(1); AT_PVM(vfa, 0); AT_PVM(kf, 8); __builtin_amdgcn_s_setprio(0); } \
        else { __builtin_amdgcn_s_setprio(1); AT_PVM(vfa, 0); __builtin_amdgcn_s_setprio(0); } \
        if (PIPE) { if (t + 2 < ntiles) AT_WRITEK(t & 1); if (t + 1 < ntiles) AT_WRITEV((t + 1) & 1); if (t + 3 < ntiles) AT_LOADK(t + 3); if (t + 2 < ntiles) AT_LOADV(t + 2); } \
        else { if (t + 1 < ntiles) { AT_WRITEK((t + 1) & 1); AT_WRITEV((t + 1) & 1); } if (t + 2 < ntiles) { AT_LOADK(t + 2); AT_LOADV(t + 2); } } \
        __syncthreads(); \
    } while (0)
    int tt = 0;
    if (PIPE) {
        for (; tt < ntiles - 2; tt += 2) { AT_BODY(true, p0, p1, n0, n1, tt); AT_BODY(true, n0, n1, p0, p1, tt + 1); }
        AT_BODY(true, p0, p1, n0, n1, tt); AT_BODY(false, n0, n1, p0, p1, tt + 1);
    } else {
        if (TPB2) {
#define AT_SUB(slot) do { AT_KFRAGS(slot); AT_VFRAGS(vfa, 0, slot); __builtin_amdgcn_sched_barrier(0); AT_QKM(p0, p1); \
            float ls = 0.f; _Pragma("unroll") for (int r = 0; r < 16; ++r) { p0[r] = __builtin_amdgcn_exp2f(p0[r]); p1[r] = __builtin_amdgcn_exp2f(p1[r]); ls += p0[r] + p1[r]; } lsum += ls; \
            { u32x4 w; \
              w.x = cvtpk_nv(p0[0], p0[1]); w.y = cvtpk_nv(p0[2], p0[3]); w.z = cvtpk_nv(p0[4], p0[5]); w.w = cvtpk_nv(p0[6], p0[7]); pf[0] = __builtin_bit_cast(bf16x8, w); \
              w.x = cvtpk_nv(p0[8], p0[9]); w.y = cvtpk_nv(p0[10], p0[11]); w.z = cvtpk_nv(p0[12], p0[13]); w.w = cvtpk_nv(p0[14], p0[15]); pf[1] = __builtin_bit_cast(bf16x8, w); \
              w.x = cvtpk_nv(p1[0], p1[1]); w.y = cvtpk_nv(p1[2], p1[3]); w.z = cvtpk_nv(p1[4], p1[5]); w.w = cvtpk_nv(p1[6], p1[7]); pf[2] = __builtin_bit_cast(bf16x8, w); \
              w.x = cvtpk_nv(p1[8], p1[9]); w.y = cvtpk_nv(p1[10], p1[11]); w.z = cvtpk_nv(p1[12], p1[13]); w.w = cvtpk_nv(p1[14], p1[15]); pf[3] = __builtin_bit_cast(bf16x8, w); } \
            __builtin_amdgcn_s_setprio(1); AT_PVM(vfa, 0); __builtin_amdgcn_s_setprio(0); } while (0)
            for (int pp = 0; 2 * pp < ntiles; ++pp) { const int sb = (pp & 1) * 2;
                AT_SUB(sb); AT_SUB(sb + 1);
                if (2 * pp + 2 < ntiles) { AT_WRITEK(sb ^ 2); AT_WRITEV(sb ^ 2); AT_WRITEKB((sb ^ 2) + 1); AT_WRITEVB((sb ^ 2) + 1); }
                if (2 * pp + 4 < ntiles) { AT_LOADK(2 * pp + 4); AT_LOADV(2 * pp + 4); AT_LOADKB(2 * pp + 5); AT_LOADVB(2 * pp + 5); }
                __syncthreads();
            }
#undef AT_SUB
        } else
        for (; tt < ntiles; ++tt) AT_BODY(true, p0, p1, p0, p1, tt);
    }
#undef AT_BODY
#undef AT_LOADK
#undef AT_LOADV
#undef AT_WRITEK
#undef AT_WRITEV
#undef AT_KFRAGS
#undef AT_QKM
#undef AT_VFRAGS
#undef AT_PVM
}
template <int NDB>
__device__ __forceinline__ void attn_store(bf16* ATT, int row0, int col0, const f32x16 (&o)[NDB], float inv, int lane) {
    const int i = lane & 31, hh = lane >> 5; bf16* rp = ATT + (size_t)(row0 + i) * D + col0 + 4 * hh;
#pragma unroll
    for (int db = 0; db < NDB; ++db)
#pragma unroll
        for (int g4 = 0; g4 < 4; ++g4) { u32x2 w; w.x = pk2(o[db][4 * g4] * inv, o[db][4 * g4 + 1] * inv); w.y = pk2(o[db][4 * g4 + 2] * inv, o[db][4 * g4 + 3] * inv);
            *(u32x2*)(rp + 32 * db + 8 * g4) = w; }
}

#define XB_TMO      128
#define XB_XCNT(j)  (256  + 64 * (j))
#define XB_XSUB(j)  (1280 + 64 * (j))
#define XB_XGEN(j)  (2304 + 64 * (j))
#define XB_TOP      3328
#define XB_TOPGEN   3392
#define XCD_BAR_WORDS 3456
#define XB_SPIN_CAP (1u << 18)

__device__ __forceinline__ unsigned xb_ld(unsigned* p)              { return __hip_atomic_load(p, __ATOMIC_RELAXED, __HIP_MEMORY_SCOPE_AGENT); }
__device__ __forceinline__ unsigned xb_add(unsigned* p, unsigned v) { return __hip_atomic_fetch_add(p, v, __ATOMIC_RELAXED, __HIP_MEMORY_SCOPE_AGENT); }
__device__ __forceinline__ unsigned xb_xcc_id() { return (unsigned)__builtin_amdgcn_s_getreg((3 << 11) | 20) & 0xFu; }
#define XB_SPIN(cond, bar) do { unsigned _sp = 0; while (cond) { __builtin_amdgcn_s_sleep(1); \
    if ((++_sp & 255u) == 0u) { if (xb_ld(&(bar)[XB_TMO])) break; if (_sp > XB_SPIN_CAP) { atomicAdd(&(bar)[XB_TMO], 1u); break; } } } } while (0)

struct XcdBarrier {
    unsigned* bar; unsigned x;
    volatile LAS unsigned* st;
};

__device__ __forceinline__ XcdBarrier xcd_barrier_post(unsigned* bar, volatile LAS unsigned* st) {
    XcdBarrier b; b.bar = bar; b.x = xb_xcc_id(); b.st = st;
    if (threadIdx.x == 0) (void)xb_add(&bar[XB_XCNT(b.x)], 1u);
    return b;
}
__device__ __forceinline__ void xcd_barrier_complete(unsigned* bar, unsigned x, unsigned& nloc, unsigned& nx) {
    const unsigned G = gridDim.x * gridDim.y * gridDim.z;
    unsigned sum, cnt, mine, sp = 0u;
    for (;;) {
        sum = 0u; cnt = 0u; mine = 0u;
#pragma unroll
        for (unsigned j = 0; j < 16; ++j) { const unsigned c = xb_ld(&bar[XB_XCNT(j)]); sum += c; cnt += (c > 0u) ? 1u : 0u; mine = (j == x) ? c : mine; }
        if (sum == G) break;
        __builtin_amdgcn_s_sleep(1);
        if ((++sp & 255u) == 0u) { if (xb_ld(&bar[XB_TMO])) break; if (sp > XB_SPIN_CAP) { atomicAdd(&bar[XB_TMO], 1u); break; } }
    }
    nloc = mine > 0u ? mine : 1u; nx = cnt > 0u ? cnt : 1u;
}

__device__ __forceinline__ void xcd_barrier(const XcdBarrier& b, const int wave_s) {
    asm volatile("s_waitcnt vmcnt(0)" ::: "memory");
    __syncthreads();
    if (wave_s == 0 && fresh_lane() == 0) {
        unsigned* bar = b.bar; asm volatile("" : "+s"(bar));
        __builtin_amdgcn_s_waitcnt(0);
        unsigned nloc = b.st[0], nx = b.st[1];
        if (nloc == 0u) { xcd_barrier_complete(bar, b.x, nloc, nx); b.st[0] = nloc; b.st[1] = nx; }
        const unsigned old = xb_add(&bar[XB_XSUB(b.x)], 1u);
        const unsigned gen = old / nloc;
        if (old + 1u == (gen + 1u) * nloc) {
            __builtin_amdgcn_fence(__ATOMIC_RELEASE, "agent");
            asm volatile("s_waitcnt vmcnt(0)" ::: "memory");
            const unsigned og = xb_add(&bar[XB_TOP], 1u);
            const unsigned tg = og / nx;
            if (og + 1u == (tg + 1u) * nx) xb_add(&bar[XB_TOPGEN], 1u);
            else XB_SPIN(xb_ld(&bar[XB_TOPGEN]) == tg, bar);
            __builtin_amdgcn_fence(__ATOMIC_ACQUIRE, "agent");
            xb_add(&bar[XB_XGEN(b.x)], 1u);
            asm volatile("s_waitcnt vmcnt(0)" ::: "memory");
        } else {
            XB_SPIN(xb_ld(&bar[XB_XGEN(b.x)]) == gen, bar);
            __builtin_amdgcn_fence(__ATOMIC_ACQUIRE, "agent");
            asm volatile("s_waitcnt vmcnt(0)" ::: "memory");
        }
    }
    __syncthreads();
}

__device__ __forceinline__ int grab_unit(unsigned* ctr, volatile LAS unsigned* slot, int wave_s) {
    if (wave_s == 0 && fresh_lane() == 0) *slot = __hip_atomic_fetch_add(ctr, 1u, __ATOMIC_RELAXED, __HIP_MEMORY_SCOPE_AGENT);
    __syncthreads();
    const unsigned v = *slot;
    __syncthreads();
    return __builtin_amdgcn_readfirstlane((int)v);
}
__device__ __forceinline__ unsigned ticket_issue(unsigned* ctr, int wave_s, bool& mine) {
    mine = (wave_s == 0) && (fresh_lane() == 0); unsigned v = 0u;
    if (mine) v = __hip_atomic_fetch_add(ctr, 1u, __ATOMIC_RELAXED, __HIP_MEMORY_SCOPE_AGENT);
    return v;
}
__device__ __forceinline__ int ticket_publish(unsigned v, bool mine, volatile LAS unsigned* slot) {
    if (mine) *slot = v;
    __syncthreads();
    const unsigned r = *slot;
    __syncthreads();
    return __builtin_amdgcn_readfirstlane((int)r);
}
struct Args { const float* in[23]; float* out; unsigned char* ws; };

__global__ void __launch_bounds__(NTHR, 2) mega_fwd(Args args) {
    extern __shared__ __attribute__((aligned(16))) unsigned char lds_raw[];
    LAS unsigned char* lds = (LAS unsigned char*)lds_raw;
    cg::grid_group grid = cg::this_grid();
    const int wave_s = __builtin_amdgcn_readfirstlane(threadIdx.x >> 6);
    if (threadIdx.x < 16) ((LAS unsigned*)(lds + MISC_OFF))[threadIdx.x] = 0u;
    __syncthreads();
    const XcdBarrier xbar = xcd_barrier_post((unsigned*)(args.ws + WS_CTL), (volatile LAS unsigned*)(lds + MISC_OFF));
    const int G = gridDim.x, bx = blockIdx.x; const int vcu = (G % 8 == 0) ? (bx % 8) * (G / 8) + bx / 8 : bx;
    const int NGW = G * NWAVES;
    unsigned char* ws = args.ws;
    const float* x_in = args.in[0]; const float* c_in = args.in[1]; const float* ctx_in = args.in[2]; const float* cctx_in = args.in[3];
    const float* ada_w = args.in[4]; const float* ada_b = args.in[5]; const float* norm_mix = args.in[6]; const float* norm_mlp = args.in[7];
    float* MOD = (float*)(ws + WS_MOD); float* XCTX = (float*)(ws + WS_XCTX); bf16* H = (bf16*)(ws + WS_H); unsigned char* RG = ws + WS_R;
    float* XLAT = args.out;

    {   const int tid = threadIdx.x, lane = tid & 63, wave = __builtin_amdgcn_readfirstlane(tid >> 6);
        const bool split = G >= 96; const int NGW = split ? (G - 48) * NWAVES : G * NWAVES; const int gw = split ? ((bx >= 48) ? (bx - 48) * NWAVES + wave : NGW + wave) : bx * NWAVES + wave;
        if (bx < 48) {
            LAS float* S = (LAS float*)lds;
            for (int idx = tid; idx < 33 * 1024; idx += NTHR) { const int b = idx >> 10, k = idx & 1023; const float cv = (b < 32) ? c_in[b * 1024 + k] : cctx_in[k]; S[idx] = cv / (1.0f + __expf(-cv)); }
            __syncthreads();
            for (int item = bx; item < 48; item += G) {
                const int L = item / 12, col = (item % 12) * 512 + wave * 64 + lane; const float* wp = ada_w + (size_t)L * 1024 * 6144 + col;
                float acc[33];
#pragma unroll
                for (int b = 0; b < 33; ++b) acc[b] = 0.f;
                float wn[16];
#pragma unroll
                for (int e = 0; e < 16; ++e) wn[e] = wp[(size_t)e * 6144];
                for (int kb = 0; kb < 1024; kb += 16) {
                    float wc[16];
#pragma unroll
                    for (int e = 0; e < 16; ++e) wc[e] = wn[e];
                    if (kb + 16 < 1024) {
#pragma unroll
                        for (int e = 0; e < 16; ++e) wn[e] = wp[(size_t)(kb + 16 + e) * 6144]; }
#pragma unroll
                    for (int q4 = 0; q4 < 4; ++q4)
#pragma unroll
                        for (int b = 0; b < 33; ++b) { const f32x4 s = *(const LAS f32x4*)(S + b * 1024 + kb + 4 * q4); acc[b] += (s.x * wc[4 * q4] + s.y * wc[4 * q4 + 1]) + (s.z * wc[4 * q4 + 2] + s.w * wc[4 * q4 + 3]); }
                }
                const float bias = ada_b[L * 6144 + col];
#pragma unroll
                for (int b = 0; b < 33; ++b) MOD[((size_t)L * 33 + b) * 6144 + col] = acc[b] + bias;
            }
            __syncthreads();
        }
        LAS float* scr = (LAS float*)(lds + wave * 16384); int cur = 0;
        if (gw < NGW) {
        for (int i2 = 0; i2 < 2; ++i2) {
            unsigned char* we = ws + WS_W + (size_t)i2 * 8 * MiB; bf16* WinM = (bf16*)we; bf16* WinV = (bf16*)(we + 3584 * 1024); bf16* Wout = (bf16*)(we + 5 * MiB);
            const float* win = args.in[10] + (size_t)i2 * 1024 * 2304;
            xpose_seg(win, 1024, 2304, 0, 1024, false, WinM, 0, scr, gw, NGW, cur, lane);
            xpose_seg(win, 1024, 2304, 1536, 640, false, WinM, 1024, scr, gw, NGW, cur, lane);
            xpose_seg(win, 1024, 2304, 1024, 512, false, WinV, 0, scr, gw, NGW, cur, lane);
            xpose_seg(win, 1024, 2304, 2176, 128, false, WinV, 512, scr, gw, NGW, cur, lane);
            zero_rows(WinM, 1024, 1664, 128, gw, NGW, lane); zero_rows(WinV, 1024, 640, 128, gw, NGW, lane);
            xpose_seg(args.in[11] + (size_t)i2 * 1024 * 1024, 1024, 1024, 0, 1024, false, Wout, 0, scr, gw, NGW, cur, lane);
            unsigned char* wo = ws + WS_W + 16 * MiB + (size_t)i2 * 8 * MiB; bf16* MWin = (bf16*)wo; bf16* MQup = (bf16*)(wo + 2 * MiB); bf16* MKn = (bf16*)(wo + 3584 * 1024); bf16* MV = (bf16*)(wo + 4 * MiB); bf16* MWout = (bf16*)(wo + 4608 * 1024);
            xpose_seg(args.in[16] + (size_t)i2 * 1024 * 800, 1024, 800, 0, 800, false, MWin, 0, scr, gw, NGW, cur, lane);
            zero_rows(MWin, 1024, 800, 224, gw, NGW, lane);
            xpose_seg(args.in[18] + (size_t)i2 * 512 * 1536, 512, 1536, 0, 1536, false, MQup, 0, scr, gw, NGW, cur, lane);
            xpose_seg(args.in[20] + (size_t)i2 * 256 * 2048, 256, 2048, 0, 1024, true, MKn, 0, scr, gw, NGW, cur, lane);
            xpose_seg(args.in[20] + (size_t)i2 * 256 * 2048, 256, 2048, 64, 1024, true, MV, 0, scr, gw, NGW, cur, lane);
            xpose_seg(args.in[22] + (size_t)i2 * 1024 * 1024, 1024, 1024, 0, 1024, false, MWout, 0, scr, gw, NGW, cur, lane);
        }
        for (int L = 0; L < 4; ++L) {
            unsigned char* wm = ws + WS_W + 32 * MiB + (size_t)L * 16 * MiB;
            xpose_seg(args.in[8] + (size_t)L * 1024 * 4096, 1024, 4096, 0, 4096, false, (bf16*)wm, 0, scr, gw, NGW, cur, lane);
            xpose_seg(args.in[9] + (size_t)L * 4096 * 1024, 4096, 1024, 0, 1024, false, (bf16*)(wm + 8 * MiB), 0, scr, gw, NGW, cur, lane);
        }
        }
    }
    grid.sync();
    {
        float* MOD = (float*)(ws + WS_MOD); bf16* SHB = (bf16*)(ws + WS_SHB); float* SSQ1 = (float*)(ws + WS_SSQ); float* SSQ2 = SSQ1 + 131072;
        const int lane = fresh_lane(); const int gw = vcu * NWAVES + wave_s;
        for (int idx = gw; idx < 264; idx += NGW) { const int L = idx / 66, rem = idx % 66, w = rem / 33, b = rem % 33;
            const float* src = MOD + ((size_t)L * 33 + b) * 6144 + (w ? 3072 : 0); bf16* dst = SHB + ((size_t)(2 * L + w) * 256 + b) * 1024;
#pragma unroll
            for (int j = 0; j < 4; ++j) { const f32x4 v = *(const f32x4*)(src + 256 * j + 4 * lane); u32x2 o; o.x = pk2(v.x, v.y); o.y = pk2(v.z, v.w); *(u32x2*)(dst + 256 * j + 4 * lane) = o; } }
        prep_phase(x_in, ctx_in, norm_mix, MOD, 1024, (bf16*)(ws + WS_H), SSQ1, vcu, NGW, wave_s);
        zero_f32(SSQ2, R, vcu, NGW, wave_s);
        zero_f32((float*)(ws + WS_SSQM), 262144, vcu, NGW, wave_s);
    }
    xcd_barrier(xbar, wave_s);
    {
        pg8::Gemm g{(const bf16*)(ws + WS_SHB), (const bf16*)(ws + WS_W), 2048, 256, 1024}; pg8::ShwOrder S{G, bx}; pg8::EpiShw E{(float*)(ws + WS_SHW)};
        pg8::gemm_phase<pg8::EpiShw, pg8::ShwOrder, true, true>(lds, g, S, E, wave_s);
    }
    xcd_barrier(xbar, wave_s);

    const int G0 = G, bx0 = bx, vcu0 = vcu;
    for (int L = 0; L < 4; ++L) {
        int G = G0, bx = bx0, vcu = vcu0; asm volatile("" : "+s"(G), "+s"(bx), "+s"(vcu)); const int NGW = G * NWAVES;
        const __attribute__((address_space(4))) Args* ap = (const __attribute__((address_space(4))) Args*)__builtin_amdgcn_kernarg_segment_ptr(); asm volatile("" : "+s"(ap));
        unsigned char* ws = ap->ws; float* XLAT = ap->out; const float* x_in = ap->in[0]; const float* ctx_in = ap->in[2]; const float* norm_mix = ap->in[6]; const float* norm_mlp = ap->in[7];
        float* MOD = (float*)(ws + WS_MOD); float* XCTX = (float*)(ws + WS_XCTX); bf16* H = (bf16*)(ws + WS_H); unsigned char* RG = ws + WS_R;
        const int i2 = L >> 1; const bool last = (L == 3);
        const float* modl = MOD + (size_t)L * 33 * 6144;
        const float* xl = (L == 0) ? x_in : XLAT; const float* xc = (L == 0) ? ctx_in : XCTX;
        float* SSQ1 = (float*)(ws + WS_SSQ); float* SSQ2 = SSQ1 + 131072; const float* SHWin = (const float*)(ws + WS_SHW) + (size_t)L * 33 * 8192; const float* SHW1 = SHWin + 33 * 4096;
        const int Ln = (L < 3) ? L + 1 : 3;
        bf16* ATT;
        if ((L & 1) == 0) {
            unsigned char* we = ws + WS_W + (size_t)i2 * 8 * MiB; const bf16* WinM = (const bf16*)we; const bf16* WinV = (const bf16*)(we + 3584 * 1024); const bf16* Wout = (const bf16*)(we + 5 * MiB);
            bf16* RAW = (bf16*)RG; bf16* VT = (bf16*)(RG + 252 * MiB); ATT = (bf16*)(RG + 576 * MiB);
            {   pg8::Gemm g{H, WinM, R, 1792, 1024}; pg8::StaticOrder S; S.init(R, 1792, G, bx); pg8::EpiEvenIn E{RAW, SSQ1, SHWin, ap->in[12] + i2 * 128 + 64, ap->in[15] + i2 * 128 + 64};
                pg8::gemm_phase<pg8::EpiEvenIn, pg8::StaticOrder, true, true>(lds, g, S, E, wave_s); }
            {   pg8::Gemm g{WinV, H, 768, R, 1024}; pg8::StaticOrder S; S.init(768, R, G, bx); pg8::EpiVT<true> E{VT, 768, SSQ1, SHWin + 1792, 2560, 1.0f / 1024.0f};
                pg8::gemm_phase<pg8::EpiVT<true>, pg8::StaticOrder, true, true>(lds, g, S, E, wave_s); }
            xcd_barrier(xbar, wave_s);
            {
                const int lane = fresh_lane(), wave = wave_s;
                const float* lamp = ap->in[13] + i2 * 256;
                const float lam_init = 0.8f - 0.6f * __expf(-0.3f * (float)L);
                const float lam_v = __expf(wave_sum(lamp[lane] * lamp[64 + lane], lane)) - __expf(wave_sum(lamp[128 + lane] * lamp[192 + lane], lane)) + lam_init;
                const float lam = __builtin_bit_cast(float, __builtin_amdgcn_readfirstlane(__builtin_bit_cast(int, lam_v)));
                const float* subln = ap->in[14] + i2 * 128;
                const int nlat_d = 1024, nctx_d = 128, nlat_g = 2048, nctx_g = 256;
#ifndef NO_DIFF
                unsigned* ctrs = (unsigned*)(ws + WS_CTL) + 3584 + 8 * L; volatile LAS unsigned* slot = (volatile LAS unsigned*)(lds + MISC_OFF) + 8;
                for (int u = grab_unit(ctrs, slot, wave_s); u < nlat_d + nctx_d; ) { bool tk_mine; const unsigned tk_next = ticket_issue(ctrs, wave_s, tk_mine);
                    int b, h, row0, nt;
                    if (u < nlat_d) { const int qb = u & 7; h = (u >> 3) & 3; b = u >> 5; row0 = b * 2048 + qb * 256 + wave * 32; nt = 36; }
                    else { const int uu = u - nlat_d; h = uu & 3; b = uu >> 2; row0 = NLAT + b * 256 + wave * 32; nt = 4; }
                    f32x16 o[4]; float l;
                    const bf16* vt = VT + ((size_t)b * 768 + h * 128) * KV;
                    attn_pass<64, 128, false>(lds, RAW + (size_t)row0 * RAWP + (h * 2) * 64, RAWP, RAW + (size_t)(NLAT + b * 256) * RAWP + 512 + (h * 2) * 64, RAW + (size_t)(b * 2048) * RAWP + 512 + (h * 2) * 64, RAWP, vt, nt, ap->in[12] + i2 * 128, row0, 0.125f * LOG2E, o, l, wave_s);
                    { const int ln = fresh_lane(); LAS unsigned* o1s = (LAS unsigned*)(lds + 57344 + wave_s * 8192) + ln; const float inv = 1.0f / (l + shx(l, 32, ln));
#pragma unroll
                      for (int db = 0; db < 4; ++db)
#pragma unroll
                          for (int j = 0; j < 8; ++j) o1s[(db * 8 + j) * 64] = pg8::cvt_pk_bf16(o[db][2 * j] * inv, o[db][2 * j + 1] * inv); }
                    attn_pass<64, 128, false>(lds, RAW + (size_t)row0 * RAWP + (h * 2 + 1) * 64, RAWP, RAW + (size_t)(NLAT + b * 256) * RAWP + 512 + (h * 2 + 1) * 64, RAW + (size_t)(b * 2048) * RAWP + 512 + (h * 2 + 1) * 64, RAWP, vt, nt, ap->in[12] + i2 * 128, row0, 0.125f * LOG2E, o, l, wave_s);
                    { const int ln = fresh_lane(), i = ln & 31, hh = ln >> 5; LAS unsigned* o1s = (LAS unsigned*)(lds + 57344 + wave_s * 8192) + ln; const float inv = lam / (l + shx(l, 32, ln)); float ss = 0.f;
#pragma unroll
                      for (int db = 0; db < 4; ++db)
#pragma unroll
                          for (int j = 0; j < 8; ++j) { const unsigned pk = o1s[(db * 8 + j) * 64]; const float a0 = bflo(pk) - o[db][2 * j] * inv, a1 = bfhi(pk) - o[db][2 * j + 1] * inv; o[db][2 * j] = a0; o[db][2 * j + 1] = a1; ss += a0 * a0 + a1 * a1; }
                      ss += shx(ss, 32, ln);
                      const float rinv = (1.0f - lam_init) / sqrtf(ss * (1.0f / 128) + EPS);
                      bf16* rp = ATT + (size_t)(row0 + i) * D + h * 128 + 4 * hh;
#pragma unroll
                      for (int db = 0; db < 4; ++db)
#pragma unroll
                          for (int g4 = 0; g4 < 4; ++g4) { const f32x4 sg = *(const f32x4*)(subln + 32 * db + 8 * g4 + 4 * hh);
                              u32x2 w; w.x = pk2(o[db][4 * g4] * rinv * sg.x, o[db][4 * g4 + 1] * rinv * sg.y); w.y = pk2(o[db][4 * g4 + 2] * rinv * sg.z, o[db][4 * g4 + 3] * rinv * sg.w);
                              *(u32x2*)(rp + 32 * db + 8 * g4) = w; } }
                    u = ticket_publish(tk_next, tk_mine, slot);
                }
#endif
#ifndef NO_GQA
                for (int u = grab_unit(ctrs + 1, slot, wave_s); u < nlat_g + nctx_g; ) { bool tk_mine; const unsigned tk_next = ticket_issue(ctrs + 1, wave_s, tk_mine);
                    int b, hq, row0, nt;
                    if (u < nlat_g) { const int qb = u & 7; hq = (u >> 3) & 7; b = u >> 6; row0 = b * 2048 + qb * 256 + wave * 32; nt = 36; }
                    else { const int uu = u - nlat_g; hq = uu & 7; b = uu >> 3; row0 = NLAT + b * 256 + wave * 32; nt = 4; }
                    const int kvh = hq >> 2; f32x16 o[2]; float l;
                    attn_pass<64, 64, false>(lds, RAW + (size_t)row0 * RAWP + 1024 + hq * 64, RAWP, RAW + (size_t)(NLAT + b * 256) * RAWP + 1536 + kvh * 64, RAW + (size_t)(b * 2048) * RAWP + 1536 + kvh * 64, RAWP,
                                      VT + ((size_t)b * 768 + 512 + kvh * 64) * KV, nt, ap->in[15] + i2 * 128, row0, 0.125f * LOG2E, o, l, wave_s);
                    { const int ln = fresh_lane(); attn_store<2>(ATT, row0, 512 + hq * 64, o, 1.0f / (l + shx(l, 32, ln)), ln); }
                    u = ticket_publish(tk_next, tk_mine, slot);
                }
#endif
            }
            xcd_barrier(xbar, wave_s);
            {   pg8::Gemm g{ATT, Wout, R, 1024, 1024}; pg8::StaticOrder S; S.init(R, 1024, G, bx); pg8::EpiResid E{xl, xc, XLAT, XCTX, modl + 2048, H, norm_mlp + L * 1024, modl + 4096, SSQ2};
                zero_f32(SSQ1, R, vcu, NGW, wave_s);
                pg8::gemm_phase<pg8::EpiResid, pg8::StaticOrder, true, true>(lds, g, S, E, wave_s); }
        } else {
            unsigned char* wo = ws + WS_W + 16 * MiB + (size_t)i2 * 8 * MiB; const bf16* MWin = (const bf16*)wo; const bf16* MQup = (const bf16*)(wo + 2 * MiB); const bf16* MKn = (const bf16*)(wo + 3584 * 1024);
            const bf16* MV = (const bf16*)(wo + 4 * MiB); const bf16* MWout = (const bf16*)(wo + 4608 * 1024);
            bf16* MRAW = (bf16*)RG; ATT = (bf16*)RG; bf16* Q = (bf16*)(RG + 144 * MiB); bf16* Kb = (bf16*)(RG + 360 * MiB); bf16* VT = (bf16*)(RG + 576 * MiB);
            bf16* QCn = (bf16*)RG; bf16* KVCn = (bf16*)(RG + 72 * MiB); bf16* KR = (bf16*)(RG + 108 * MiB);
            float* SSQq = (float*)(ws + WS_SSQM); float* SSQkv = SSQq + 131072; const float* ZSH = SSQq + 229376;
            {   pg8::Gemm g{H, MWin, R, 1024, 1024}; pg8::StaticOrder S; S.init(R, 1024, G, bx); pg8::EpiMlaIn E{SSQ1, SHWin, QCn, KVCn, KR, ap->in[17] + i2 * 512, ap->in[19] + i2 * 256, SSQq, SSQkv};
                pg8::gemm_phase<pg8::EpiMlaIn, pg8::StaticOrder, true, true>(lds, g, S, E, wave_s); }
            xcd_barrier(xbar, wave_s);
            {   pg8::Gemm g{QCn, MQup, R, 1536, 512}; pg8::StaticOrder S; S.init(R, 1536, G, bx); pg8::EpiStore<0, 0, true> E{Q, MQP, SSQq, ZSH, 0, 1.0f / 512.0f};
                pg8::gemm_phase<pg8::EpiStore<0, 0, true>, pg8::StaticOrder, true, true>(lds, g, S, E, wave_s); }
            {   pg8::Gemm g{KVCn, MKn, R, 1024, 256}; pg8::StaticOrder S; S.init(R, 1024, G, bx); pg8::EpiMlaKn E{Kb, SSQkv, KR, ap->in[21] + i2 * 192 + 96};
                pg8::gemm_phase<pg8::EpiMlaKn, pg8::StaticOrder, true, true>(lds, g, S, E, wave_s); }
            {   pg8::Gemm g{MV, KVCn, 1024, R, 256}; pg8::StaticOrder S; S.init(1024, R, G, bx); pg8::EpiVT<true> E{VT, 1024, SSQkv, ZSH, 0, 1.0f / 256.0f};
                pg8::gemm_phase<pg8::EpiVT<true>, pg8::StaticOrder, true, true>(lds, g, S, E, wave_s); }
            xcd_barrier(xbar, wave_s);
            {   const float* gq = ap->in[21] + i2 * 192; const float* gk = gq + 96;
                const int lane = fresh_lane(), wave = wave_s;
                const int nlat = 4096, nctx = last ? 0 : 512;
#ifndef NO_MLA
                unsigned* ctrs = (unsigned*)(ws + WS_CTL) + 3584 + 8 * L; volatile LAS unsigned* slot = (volatile LAS unsigned*)(lds + MISC_OFF) + 8;
                for (int u = grab_unit(ctrs, slot, wave_s); u < nlat + nctx; ) { bool tk_mine; const unsigned tk_next = ticket_issue(ctrs, wave_s, tk_mine);
                    int b, h, row0, nt;
                    if (u < nlat) { const int qb = u & 7; h = (u >> 3) & 15; b = u >> 7; row0 = b * 2048 + qb * 256 + wave * 32; nt = 36; }
                    else { const int uu = u - nlat; h = uu & 15; b = uu >> 4; row0 = NLAT + b * 256 + wave * 32; nt = 4; }
                    f32x16 o[2]; float l;
                    attn_pass<96, 64, false>(lds, Q + (size_t)row0 * MQP + h * 96, MQP, Kb + (size_t)(NLAT + b * 256) * MQP + h * 96, Kb + (size_t)(b * 2048) * MQP + h * 96, MQP,
                                      VT + ((size_t)b * 1024 + h * 64) * KV, nt, gq, row0, 0.10206207261596577f * LOG2E, o, l, wave_s);
                    { const int ln = fresh_lane(); attn_store<2>(ATT, row0, h * 64, o, 1.0f / (l + shx(l, 32, ln)), ln); }
                    u = ticket_publish(tk_next, tk_mine, slot);
                }
#endif
            }
            xcd_barrier(xbar, wave_s);
            {   const int Mr = last ? NLAT : R;
                pg8::Gemm g{ATT, MWout, Mr, 1024, 1024}; pg8::StaticOrder S; S.init(Mr, 1024, G, bx); pg8::EpiResid E{xl, xc, XLAT, XCTX, modl + 2048, H, norm_mlp + L * 1024, modl + 4096, SSQ2};
                zero_f32(SSQ1, R, vcu, NGW, wave_s);
                pg8::gemm_phase<pg8::EpiResid, pg8::StaticOrder, true, true>(lds, g, S, E, wave_s); }
        }
        xcd_barrier(xbar, wave_s);
        {   const int Mr = last ? NLAT : R; unsigned char* wm = ws + WS_W + 32 * MiB + (size_t)L * 16 * MiB; bf16* HID = (bf16*)RG;
            {   pg8::Gemm g{H, (const bf16*)wm, Mr, FF, 1024}; pg8::StaticOrder S; S.init(Mr, FF, G, bx); pg8::EpiStore<1, 0, true> E{HID, FF, SSQ2, SHW1, 4096, 1.0f / 1024.0f};
                pg8::gemm_phase<pg8::EpiStore<1, 0, true>, pg8::StaticOrder, true, true>(lds, g, S, E, wave_s); }
            xcd_barrier(xbar, wave_s);
            {   pg8::Gemm g{HID, (const bf16*)(wm + 8 * MiB), Mr, 1024, FF}; pg8::StaticOrder S; S.init(Mr, 1024, G, bx); pg8::EpiResid E{XLAT, XCTX, XLAT, XCTX, modl + 5120, H, norm_mix + Ln * 1024, MOD + (size_t)Ln * 33 * 6144 + 1024, SSQ1};
                zero_f32(SSQ2, R, vcu, NGW, wave_s); zero_f32((float*)(ws + WS_SSQM), 229376, vcu, NGW, wave_s);
                pg8::gemm_phase<pg8::EpiResid, pg8::StaticOrder, true, true>(lds, g, S, E, wave_s); }
        }
        xcd_barrier(xbar, wave_s);
    }
}

extern "C" void kernel_launch(void* const* d_in, const int* in_sizes, int n_in, void* d_out, int out_size, void* d_ws, size_t ws_size, hipStream_t stream) {
    static int grid = 0;
    if (grid == 0) {
        if (n_in != 23 || out_size != NLAT * D || ws_size < WS_END) { fprintf(stderr, "kernel_launch: unexpected shapes (n_in %d, out %d, ws %zu)\n", n_in, out_size, ws_size); grid = -1; return; }
        int dev = 0, cus = 0, per_cu = 0;
        hipGetDevice(&dev); hipDeviceGetAttribute(&cus, hipDeviceAttributeMultiprocessorCount, dev);
        if (hipFuncSetAttribute((const void*)mega_fwd, hipFuncAttributeMaxDynamicSharedMemorySize, LDS_BYTES) != hipSuccess) { fprintf(stderr, "kernel_launch: hipFuncSetAttribute failed\n"); grid = -1; return; }
        if (hipOccupancyMaxActiveBlocksPerMultiprocessor(&per_cu, (const void*)mega_fwd, NTHR, LDS_BYTES) != hipSuccess || per_cu < 1) { fprintf(stderr, "kernel_launch: occupancy query says %d\n", per_cu); per_cu = 1; }
        (void)hipGetLastError();
        grid = cus;
    }
    if (grid < 0) return;
    if (hipMemsetAsync((char*)d_ws + WS_CTL, 0, CTL_BYTES, stream) != hipSuccess) { fprintf(stderr, "kernel_launch: memset failed\n"); return; }
    Args a{};
    for (int i = 0; i < 23; ++i) a.in[i] = (const float*)d_in[i];
    a.out = (float*)d_out; a.ws = (unsigned char*)d_ws;
    void* kargs[] = {&a};
    hipError_t e = hipLaunchCooperativeKernel((const void*)mega_fwd, dim3(grid), dim3(NTHR), kargs, LDS_BYTES, stream);
    if (e != hipSuccess) fprintf(stderr, "kernel_launch: cooperative launch failed: %s (grid %d)\n", hipGetErrorString(e), grid);
}
```

```cpp
#include <hip/hip_runtime.h>
#include <hip/hip_cooperative_groups.h>
#include <cstdio>
#include <cstdint>
#include <cmath>
namespace cg = cooperative_groups;
__device__ __forceinline__ int fresh_lane() { int m1 = -1; asm volatile("" : "+s"(m1)); return __builtin_amdgcn_mbcnt_hi(m1, __builtin_amdgcn_mbcnt_lo(m1, 0)); }
namespace pg8 {
#define PG8_LAS __attribute__((address_space(3)))
typedef unsigned short bf16_t;
typedef short bf16x8 __attribute__((ext_vector_type(8)));
typedef float f32x4 __attribute__((ext_vector_type(4)));
typedef unsigned u32x4 __attribute__((ext_vector_type(4)));
constexpr int BM = 256, BK = 64, HALF = 128, HTB = HALF * BK * 2  , STAGE_BYTES = 8 * HTB, NXCD = 8, WGM = 8;

__host__ __device__ __forceinline__ int lds_byte(int r, int c) { const int st = (r >> 4) * 2 + (c >> 5), rr = r & 15, cc = c & 31, ob = rr * 64 + cc * 2; return st * 1024 + (ob ^ (((ob >> 9) & 1) << 5)); }
__host__ __device__ __forceinline__ void stage_rc(int b, int& R, int& C) { const int st = b / 1024, sb = b % 1024, swz = sb ^ (((sb >> 9) & 1) << 5); R = (st >> 1) * 16 + swz / 64; C = (st & 1) * 32 + (swz % 64) / 2; }
__host__ __device__ __forceinline__ int perm32(int rho) { const int n = rho >> 4, i = rho & 15; return 8 * (i >> 2) + 4 * n + (i & 3); }

struct Unit { int pm, pn; };
struct Gemm { const bf16_t* A; const bf16_t* Bt; int M, N, K; };

struct StaticOrder {
    int nM, nN, nwg, G, c, rev;
    __host__ __device__ void init(int M, int N, int G_, int c_) { nM = M / BM; nN = N / BM; nwg = nM * nN; G = G_; c = c_; rev = 0; }
    __host__ __device__ bool next(int i, Unit& u) const {
        const long L = (long)i * G + c; if (L >= nwg) return false;
        int wgid = (int)L; { const int q = nwg / NXCD, r = nwg % NXCD, xcd = wgid % NXCD, off = wgid / NXCD; wgid = (xcd < r ? xcd * (q + 1) : r * (q + 1) + (xcd - r) * q) + off; }
        if (rev) wgid = nwg - 1 - wgid;
        const int nig = WGM * nN, gid = wgid / nig, fm = gid * WGM, gsz = (nM - fm) < WGM ? (nM - fm) : WGM;
        u.pm = fm + ((wgid % nig) % gsz); u.pn = (wgid % nig) / gsz; return true;
    }
    __device__ __forceinline__ void a_ready(const Unit&) const {}
    __device__ __forceinline__ void done(const Unit&) const {}
};

__device__ __forceinline__ unsigned cvt_pk_bf16(float lo, float hi) { unsigned r; asm volatile("v_cvt_pk_bf16_f32 %0, %1, %2" : "=v"(r) : "v"(lo), "v"(hi)); return r; }
typedef float f32x2 __attribute__((ext_vector_type(2)));
typedef unsigned u32x2 __attribute__((ext_vector_type(2)));
__device__ __forceinline__ float rinv_of(float ssq, float invn) { return 1.0f / sqrtf(ssq * invn + 1e-6f); }
__device__ __forceinline__ int mi_of_tile(int r0) { return r0 < 65536 ? (r0 >> 11) : 32; }
template <int ACT, int HEADMAP, bool NORM> struct EpiStore {
    static constexpr bool PERM = true, AFTER_DRAIN = false, HEAD64 = false;
    bf16_t* O; int ldc; const float* ssq; const float* shw; int ldshw; float invn;
    __device__ __forceinline__ void operator()(const f32x4 (&acc)[2][2][4][2], const Unit& u, int wr, int wc, int fr, int fq) const {
        { const int t_ = fresh_lane(); fr = t_ & 15; fq = (t_ >> 4) & 3; }
        const int row0 = u.pm * BM + wr * 64 + fr; const int colb = u.pn * BM + wc * 32 + 8 * fq;
        f32x4 sw[2][2];
        if (NORM) { const float* sp = shw + (size_t)mi_of_tile(u.pm * BM) * ldshw + colb;
#pragma unroll
            for (int bj = 0; bj < 2; ++bj) { sw[bj][0] = *(const f32x4*)(sp + bj * HALF); sw[bj][1] = *(const f32x4*)(sp + bj * HALF + 4); } }
        float riv[2][4];
#pragma unroll
        for (int ai = 0; ai < 2; ++ai)
#pragma unroll
            for (int m = 0; m < 4; ++m) riv[ai][m] = NORM ? ssq[row0 + ai * HALF + m * 16] : 0.f;
#pragma unroll
        for (int ai = 0; ai < 2; ++ai)
#pragma unroll
            for (int m = 0; m < 4; ++m) { const int row = row0 + ai * HALF + m * 16; bf16_t* rowp = O + (size_t)row * ldc;
                float ri = 1.0f; if (NORM) ri = rinv_of(riv[ai][m], invn);
#pragma unroll
                for (int bj = 0; bj < 2; ++bj) { const int c = colb + bj * HALF; const int dc = HEADMAP ? ((c >> 6) * 96 + (c & 63)) : c;
                    f32x4 v0 = acc[ai][bj][m][0], v1 = acc[ai][bj][m][1];
                    if (NORM) { v0 = v0 * ri + sw[bj][0]; v1 = v1 * ri + sw[bj][1]; }
                    if (ACT == 1) {
#pragma unroll
                        for (int e = 0; e < 4; ++e) { float a = v0[e] > 0.f ? v0[e] : 0.f; v0[e] = a * a; float b = v1[e] > 0.f ? v1[e] : 0.f; v1[e] = b * b; } }
                    u32x4 w; w.x = cvt_pk_bf16(v0[0], v0[1]); w.y = cvt_pk_bf16(v0[2], v0[3]); w.z = cvt_pk_bf16(v1[0], v1[1]); w.w = cvt_pk_bf16(v1[2], v1[3]);
                    *(u32x4*)(rowp + dc) = w; } }
    }
};
template <bool NORM> struct EpiVT {
    static constexpr bool PERM = true, AFTER_DRAIN = false, HEAD64 = false;
    bf16_t* VT; int NF; const float* ssq; const float* shw; int ldshw; float invn;
    __device__ __forceinline__ void operator()(const f32x4 (&acc)[2][2][4][2], const Unit& u, int wr, int wc, int fr, int fq) const {
        { const int t_ = fresh_lane(); fr = t_ & 15; fq = (t_ >> 4) & 3; }
        const int r0 = u.pn * BM; int b, kv0; if (r0 < 65536) { b = r0 >> 11; kv0 = 256 + (r0 & 2047); } else { b = (r0 - 65536) >> 8; kv0 = 0; }
        const int f0 = u.pm * BM + wr * 64 + fr;
        f32x4 ri[2][2];
        if (NORM) {
#pragma unroll
            for (int bj = 0; bj < 2; ++bj)
#pragma unroll
                for (int n = 0; n < 2; ++n) { const f32x4 s = *(const f32x4*)(ssq + r0 + bj * HALF + wc * 32 + 8 * fq + 4 * n); ri[bj][n] = (f32x4){rinv_of(s.x, invn), rinv_of(s.y, invn), rinv_of(s.z, invn), rinv_of(s.w, invn)}; } }
        const float* sp = NORM ? shw + (size_t)mi_of_tile(r0) * ldshw : nullptr;
        float shv[2][4];
#pragma unroll
        for (int ai = 0; ai < 2; ++ai)
#pragma unroll
            for (int m = 0; m < 4; ++m) shv[ai][m] = NORM ? sp[f0 + ai * HALF + m * 16] : 0.f;
#pragma unroll
        for (int ai = 0; ai < 2; ++ai)
#pragma unroll
            for (int m = 0; m < 4; ++m) { const int f = f0 + ai * HALF + m * 16; bf16_t* rowp = VT + ((size_t)b * NF + f) * 2304 + kv0;
                const float sh = shv[ai][m];
#pragma unroll
                for (int bj = 0; bj < 2; ++bj) { const int cw = bj * HALF + wc * 32 + 8 * fq; const int gb = cw & ~15, o = cw & 15;
#pragma unroll
                    for (int n = 0; n < 2; ++n) { const int o4 = o + 4 * n; const int pos = (o4 & 3) | (((o4 >> 2) & 1) << 3) | (((o4 >> 3) & 1) << 2);
                        f32x4 v = acc[ai][bj][m][n]; if (NORM) v = v * ri[bj][n] + sh;
                        u32x2 w; w.x = cvt_pk_bf16(v[0], v[1]); w.y = cvt_pk_bf16(v[2], v[3]);
                        *(u32x2*)(rowp + gb + pos) = w; } } }
    }
};
struct EpiMlaIn {
    static constexpr bool PERM = true, AFTER_DRAIN = false, HEAD64 = false;
    const float* ssq; const float* shw; bf16_t* QCg; bf16_t* KVCg; bf16_t* KR; const float* gq; const float* gkv; float* ssq_q; float* ssq_kv;
    __device__ __forceinline__ void operator()(const f32x4 (&acc)[2][2][4][2], const Unit& u, int wr, int wc, int fr, int fq) const {
        const int ln_ = fresh_lane(); fr = ln_ & 15; fq = (ln_ >> 4) & 3;
        const int row0 = u.pm * BM + wr * 64 + fr; const int colb = u.pn * BM + wc * 32 + 8 * fq;
        const float* sp = shw + (size_t)mi_of_tile(u.pm * BM) * 1024 + colb;
        f32x4 sw[2][2], gg[2][2];
#pragma unroll
        for (int bj = 0; bj < 2; ++bj) { sw[bj][0] = *(const f32x4*)(sp + bj * HALF); sw[bj][1] = *(const f32x4*)(sp + bj * HALF + 4);
            const int c = colb + bj * HALF;
            if (u.pn < 2) { gg[bj][0] = *(const f32x4*)(gq + c); gg[bj][1] = *(const f32x4*)(gq + c + 4); }
            else if (u.pn == 2) { gg[bj][0] = *(const f32x4*)(gkv + c - 512); gg[bj][1] = *(const f32x4*)(gkv + c - 508); }
            else { gg[bj][0] = (f32x4){1.f, 1.f, 1.f, 1.f}; gg[bj][1] = gg[bj][0]; } }
        float riv[2][4];
#pragma unroll
        for (int ai = 0; ai < 2; ++ai)
#pragma unroll
            for (int m = 0; m < 4; ++m) riv[ai][m] = ssq[row0 + ai * HALF + m * 16];
#pragma unroll
        for (int ai = 0; ai < 2; ++ai)
#pragma unroll
            for (int m = 0; m < 4; ++m) { const int row = row0 + ai * HALF + m * 16; const float ri = rinv_of(riv[ai][m], 1.0f / 1024.0f); float ps = 0.f;
#pragma unroll
                for (int bj = 0; bj < 2; ++bj) { const int c = colb + bj * HALF;
                    const f32x4 v0 = acc[ai][bj][m][0] * ri + sw[bj][0], v1 = acc[ai][bj][m][1] * ri + sw[bj][1];
                    ps += ((v0[0] * v0[0] + v0[1] * v0[1]) + (v0[2] * v0[2] + v0[3] * v0[3])) + ((v1[0] * v1[0] + v1[1] * v1[1]) + (v1[2] * v1[2] + v1[3] * v1[3]));
                    const f32x4 a0 = v0 * gg[bj][0], a1 = v1 * gg[bj][1];
                    u32x4 w; w.x = cvt_pk_bf16(a0[0], a0[1]); w.y = cvt_pk_bf16(a0[2], a0[3]); w.z = cvt_pk_bf16(a1[0], a1[1]); w.w = cvt_pk_bf16(a1[2], a1[3]);
                    if (u.pn < 2) *(u32x4*)(QCg + (size_t)row * 512 + c) = w;
                    else if (u.pn == 2) *(u32x4*)(KVCg + (size_t)row * 256 + (c - 512)) = w;
                    else if (c < 800) *(u32x4*)(KR + (size_t)row * 32 + (c - 768)) = w; }
                if (u.pn < 3) {
                    ps += __builtin_bit_cast(float, __builtin_amdgcn_ds_bpermute((ln_ ^ 16) << 2, __builtin_bit_cast(int, ps)));
                    ps += __builtin_bit_cast(float, __builtin_amdgcn_ds_bpermute((ln_ ^ 32) << 2, __builtin_bit_cast(int, ps)));
                    if (fq == 0) atomicAdd((u.pn < 2 ? ssq_q : ssq_kv) + row, ps); } }
    }
};
__device__ __forceinline__ void cs_rev(float a, float& c, float& s) {
    double rev = (double)a * 0.15915494309189535; rev -= floor(rev); const float rf = (float)rev; c = __builtin_amdgcn_cosf(rf); s = __builtin_amdgcn_sinf(rf); }
__device__ __forceinline__ float shx32(float v, int o, int lane) { return __builtin_bit_cast(float, __builtin_amdgcn_ds_bpermute((lane ^ o) << 2, __builtin_bit_cast(int, v))); }
struct EpiEvenIn {
    static constexpr bool PERM = true, AFTER_DRAIN = false, HEAD64 = true;
    bf16_t* O; const float* ssq; const float* shw; const float* gdk; const float* ggk;
    __device__ __forceinline__ void operator()(const f32x4 (&acc)[2][2][4][2], const Unit& u, int wr, int wc, int fr, int fq) const {
        const int ln_ = fresh_lane(); fr = ln_ & 15; fq = (ln_ >> 4) & 3;
        const int rt = u.pm * BM; const int row0 = rt + wr * 64 + fr; const int colb = u.pn * BM + wc * 64 + 8 * fq;
        const bool isk = (u.pn == 2) || (u.pn == 3) || (u.pn == 6 && wc < 2); const bool isl = rt < 65536;
        const float* sp = shw + (size_t)mi_of_tile(rt) * 2560 + colb;
        f32x4 sw[2][2], gg[2][2]; float invf[8];
#pragma unroll
        for (int bj = 0; bj < 2; ++bj)
#pragma unroll
            for (int n = 0; n < 2; ++n) { sw[bj][n] = *(const f32x4*)(sp + 32 * bj + 4 * n); gg[bj][n] = (f32x4){1.f, 1.f, 1.f, 1.f}; }
        if (isk) { const float* g = (u.pn == 6) ? ggk : gdk;
#pragma unroll
            for (int bj = 0; bj < 2; ++bj)
#pragma unroll
                for (int n = 0; n < 2; ++n) gg[bj][n] = *(const f32x4*)(g + 32 * bj + 8 * fq + 4 * n);
#pragma unroll
            for (int j = 0; j < 8; ++j) invf[j] = exp2f(-(float)((8 * fq + j) & 15) * (13.287712379549449f / 16.0f)); }
        float riv[2][4];
#pragma unroll
        for (int ai = 0; ai < 2; ++ai)
#pragma unroll
            for (int m = 0; m < 4; ++m) riv[ai][m] = ssq[row0 + ai * HALF + m * 16];
#pragma unroll
        for (int ai = 0; ai < 2; ++ai)
#pragma unroll
            for (int m = 0; m < 4; ++m) { const int row = row0 + ai * HALF + m * 16; const float ri = rinv_of(riv[ai][m], 1.0f / 1024.0f);
                f32x4 v[2][2];
#pragma unroll
                for (int bj = 0; bj < 2; ++bj)
#pragma unroll
                    for (int n = 0; n < 2; ++n) v[bj][n] = acc[ai][bj][m][n] * ri + sw[bj][n];
                if (isk) { float ss = 0.f;
#pragma unroll
                    for (int bj = 0; bj < 2; ++bj)
#pragma unroll
                        for (int n = 0; n < 2; ++n) ss += (v[bj][n][0] * v[bj][n][0] + v[bj][n][1] * v[bj][n][1]) + (v[bj][n][2] * v[bj][n][2] + v[bj][n][3] * v[bj][n][3]);
                    ss += shx32(ss, 16, ln_); ss += shx32(ss, 32, ln_);
                    const float rh = 1.0f / sqrtf(ss * (1.0f / 64.0f) + 1e-6f);
#pragma unroll
                    for (int bj = 0; bj < 2; ++bj)
#pragma unroll
                        for (int n = 0; n < 2; ++n) v[bj][n] = v[bj][n] * rh * gg[bj][n];
                    if (isl) { const int t = row & 2047; const float pos = (fq < 2) ? (float)(t >> 6) : (float)(t & 63);
#pragma unroll
                        for (int n = 0; n < 2; ++n)
#pragma unroll
                            for (int e = 0; e < 4; ++e) { float c, s; cs_rev(pos * invf[4 * n + e], c, s); const float x1 = v[0][n][e], x2 = v[1][n][e]; v[0][n][e] = x1 * c - x2 * s; v[1][n][e] = x2 * c + x1 * s; } } }
#pragma unroll
                for (int bj = 0; bj < 2; ++bj) { u32x4 w; w.x = cvt_pk_bf16(v[bj][0][0], v[bj][0][1]); w.y = cvt_pk_bf16(v[bj][0][2], v[bj][0][3]); w.z = cvt_pk_bf16(v[bj][1][0], v[bj][1][1]); w.w = cvt_pk_bf16(v[bj][1][2], v[bj][1][3]);
                    *(u32x4*)(O + (size_t)row * 1792 + colb + 32 * bj) = w; } }
    }
};
struct EpiMlaKn {
    static constexpr bool PERM = true, AFTER_DRAIN = false, HEAD64 = true;
    bf16_t* K; const float* ssq_kv; const bf16_t* KR; const float* gk;
    __device__ __forceinline__ void operator()(const f32x4 (&acc)[2][2][4][2], const Unit& u, int wr, int wc, int fr, int fq) const {
        const int ln_ = fresh_lane(); fr = ln_ & 15; fq = (ln_ >> 4) & 3;
        const int rt = u.pm * BM; const int row0 = rt + wr * 64 + fr; const int h = 4 * u.pn + wc; const bool isl = rt < 65536;
        f32x4 gg[2][2], gr[2]; float invf[8];
#pragma unroll
        for (int bj = 0; bj < 2; ++bj)
#pragma unroll
            for (int n = 0; n < 2; ++n) gg[bj][n] = *(const f32x4*)(gk + 32 * bj + 8 * fq + 4 * n);
        gr[0] = *(const f32x4*)(gk + 64 + 8 * fq); gr[1] = *(const f32x4*)(gk + 64 + 8 * fq + 4);
#pragma unroll
        for (int j = 0; j < 8; ++j) invf[j] = exp2f(-(float)j * (13.287712379549449f / 8.0f));
        float riv[2][4];
#pragma unroll
        for (int ai = 0; ai < 2; ++ai)
#pragma unroll
            for (int m = 0; m < 4; ++m) riv[ai][m] = ssq_kv[row0 + ai * HALF + m * 16];
        u32x4 kwn = *(const u32x4*)(KR + (size_t)row0 * 32 + 8 * fq);
#pragma unroll
        for (int ai = 0; ai < 2; ++ai)
#pragma unroll
            for (int m = 0; m < 4; ++m) { const int row = row0 + ai * HALF + m * 16; const float ri = rinv_of(riv[ai][m], 1.0f / 256.0f);
                const u32x4 kw = kwn; { const int nx = ai * 4 + m + 1; if (nx < 8) kwn = *(const u32x4*)(KR + (size_t)(row0 + (nx >> 2) * HALF + (nx & 3) * 16) * 32 + 8 * fq); }
                float r[8] = {__builtin_bit_cast(float, kw.x << 16), __builtin_bit_cast(float, kw.x & 0xffff0000u), __builtin_bit_cast(float, kw.y << 16), __builtin_bit_cast(float, kw.y & 0xffff0000u),
                              __builtin_bit_cast(float, kw.z << 16), __builtin_bit_cast(float, kw.z & 0xffff0000u), __builtin_bit_cast(float, kw.w << 16), __builtin_bit_cast(float, kw.w & 0xffff0000u)};
                f32x4 v[2][2]; float ss = 0.f;
#pragma unroll
                for (int bj = 0; bj < 2; ++bj)
#pragma unroll
                    for (int n = 0; n < 2; ++n) { v[bj][n] = acc[ai][bj][m][n] * ri; ss += (v[bj][n][0] * v[bj][n][0] + v[bj][n][1] * v[bj][n][1]) + (v[bj][n][2] * v[bj][n][2] + v[bj][n][3] * v[bj][n][3]); }
#pragma unroll
                for (int j = 0; j < 8; ++j) ss += r[j] * r[j];
                ss += shx32(ss, 16, ln_); ss += shx32(ss, 32, ln_);
                const float rh = 1.0f / sqrtf(ss * (1.0f / 96.0f) + 1e-6f);
#pragma unroll
                for (int bj = 0; bj < 2; ++bj)
#pragma unroll
                    for (int n = 0; n < 2; ++n) v[bj][n] = v[bj][n] * rh * gg[bj][n];
#pragma unroll
                for (int j = 0; j < 8; ++j) r[j] *= rh * gr[j >> 2][j & 3];
                if (isl) { const int t = row & 2047; const float pos = (fq & 1) ? (float)(t & 63) : (float)(t >> 6);
#pragma unroll
                    for (int j = 0; j < 8; ++j) { const float pr = shx32(r[j], 32, ln_); float c, s; cs_rev(pos * invf[j], c, s); r[j] = (fq < 2) ? (r[j] * c - pr * s) : (r[j] * c + pr * s); } }
                bf16_t* kp = K + (size_t)row * 1536 + h * 96 + 8 * fq;
#pragma unroll
                for (int bj = 0; bj < 2; ++bj) { u32x4 w; w.x = cvt_pk_bf16(v[bj][0][0], v[bj][0][1]); w.y = cvt_pk_bf16(v[bj][0][2], v[bj][0][3]); w.z = cvt_pk_bf16(v[bj][1][0], v[bj][1][1]); w.w = cvt_pk_bf16(v[bj][1][2], v[bj][1][3]);
                    *(u32x4*)(kp + 32 * bj) = w; }
                { u32x4 w; w.x = cvt_pk_bf16(r[0], r[1]); w.y = cvt_pk_bf16(r[2], r[3]); w.z = cvt_pk_bf16(r[4], r[5]); w.w = cvt_pk_bf16(r[6], r[7]); *(u32x4*)(kp + 64) = w; } }
    }
};
struct EpiResid {
    static constexpr bool PERM = true, AFTER_DRAIN = false, HEAD64 = false;
    const float* base_lat; const float* base_ctx; float* out_lat; float* out_ctx; const float* gate;
    bf16_t* AP; const float* gn; const float* scn; float* ssq;
    __device__ __forceinline__ void operator()(const f32x4 (&acc)[2][2][4][2], const Unit& u, int wr, int wc, int fr, int fq) const {
        const int ln_ = fresh_lane(); fr = ln_ & 15; fq = (ln_ >> 4) & 3;
        const int rt = u.pm * BM; const bool isl = rt < 65536; const int mi = isl ? (rt >> 11) : 32;
        const float* bp = isl ? base_lat + (size_t)rt * 1024 : base_ctx + (size_t)(rt - 65536) * 1024;
        float* op = isl ? out_lat + (size_t)rt * 1024 : out_ctx + (size_t)(rt - 65536) * 1024;
        bf16_t* ap = AP + (size_t)rt * 1024;
        const int col0 = u.pn * BM + wc * 32 + 8 * fq; const float* gp = gate + mi * 6144 + col0; const float* sp = scn + mi * 6144 + col0; const float* gnp = gn + col0;
        float ps[2][4];
#pragma unroll
        for (int ai = 0; ai < 2; ++ai)
#pragma unroll
            for (int m = 0; m < 4; ++m) ps[ai][m] = 0.f;
#pragma unroll
        for (int bj = 0; bj < 2; ++bj) { const int co = bj * HALF;
            const f32x4 gv0 = *(const f32x4*)(gp + co), gv1 = *(const f32x4*)(gp + co + 4);
            const f32x4 gs0 = *(const f32x4*)(gnp + co) * (*(const f32x4*)(sp + co) + 1.0f), gs1 = *(const f32x4*)(gnp + co + 4) * (*(const f32x4*)(sp + co + 4) + 1.0f);
#pragma unroll
            for (int ai = 0; ai < 2; ++ai) {
                f32x4 b0[4], b1[4];
#pragma unroll
                for (int m = 0; m < 4; ++m) { const size_t off = (size_t)(ai * HALF + wr * 64 + m * 16 + fr) * 1024 + col0 + co; b0[m] = *(const f32x4*)(bp + off); b1[m] = *(const f32x4*)(bp + off + 4); }
#pragma unroll
                for (int m = 0; m < 4; ++m) { const size_t off = (size_t)(ai * HALF + wr * 64 + m * 16 + fr) * 1024 + col0 + co;
                    const f32x4 o0 = b0[m] + gv0 * acc[ai][bj][m][0], o1 = b1[m] + gv1 * acc[ai][bj][m][1];
                    *(f32x4*)(op + off) = o0; *(f32x4*)(op + off + 4) = o1;
                    const f32x4 a0 = o0 * gs0, a1 = o1 * gs1; u32x4 w; w.x = cvt_pk_bf16(a0[0], a0[1]); w.y = cvt_pk_bf16(a0[2], a0[3]); w.z = cvt_pk_bf16(a1[0], a1[1]); w.w = cvt_pk_bf16(a1[2], a1[3]);
                    *(u32x4*)(ap + off) = w;
                    ps[ai][m] += ((o0[0] * o0[0] + o0[1] * o0[1]) + (o0[2] * o0[2] + o0[3] * o0[3])) + ((o1[0] * o1[0] + o1[1] * o1[1]) + (o1[2] * o1[2] + o1[3] * o1[3])); }
                asm volatile("" ::: "memory"); } }
#pragma unroll
        for (int ai = 0; ai < 2; ++ai)
#pragma unroll
            for (int m = 0; m < 4; ++m) { float s = ps[ai][m];
                s += __builtin_bit_cast(float, __builtin_amdgcn_ds_bpermute((ln_ ^ 16) << 2, __builtin_bit_cast(int, s)));
                s += __builtin_bit_cast(float, __builtin_amdgcn_ds_bpermute((ln_ ^ 32) << 2, __builtin_bit_cast(int, s)));
                if (fq == 0) atomicAdd(ssq + rt + ai * HALF + wr * 64 + m * 16 + fr, s); }
    }
};
struct EpiShw {
    static constexpr bool PERM = false, AFTER_DRAIN = false, HEAD64 = false;
    float* SHW;
    __device__ __forceinline__ void operator()(const f32x4 (&acc)[2][2][4][2], const Unit& u, int wr, int wc, int fr, int fq) const {
        { const int t_ = fresh_lane(); fr = t_ & 15; fq = (t_ >> 4) & 3; }
        if (wr != 0) return;
        const int L = u.pm >> 1, w = u.pm & 1; const int i2 = L >> 1;
        const int t0 = w ? (64 + L * 32) : ((L & 1) ? (32 + i2 * 16) : (i2 * 16));
        const int ld = w ? 4096 : ((L & 1) ? 1024 : 2560);
        float* dst = SHW + (size_t)L * 33 * 8192 + (w ? 33 * 4096 : 0) + (u.pn - t0) * 256 + wc * 32 + 4 * fq;
#pragma unroll
        for (int m = 0; m < 3; ++m) { const int row = m * 16 + fr; if (row < 33) {
#pragma unroll
                for (int bj = 0; bj < 2; ++bj)
#pragma unroll
                    for (int n = 0; n < 2; ++n) *(f32x4*)(dst + (size_t)row * ld + bj * HALF + n * 16) = acc[0][bj][m][n]; } }
    }
};
struct ShwOrder {
    int G, c;
    __device__ __forceinline__ bool next(int i, Unit& u) const {
        int j = i * G + c; if (j >= 92) return false;
        int L = 0; if (j >= 26) { j -= 26; L = 1; if (j >= 20) { j -= 20; L = 2; if (j >= 26) { j -= 26; L = 3; } } }
        const int nin = (L & 1) ? 4 : 10; const int i2 = L >> 1;
        if (j < nin) { u.pm = 2 * L; u.pn = ((L & 1) ? (32 + i2 * 16) : (i2 * 16)) + j; }
        else { u.pm = 2 * L + 1; u.pn = 64 + L * 32 + (j - nin); }
        return true;
    }
    __device__ __forceinline__ void a_ready(const Unit&) const {}
    __device__ __forceinline__ void done(const Unit&) const {}
};
template <class Epi, class Sched, bool ALIGN_EPI = false, bool SP2 = false>
__device__ __forceinline__ void gemm_phase(PG8_LAS unsigned char* lds, const Gemm g, const Sched& S, const Epi& E, const int wave_s) {
    int tid_ = wave_s * 64 + fresh_lane();
    const int tid = tid_, wid = __builtin_amdgcn_readfirstlane(tid >> 6), lane = tid & 63, wr = wid >> 2, wc = wid & 3, fr = lane & 15, fq = lane >> 4;
    const int K = g.K, nt = K / BK;
    unsigned voffA[2], voffB[2];
#pragma unroll
    for (int i = 0; i < 2; ++i) { int R, C; stage_rc(tid * 16 + i * 8192, R, C); const int Rb = Epi::HEAD64 ? (64 * (R >> 5) + perm32(R & 31)) : (Epi::PERM ? ((R & ~31) + perm32(R & 31)) : R);
        voffA[i] = (unsigned)(R * K + C) * 2u; voffB[i] = (unsigned)(Rb * K + C) * 2u; }
    const size_t kstep = (size_t)(BK * 2);
    const size_t hstep = (size_t)HALF * K * 2;
    const size_t hstepB = Epi::HEAD64 ? (size_t)32 * K * 2 : hstep;
    const size_t tstep = 2 * hstep;
    const unsigned ldsw = (unsigned)wid * 1024u;
    const int aoff = lds_byte(wr * 64 + fr, fq * 8), boff = lds_byte(wc * 32 + fr, fq * 8);
#define PG8_SA(b, h) (((b) * 2 + (h)) * HTB)
#define PG8_SB(b, h) ((4 + (b) * 2 + (h)) * HTB)
#define PG8_STAGE(bufoff, gbase, voff) do { _Pragma("unroll") for (int _i = 0; _i < 2; ++_i) \
        __builtin_amdgcn_global_load_lds((const unsigned*)((const char*)(gbase) + (voff)[_i]), (PG8_LAS unsigned*)(lds + (bufoff) + ldsw + _i * 8192), 16, 0, 0); } while (0)
#define PG8_LDA(dst, b, h) do { _Pragma("unroll") for (int m = 0; m < 4; ++m) _Pragma("unroll") for (int k = 0; k < 2; ++k) dst[m][k] = *(const PG8_LAS bf16x8*)(lds + PG8_SA(b, h) + aoff + m * 2048 + k * 1024); } while (0)
#define PG8_LDB(dst, b, h) do { _Pragma("unroll") for (int n = 0; n < 2; ++n) _Pragma("unroll") for (int k = 0; k < 2; ++k) dst[n][k] = *(const PG8_LAS bf16x8*)(lds + PG8_SB(b, h) + boff + n * 2048 + k * 1024); } while (0)
#define PG8_MMA(ai, bj, At, Bt) do { __builtin_amdgcn_s_setprio(1); _Pragma("unroll") for (int m = 0; m < 4; ++m) _Pragma("unroll") for (int n = 0; n < 2; ++n) _Pragma("unroll") for (int k = 0; k < 2; ++k) \
        acc[ai][bj][m][n] = __builtin_amdgcn_mfma_f32_16x16x32_bf16(Bt[n][k], At[m][k], acc[ai][bj][m][n], 0, 0, 0); __builtin_amdgcn_s_setprio(0); } while (0)
#define PG8_WAIT_V(n) asm volatile("s_waitcnt vmcnt(" #n ")" ::: "memory")
#define PG8_WAIT_L(n) asm volatile("s_waitcnt lgkmcnt(" #n ")" ::: "memory")
#define PG8_BAR __builtin_amdgcn_s_barrier()
#define PG8_SCHED __builtin_amdgcn_sched_barrier(0)
    Unit cur, nxt; int ui = 0;
    if (!S.next(0, cur)) return;
    f32x4 acc[2][2][4][2];
#pragma unroll
    for (int a = 0; a < 2; ++a)
#pragma unroll
        for (int b = 0; b < 2; ++b)
#pragma unroll
            for (int m = 0; m < 4; ++m)
#pragma unroll
                for (int n = 0; n < 2; ++n) acc[a][b][m][n] = (f32x4){0.f, 0.f, 0.f, 0.f};
    bf16x8 At[4][2], B0[2][2], B1[2][2];
    const char* cA = (const char*)g.A + (size_t)cur.pm * tstep; const char* cB = (const char*)g.Bt + (size_t)cur.pn * tstep;
    S.a_ready(cur);
    if constexpr (SP2) {
        PG8_STAGE(PG8_SB(0, 0), cB, voffB); PG8_STAGE(PG8_SB(0, 1), cB + hstepB, voffB); PG8_STAGE(PG8_SA(0, 0), cA, voffA); PG8_STAGE(PG8_SA(0, 1), cA + hstep, voffA);
        if (wr == 1) PG8_BAR;
        PG8_WAIT_V(2); PG8_BAR;
        PG8_STAGE(PG8_SB(1, 0), cB + kstep, voffB); PG8_STAGE(PG8_SA(1, 0), cA + kstep, voffA); PG8_STAGE(PG8_SB(1, 1), cB + hstepB + kstep, voffB);
        PG8_WAIT_V(6); PG8_BAR;
    } else {
        PG8_STAGE(PG8_SB(0, 0), cB, voffB); PG8_STAGE(PG8_SA(0, 0), cA, voffA); PG8_STAGE(PG8_SB(0, 1), cB + hstepB, voffB); PG8_STAGE(PG8_SA(0, 1), cA + hstep, voffA);
        if (wr == 1) PG8_BAR;
        PG8_WAIT_V(4); PG8_BAR;
        PG8_STAGE(PG8_SB(1, 0), cB + kstep, voffB); PG8_STAGE(PG8_SA(1, 0), cA + kstep, voffA); PG8_STAGE(PG8_SB(1, 1), cB + hstepB + kstep, voffB);
        PG8_WAIT_V(6); PG8_BAR;
    }
    for (;;) {
        const bool has_next = S.next(ui + 1, nxt);
        const char* nA = has_next ? (const char*)g.A + (size_t)nxt.pm * tstep : cA; const char* nB = has_next ? (const char*)g.Bt + (size_t)nxt.pn * tstep : cB;
        for (int t = 0; t < nt; t += 2) {
            const bool last = (t == nt - 2);
            const char* a1 = cA + (size_t)(t + 1) * kstep;
            const char* a2 = last ? nA : cA + (size_t)(t + 2) * kstep; const char* b2 = last ? nB : cB + (size_t)(t + 2) * kstep;
            const char* a3 = a2 + kstep; const char* b3 = b2 + kstep;
            if (last && has_next) S.a_ready(nxt);
            if constexpr (SP2) {
            PG8_LDB(B0, 0, 0); PG8_LDB(B1, 0, 1); PG8_SCHED; PG8_LDA(At, 0, 0); PG8_STAGE(PG8_SA(1, 1), a1 + hstep, voffA);
            PG8_WAIT_V(8); PG8_WAIT_L(0); PG8_BAR; PG8_MMA(0, 0, At, B0); PG8_MMA(0, 1, At, B1); PG8_BAR; PG8_SCHED;
            PG8_LDA(At, 0, 1); PG8_STAGE(PG8_SB(0, 0), b2, voffB); PG8_STAGE(PG8_SB(0, 1), b2 + hstepB, voffB); PG8_STAGE(PG8_SA(0, 0), a2, voffA);
            PG8_WAIT_V(8); PG8_WAIT_L(0); PG8_BAR; PG8_MMA(1, 0, At, B0); PG8_MMA(1, 1, At, B1); PG8_BAR; PG8_SCHED;
            PG8_LDB(B0, 1, 0); PG8_LDB(B1, 1, 1); PG8_SCHED; PG8_LDA(At, 1, 0); PG8_STAGE(PG8_SA(0, 1), a2 + hstep, voffA);
            PG8_WAIT_V(8); PG8_WAIT_L(0); PG8_BAR; PG8_MMA(0, 0, At, B0); PG8_MMA(0, 1, At, B1); PG8_BAR; PG8_SCHED;
            PG8_LDA(At, 1, 1); PG8_STAGE(PG8_SB(1, 0), b3, voffB); PG8_STAGE(PG8_SB(1, 1), b3 + hstepB, voffB); PG8_STAGE(PG8_SA(1, 0), a3, voffA);
            PG8_WAIT_V(8); PG8_WAIT_L(0); PG8_BAR; PG8_MMA(1, 0, At, B0); PG8_MMA(1, 1, At, B1); PG8_BAR; PG8_SCHED;
            } else {
            PG8_LDB(B0, 0, 0); PG8_SCHED; PG8_LDA(At, 0, 0); PG8_STAGE(PG8_SA(1, 1), a1 + hstep, voffA);
            PG8_WAIT_L(8); PG8_BAR; PG8_WAIT_L(0); PG8_MMA(0, 0, At, B0); PG8_BAR; PG8_SCHED;
            PG8_LDB(B1, 0, 1); PG8_STAGE(PG8_SB(0, 0), b2, voffB);
            PG8_BAR; PG8_WAIT_L(0); PG8_MMA(0, 1, At, B1); PG8_BAR;
            PG8_LDA(At, 0, 1); PG8_STAGE(PG8_SA(0, 0), a2, voffA);
            PG8_BAR; PG8_WAIT_L(0); PG8_MMA(1, 0, At, B0); PG8_BAR; PG8_SCHED;
            PG8_STAGE(PG8_SB(0, 1), b2 + hstepB, voffB);
            PG8_WAIT_V(6); PG8_BAR; PG8_MMA(1, 1, At, B1); PG8_BAR;
            PG8_LDB(B0, 1, 0); PG8_SCHED; PG8_LDA(At, 1, 0); PG8_STAGE(PG8_SA(0, 1), a2 + hstep, voffA);
            PG8_WAIT_L(8); PG8_BAR; PG8_WAIT_L(0); PG8_MMA(0, 0, At, B0); PG8_BAR; PG8_SCHED;
            PG8_LDB(B1, 1, 1); PG8_STAGE(PG8_SB(1, 0), b3, voffB);
            PG8_BAR; PG8_WAIT_L(0); PG8_MMA(0, 1, At, B1); PG8_BAR;
            PG8_LDA(At, 1, 1); PG8_STAGE(PG8_SA(1, 0), a3, voffA);
            PG8_BAR; PG8_WAIT_L(0); PG8_MMA(1, 0, At, B0); PG8_BAR; PG8_SCHED;
            PG8_STAGE(PG8_SB(1, 1), b3 + hstepB, voffB);
            PG8_WAIT_V(6); PG8_BAR; PG8_MMA(1, 1, At, B1); PG8_BAR;
            }
        }
        if constexpr (ALIGN_EPI) { if (wr == 0) PG8_BAR; }
        if constexpr (!Epi::AFTER_DRAIN) { E(acc, cur, wr, wc, fr, fq); S.done(cur); }
        if (!has_next) break;
#pragma unroll
        for (int a = 0; a < 2; ++a)
#pragma unroll
            for (int b = 0; b < 2; ++b)
#pragma unroll
                for (int m = 0; m < 4; ++m)
#pragma unroll
                    for (int n = 0; n < 2; ++n) acc[a][b][m][n] = (f32x4){0.f, 0.f, 0.f, 0.f};
        cur = nxt; cA = nA; cB = nB; ++ui;
        if constexpr (ALIGN_EPI) { if (wr == 1) PG8_BAR; }
    }
    PG8_WAIT_V(0);
    if constexpr (!ALIGN_EPI) { if (wr == 0) PG8_BAR; }
    PG8_BAR;
    if constexpr (Epi::AFTER_DRAIN) { E.fused(acc, cur, wr, wc, fr, fq, lds, wid, lane); S.done(cur); }
#undef PG8_SA
#undef PG8_SB
#undef PG8_STAGE
#undef PG8_LDA
#undef PG8_LDB
#undef PG8_MMA
#undef PG8_WAIT_V
#undef PG8_WAIT_L
#undef PG8_BAR
#undef PG8_SCHED
}
}

#define LAS __attribute__((address_space(3)))
typedef unsigned short bf16;
typedef short bf16x8 __attribute__((ext_vector_type(8)));
typedef float f32x4 __attribute__((ext_vector_type(4)));
typedef float f32x2 __attribute__((ext_vector_type(2)));
typedef float f32x16 __attribute__((ext_vector_type(16)));
typedef unsigned u32x4 __attribute__((ext_vector_type(4)));
typedef unsigned u32x2 __attribute__((ext_vector_type(2)));

constexpr int NWAVES = 8, NTHR = 512;
constexpr int NLAT = 65536, NCTX = 8192, R = NLAT + NCTX;
constexpr int D = 1024, FF = 4096, KV = 2304;
constexpr float EPS = 1e-6f, LOG2E = 1.4426950408889634f;
constexpr size_t MiB = 1u << 20;
constexpr size_t WS_MOD = 0, WS_W = 4 * MiB, WS_XCTX = 100 * MiB, WS_H = 132 * MiB, WS_R = 276 * MiB, WS_CTL = 996 * MiB, WS_SSQ = 997 * MiB, WS_SHB = 998 * MiB, WS_SHW = 1002 * MiB, WS_SSQM = 1007 * MiB, WS_END = 1008 * MiB;
constexpr size_t CTL_BYTES = 16384;
constexpr int MISC_OFF = 147456 - 64;
constexpr int LDS_BYTES = 147456;
constexpr int RAWP = 1792;
constexpr int MQP = 1536;

__device__ __forceinline__ unsigned f2bf(float f) { unsigned u = __builtin_bit_cast(unsigned, f); return (u + 0x7fffu + ((u >> 16) & 1u)) >> 16; }
__device__ __forceinline__ unsigned pk2(float lo, float hi) { return f2bf(lo) | (f2bf(hi) << 16); }
typedef __bf16 bf16x2_t __attribute__((ext_vector_type(2)));
__device__ __forceinline__ unsigned cvtpk_nv(float lo, float hi) { f32x2 v = {lo, hi}; bf16x2_t b = __builtin_convertvector(v, bf16x2_t); return __builtin_bit_cast(unsigned, b); }
__device__ __forceinline__ float bflo(unsigned u) { return __builtin_bit_cast(float, u << 16); }
__device__ __forceinline__ float bfhi(unsigned u) { return __builtin_bit_cast(float, u & 0xffff0000u); }
__device__ __forceinline__ float shx(float v, int o, int lane) { return __builtin_bit_cast(float, __builtin_amdgcn_ds_bpermute((lane ^ o) << 2, __builtin_bit_cast(int, v))); }
__device__ __forceinline__ float wave_sum(float v, int lane) {
#pragma unroll
    for (int o = 1; o < 64; o <<= 1) v += shx(v, o, lane);
    return v;
}
__device__ __forceinline__ float wave_max(float v, int lane) {
#pragma unroll
    for (int o = 1; o < 64; o <<= 1) v = fmaxf(v, shx(v, o, lane));
    return v;
}
__device__ __forceinline__ void cs_of(float a, float& c, float& s) {
    double rev = (double)a * 0.15915494309189535; rev -= floor(rev); const float rf = (float)rev;
    c = __builtin_amdgcn_cosf(rf); s = __builtin_amdgcn_sinf(rf);
}

__device__ __forceinline__ void xpose_item(const float* W, int srcN, int scol, bf16* WT, int K, int drow, LAS float* scr, int k0, int lane) {
#pragma unroll 8
    for (int i = 0; i < 32; ++i) { const int kk = 2 * i + (lane >> 5); scr[kk * 33 + (lane & 31)] = W[(size_t)(k0 + kk) * srcN + scol + (lane & 31)]; }
    asm volatile("s_waitcnt lgkmcnt(0)" ::: "memory");
    const int c = lane & 7;
#pragma unroll
    for (int j = 0; j < 4; ++j) { const int n = (lane >> 3) + 8 * j; const LAS float* s = scr + (8 * c) * 33 + n;
        u32x4 o; o.x = pk2(s[0 * 33], s[1 * 33]); o.y = pk2(s[2 * 33], s[3 * 33]); o.z = pk2(s[4 * 33], s[5 * 33]); o.w = pk2(s[6 * 33], s[7 * 33]);
        *(u32x4*)(WT + (size_t)(drow + n) * K + k0 + 8 * c) = o; }
    asm volatile("s_waitcnt lgkmcnt(0)" ::: "memory");
}
__device__ __forceinline__ void xpose_seg(const float* W, int K, int srcN, int scol0, int ncols, bool hs, bf16* WT, int drow0, LAS float* scr, int gw, int NGW, int& cur, int lane) {
    const int nblk = ncols / 32, nit = (K / 64) * nblk;
    int it = gw - cur; if (it < 0) it += NGW;
    for (; it < nit; it += NGW) { const int kb = it / nblk, nb = it % nblk; const int sc = scol0 + (hs ? ((nb >> 1) * 128 + (nb & 1) * 32) : nb * 32);
        xpose_item(W, srcN, sc, WT, K, drow0 + nb * 32, scr, kb * 64, lane); }
    cur = (cur + nit) % NGW;
}
__device__ __forceinline__ void zero_rows(bf16* WT, int K, int row0, int nrows, int gw, int NGW, int lane) {
    const int n16 = nrows * K / 8; u32x4* p = (u32x4*)(WT + (size_t)row0 * K); const u32x4 z = {0u, 0u, 0u, 0u};
    for (int i = gw * 64 + lane; i < n16; i += NGW * 64) p[i] = z;
}

__device__ __forceinline__ void norm_phase(const float* xlat, const float* xctx, const float* g, const float* modl, int sh_off, int sc_off, bf16* H, int vcu, int NGW, int wave_s) {
    const int lane = fresh_lane(); const int gw = vcu * NWAVES + wave_s;
    f32x4 g4[4];
#pragma unroll
    for (int j = 0; j < 4; ++j) g4[j] = *(const f32x4*)(g + 256 * j + 4 * lane);
    for (int r0 = gw; r0 < R; r0 += 2 * NGW) {
        const int r1 = r0 + NGW; const bool has1 = r1 < R;
        const float* xr0 = (r0 < NLAT) ? xlat + (size_t)r0 * D : xctx + (size_t)(r0 - NLAT) * D;
        const float* xr1 = has1 ? ((r1 < NLAT) ? xlat + (size_t)r1 * D : xctx + (size_t)(r1 - NLAT) * D) : xr0;
        f32x4 v0[4], v1[4]; float s0 = 0.f, s1 = 0.f;
#pragma unroll
        for (int j = 0; j < 4; ++j) { v0[j] = *(const f32x4*)(xr0 + 256 * j + 4 * lane); v1[j] = *(const f32x4*)(xr1 + 256 * j + 4 * lane); }
#pragma unroll
        for (int j = 0; j < 4; ++j) { s0 += (v0[j].x * v0[j].x + v0[j].y * v0[j].y) + (v0[j].z * v0[j].z + v0[j].w * v0[j].w); s1 += (v1[j].x * v1[j].x + v1[j].y * v1[j].y) + (v1[j].z * v1[j].z + v1[j].w * v1[j].w); }
        const float ri0 = 1.0f / sqrtf(wave_sum(s0, lane) * (1.0f / D) + EPS), ri1 = 1.0f / sqrtf(wave_sum(s1, lane) * (1.0f / D) + EPS);
        const float* mp0 = modl + ((r0 < NLAT) ? (r0 >> 11) : 32) * 6144; const float* mp1 = modl + ((r1 < NLAT) ? (r1 >> 11) : 32) * 6144;
#pragma unroll
        for (int j = 0; j < 4; ++j) { const int c = 256 * j + 4 * lane; const f32x4 sc = *(const f32x4*)(mp0 + sc_off + c), sh = *(const f32x4*)(mp0 + sh_off + c);
            const f32x4 y = (v0[j] * ri0 * g4[j]) * (sc + 1.0f) + sh; u32x2 w; w.x = pk2(y.x, y.y); w.y = pk2(y.z, y.w);
            *(u32x2*)(H + (size_t)r0 * D + c) = w; }
        if (has1) {
#pragma unroll
            for (int j = 0; j < 4; ++j) { const int c = 256 * j + 4 * lane; const f32x4 sc = *(const f32x4*)(mp1 + sc_off + c), sh = *(const f32x4*)(mp1 + sh_off + c);
                const f32x4 y = (v1[j] * ri1 * g4[j]) * (sc + 1.0f) + sh; u32x2 w; w.x = pk2(y.x, y.y); w.y = pk2(y.z, y.w);
                *(u32x2*)(H + (size_t)r1 * D + c) = w; }
        }
    }
}
__device__ __forceinline__ void prep_phase(const float* xlat, const float* xctx, const float* g, const float* modl, int sc_off, bf16* AP, float* ssq, int vcu, int NGW, int wave_s) {
    const int lane = fresh_lane(); const int gw = vcu * NWAVES + wave_s;
    f32x4 g4[4];
#pragma unroll
    for (int j = 0; j < 4; ++j) g4[j] = *(const f32x4*)(g + 256 * j + 4 * lane);
    for (int r0 = gw; r0 < R; r0 += 2 * NGW) {
        const int r1 = r0 + NGW; const bool has1 = r1 < R;
        const float* xr0 = (r0 < NLAT) ? xlat + (size_t)r0 * D : xctx + (size_t)(r0 - NLAT) * D;
        const float* xr1 = has1 ? ((r1 < NLAT) ? xlat + (size_t)r1 * D : xctx + (size_t)(r1 - NLAT) * D) : xr0;
        f32x4 v0[4], v1[4]; float s0 = 0.f, s1 = 0.f;
#pragma unroll
        for (int j = 0; j < 4; ++j) { v0[j] = *(const f32x4*)(xr0 + 256 * j + 4 * lane); v1[j] = *(const f32x4*)(xr1 + 256 * j + 4 * lane); }
#pragma unroll
        for (int j = 0; j < 4; ++j) { s0 += (v0[j].x * v0[j].x + v0[j].y * v0[j].y) + (v0[j].z * v0[j].z + v0[j].w * v0[j].w); s1 += (v1[j].x * v1[j].x + v1[j].y * v1[j].y) + (v1[j].z * v1[j].z + v1[j].w * v1[j].w); }
        s0 = wave_sum(s0, lane); s1 = wave_sum(s1, lane);
        const float* mp0 = modl + ((r0 < NLAT) ? (r0 >> 11) : 32) * 6144; const float* mp1 = modl + ((r1 < NLAT) ? (r1 >> 11) : 32) * 6144;
#pragma unroll
        for (int j = 0; j < 4; ++j) { const int c = 256 * j + 4 * lane; const f32x4 sc = *(const f32x4*)(mp0 + sc_off + c);
            const f32x4 y = (v0[j] * g4[j]) * (sc + 1.0f); u32x2 w; w.x = pk2(y.x, y.y); w.y = pk2(y.z, y.w);
            *(u32x2*)(AP + (size_t)r0 * D + c) = w; }
        if (lane == 0) ssq[r0] = s0;
        if (has1) {
#pragma unroll
            for (int j = 0; j < 4; ++j) { const int c = 256 * j + 4 * lane; const f32x4 sc = *(const f32x4*)(mp1 + sc_off + c);
                const f32x4 y = (v1[j] * g4[j]) * (sc + 1.0f); u32x2 w; w.x = pk2(y.x, y.y); w.y = pk2(y.z, y.w);
                *(u32x2*)(AP + (size_t)r1 * D + c) = w; }
            if (lane == 0) ssq[r1] = s1;
        }
    }
}
__device__ __forceinline__ void zero_f32(float* p, int n, int vcu, int NGW, int wave_s) {
    const int lane = fresh_lane(); const int gw = vcu * NWAVES + wave_s;
    for (int i = gw * 64 + lane; i < n; i += NGW * 64) p[i] = 0.f;
}
__device__ __forceinline__ void mlanorm_phase(const bf16* MRAW, const float* gq, const float* gkv, bf16* QCn, bf16* KVCn, int vcu, int NGW, int wave_s) {
    const int lane = fresh_lane(); const int gw = vcu * NWAVES + wave_s;
    u32x4 na = {0u, 0u, 0u, 0u}; u32x2 nb = {0u, 0u};
    if (gw < R) { na = *(const u32x4*)(MRAW + (size_t)gw * 1024 + 8 * lane); nb = *(const u32x2*)(MRAW + (size_t)gw * 1024 + 512 + 4 * lane); }
    for (int r = gw; r < R; r += NGW) {
        const bf16* row = MRAW + (size_t)r * 1024;
        const u32x4 a = na; const u32x2 b = nb;
        if (r + NGW < R) { na = *(const u32x4*)(row + (size_t)NGW * 1024 + 8 * lane); nb = *(const u32x2*)(row + (size_t)NGW * 1024 + 512 + 4 * lane); }
        float x[8] = {bflo(a.x), bfhi(a.x), bflo(a.y), bfhi(a.y), bflo(a.z), bfhi(a.z), bflo(a.w), bfhi(a.w)}; float y[4] = {bflo(b.x), bfhi(b.x), bflo(b.y), bfhi(b.y)};
        float s1 = 0.f, s2 = 0.f;
#pragma unroll
        for (int e = 0; e < 8; ++e) s1 += x[e] * x[e];
#pragma unroll
        for (int e = 0; e < 4; ++e) s2 += y[e] * y[e];
        const float r1 = 1.0f / sqrtf(wave_sum(s1, lane) * (1.0f / 512) + EPS), r2 = 1.0f / sqrtf(wave_sum(s2, lane) * (1.0f / 256) + EPS);
        const f32x4 g0 = *(const f32x4*)(gq + 8 * lane), g1 = *(const f32x4*)(gq + 8 * lane + 4), g2 = *(const f32x4*)(gkv + 4 * lane);
        u32x4 o; o.x = pk2(x[0] * r1 * g0.x, x[1] * r1 * g0.y); o.y = pk2(x[2] * r1 * g0.z, x[3] * r1 * g0.w); o.z = pk2(x[4] * r1 * g1.x, x[5] * r1 * g1.y); o.w = pk2(x[6] * r1 * g1.z, x[7] * r1 * g1.w);
        *(u32x4*)(QCn + (size_t)r * 512 + 8 * lane) = o;
        u32x2 p; p.x = pk2(y[0] * r2 * g2.x, y[1] * r2 * g2.y); p.y = pk2(y[2] * r2 * g2.z, y[3] * r2 * g2.w);
        *(u32x2*)(KVCn + (size_t)r * 256 + 4 * lane) = p;
    }
}
__device__ __forceinline__ void post_even(bf16* RAW, const float* gdq, const float* gdk, const float* ggq, const float* ggk, int vcu, int NGW, int wave_s) {
    const int lane = fresh_lane(); const int gw = vcu * NWAVES + wave_s;
    const int sub = lane & 15; const float L2T = 13.287712379549449f;
    float invf[4];
#pragma unroll
    for (int e = 0; e < 4; ++e) { const int jj = 4 * (sub & 7) + e; invf[e] = exp2f(-(float)(jj & 15) * (1.0f / 16.0f) * L2T); }
    f32x4 G[4]; G[0] = *(const f32x4*)(gdq + 4 * sub); G[1] = *(const f32x4*)(gdk + 4 * sub); G[2] = *(const f32x4*)(ggq + 4 * sub); G[3] = *(const f32x4*)(ggk + 4 * sub);
    u32x2 nx[7];
    if (gw < R) {
#pragma unroll
        for (int c = 0; c < 7; ++c) if (c == 2 || c == 3 || c == 6) nx[c] = *(const u32x2*)(RAW + (size_t)gw * RAWP + 256 * c + 4 * lane); }
    for (int r = gw; r < R; r += NGW) {
        const bool isl = r < NLAT; const int t = r & 2047; const float prow = (float)(t >> 6), pcol = (float)(t & 63);
        float cs[4], sn[4];
#pragma unroll
        for (int e = 0; e < 4; ++e) { if (isl) { const int jj = 4 * (sub & 7) + e; cs_of((jj < 16 ? prow : pcol) * invf[e], cs[e], sn[e]); } else { cs[e] = 1.f; sn[e] = 0.f; } }
        bf16* row = RAW + (size_t)r * RAWP;
        u32x2 av[7];
#pragma unroll
        for (int c = 0; c < 7; ++c) if (c == 2 || c == 3 || c == 6) av[c] = nx[c];
        if (r + NGW < R) {
#pragma unroll
            for (int c = 0; c < 7; ++c) if (c == 2 || c == 3 || c == 6) nx[c] = *(const u32x2*)(row + (size_t)NGW * RAWP + 256 * c + 4 * lane); }
#pragma unroll
        for (int c = 0; c < 7; ++c) { if (!(c == 2 || c == 3 || c == 6)) continue;
            const u32x2 a = av[c];
            float x[4] = {bflo(a.x), bfhi(a.x), bflo(a.y), bfhi(a.y)};
            float ss = (x[0] * x[0] + x[1] * x[1]) + (x[2] * x[2] + x[3] * x[3]);
            ss += shx(ss, 1, lane); ss += shx(ss, 2, lane); ss += shx(ss, 4, lane); ss += shx(ss, 8, lane);
            const float rinv = 1.0f / sqrtf(ss * (1.0f / 64) + EPS);
            const f32x4 g4 = G[c < 2 ? 0 : (c < 4 ? 1 : (c < 6 ? 2 : 3))];
            const float qs = (c < 2 || c == 4 || c == 5) ? 0.125f * LOG2E : 1.0f;
            float y[4] = {x[0] * rinv * g4.x, x[1] * rinv * g4.y, x[2] * rinv * g4.z, x[3] * rinv * g4.w}; float o[4];
#pragma unroll
            for (int e = 0; e < 4; ++e) { const float py = shx(y[e], 8, lane); o[e] = ((sub < 8) ? (y[e] * cs[e] - py * sn[e]) : (y[e] * cs[e] + py * sn[e])) * qs; }
            u32x2 w; w.x = pk2(o[0], o[1]); w.y = pk2(o[2], o[3]);
            *(u32x2*)(row + 256 * c + 4 * lane) = w;
        }
    }
}
__device__ __forceinline__ void post_mla(bf16* Q, bf16* Kb, const bf16* MRAW, const float* gq, const float* gk, int vcu, int NGW, int wave_s) {
    const int lane = fresh_lane(); const int gw = vcu * NWAVES + wave_s;
    const int i = lane & 31, half = lane >> 5; const float L2T = 13.287712379549449f;
    float invf[2];
#pragma unroll
    for (int e = 0; e < 2; ++e) { const int jj = (2 * i + e) & 15; invf[e] = exp2f(-(float)(jj & 7) * (1.0f / 8.0f) * L2T); }
    const f32x2 gqa = *(const f32x2*)(gq + 2 * i), gqb = *(const f32x2*)(gq + 64 + 2 * (i & 15)), gka = *(const f32x2*)(gk + 2 * i), gkb = *(const f32x2*)(gk + 64 + 2 * (i & 15));
    const float qs = 0.10206207261596577f * LOG2E;
    unsigned na[2][8], nb[8], nkr = 0u;
#define MLA_LOAD(rr) do { _Pragma("unroll") for (int p = 0; p < 8; ++p) { na[0][p] = 0u; na[1][p] = *(const unsigned*)(Kb + (size_t)(rr) * MQP + (2 * p + half) * 96 + 2 * i); nb[p] = 0u; } \
        nkr = (i < 16) ? *(const unsigned*)(MRAW + (size_t)(rr) * 32 + 2 * i) : 0u; } while (0)
    if (gw < R) MLA_LOAD(gw);
    for (int r = gw; r < R; r += NGW) {
        const bool isl = r < NLAT; const int t = r & 2047; const float prow = (float)(t >> 6), pcol = (float)(t & 63);
        float cs[2], sn[2];
#pragma unroll
        for (int e = 0; e < 2; ++e) { if (isl) { const int jj = (2 * i + e) & 15; cs_of((jj < 8 ? prow : pcol) * invf[e], cs[e], sn[e]); } else { cs[e] = 1.f; sn[e] = 0.f; } }
        unsigned la[2][8], lb[8];
#pragma unroll
        for (int p = 0; p < 8; ++p) { la[0][p] = na[0][p]; la[1][p] = na[1][p]; lb[p] = nb[p]; }
        const unsigned krw = nkr;
        if (r + NGW < R) { const int rn = r + NGW; MLA_LOAD(rn); }
#pragma unroll
        for (int isk = 1; isk < 2; ++isk) {
            bf16* base = (isk ? Kb : Q) + (size_t)r * MQP; const f32x2 ga = isk ? gka : gqa, gb = isk ? gkb : gqb; const float sc = isk ? 1.0f : qs;
#pragma unroll
            for (int p = 0; p < 8; ++p) {
                bf16* hp = base + (2 * p + half) * 96;
                const unsigned a = la[isk][p];
                const unsigned b = isk ? krw : lb[p];
                const float a0 = bflo(a), a1 = bfhi(a), b0 = bflo(b), b1 = bfhi(b);
                float ss = (a0 * a0 + a1 * a1) + (b0 * b0 + b1 * b1);
                ss += shx(ss, 1, lane); ss += shx(ss, 2, lane); ss += shx(ss, 4, lane); ss += shx(ss, 8, lane); ss += shx(ss, 16, lane);
                const float rinv = 1.0f / sqrtf(ss * (1.0f / 96) + EPS);
                const float y0 = b0 * rinv * gb.x, y1 = b1 * rinv * gb.y; const float p0 = shx(y0, 8, lane), p1 = shx(y1, 8, lane);
                const float o0 = (i < 8) ? (y0 * cs[0] - p0 * sn[0]) : (y0 * cs[0] + p0 * sn[0]);
                const float o1 = (i < 8) ? (y1 * cs[1] - p1 * sn[1]) : (y1 * cs[1] + p1 * sn[1]);
                *(unsigned*)(hp + 2 * i) = pk2(a0 * rinv * ga.x * sc, a1 * rinv * ga.y * sc);
                if (i < 16) *(unsigned*)(hp + 64 + 2 * i) = pk2(o0 * sc, o1 * sc);
            }
        }
    }
}

#undef MLA_LOAD
template <int DQK>
__device__ __forceinline__ void q_prep(bf16x8 (&qf)[DQK / 16], const float* gq, int row, float qs, int lane) {
    constexpr int NKS = DQK / 16; const int hh = lane >> 5; const float L2T = 13.287712379549449f;
    float x[NKS][8]; float ss = 0.f;
#pragma unroll
    for (int ks = 0; ks < NKS; ++ks)
#pragma unroll
        for (int e = 0; e < 8; ++e) { x[ks][e] = __builtin_bit_cast(float, ((unsigned)(unsigned short)qf[ks][e]) << 16); ss += x[ks][e] * x[ks][e]; }
    ss += shx(ss, 32, lane);
    const float rinv = 1.0f / sqrtf(ss * (1.0f / DQK) + EPS);
#pragma unroll
    for (int ks = 0; ks < NKS; ++ks) { const f32x4 g0 = *(const f32x4*)(gq + 16 * ks + 8 * hh), g1 = *(const f32x4*)(gq + 16 * ks + 8 * hh + 4);
        x[ks][0] *= rinv * g0.x; x[ks][1] *= rinv * g0.y; x[ks][2] *= rinv * g0.z; x[ks][3] *= rinv * g0.w; x[ks][4] *= rinv * g1.x; x[ks][5] *= rinv * g1.y; x[ks][6] *= rinv * g1.z; x[ks][7] *= rinv * g1.w; }
    if (row < NLAT) { const int t = row & 2047; const float prow = (float)(t >> 6), pcol = (float)(t & 63);
        if (DQK == 64) {
#pragma unroll
            for (int e = 0; e < 8; ++e) { const float invf = exp2f(-(float)(8 * hh + e) * (1.0f / 16.0f) * L2T); float c0, s0, c1, s1; cs_of(prow * invf, c0, s0); cs_of(pcol * invf, c1, s1);
                const float a0 = x[0][e], b0 = x[2][e], a1 = x[1][e], b1 = x[3][e];
                x[0][e] = a0 * c0 - b0 * s0; x[2][e] = b0 * c0 + a0 * s0; x[1][e] = a1 * c1 - b1 * s1; x[3][e] = b1 * c1 + a1 * s1; }
        } else {
#pragma unroll
            for (int e = 0; e < 8; ++e) { const float invf = exp2f(-(float)e * (1.0f / 8.0f) * L2T); float c, s; cs_of((hh ? pcol : prow) * invf, c, s);
                const float a = x[NKS - 2][e], b = x[NKS - 1][e]; x[NKS - 2][e] = a * c - b * s; x[NKS - 1][e] = b * c + a * s; }
        } }
#pragma unroll
    for (int ks = 0; ks < NKS; ++ks) { u32x4 w; w.x = pk2(x[ks][0] * qs, x[ks][1] * qs); w.y = pk2(x[ks][2] * qs, x[ks][3] * qs); w.z = pk2(x[ks][4] * qs, x[ks][5] * qs); w.w = pk2(x[ks][6] * qs, x[ks][7] * qs);
        qf[ks] = __builtin_bit_cast(bf16x8, w); }
}
template <int DQK, int DV, bool PIPE>
__device__ __forceinline__ void attn_pass(LAS unsigned char* lds, const bf16* Qw, int qpitch, const bf16* Kctx, const bf16* Klat, int kpitch, const bf16* VT, int ntiles, const float* gq, int qrow0, float qs,
                                          f32x16 (&o)[DV / 32], float& lsum, const int wave_s) {
    constexpr int KSTR = DQK * 2 + 16, VSTR = 144, KBYTES = 64 * KSTR, VBYTES = DV * VSTR, KC = DQK / 8, NKS = DQK / 16, NDB = DV / 32, NV = 4 * NDB;
    const int lane = fresh_lane(), tid = wave_s * 64 + lane, i = lane & 31, hh = lane >> 5;
    bf16x8 qf[NKS];
#pragma unroll
    for (int ks = 0; ks < NKS; ++ks) qf[ks] = *(const bf16x8*)(Qw + (size_t)i * qpitch + 16 * ks + 8 * hh);
    q_prep<DQK>(qf, gq, qrow0 + i, qs, lane);
#pragma unroll
    for (int db = 0; db < NDB; ++db)
#pragma unroll
        for (int r = 0; r < 16; ++r) o[db][r] = 0.f;
    lsum = 0.f;
    const int kc0 = tid, kc1 = tid + 512; const bool k2 = (DQK == 96) && (tid < 256);
    const int kr0 = kc0 / KC, kcc0 = kc0 % KC, kr1 = kc1 / KC, kcc1 = kc1 % KC;
    const int vd0 = tid >> 3, vc0 = tid & 7;
    u32x4 kreg0, kreg1 = {0u, 0u, 0u, 0u}, vreg0, vreg1 = {0u, 0u, 0u, 0u};
    constexpr bool TPB2 = (!PIPE) && (NV == 8);
    LAS unsigned char* const Kl = lds; LAS unsigned char* const Vl = lds + (TPB2 ? 4 : 2) * KBYTES;
    const int kfo = i * KSTR + 16 * hh, vfo = i * VSTR + 16 * hh;
    const unsigned koff0 = (unsigned)(kr0 * kpitch + 8 * kcc0) * 2u, koff1 = (unsigned)(kr1 * kpitch + 8 * kcc1) * 2u;
    const unsigned voff0 = (unsigned)(vd0 * KV + 8 * vc0) * 2u, voff1 = (unsigned)((vd0 + 64) * KV + 8 * vc0) * 2u;
#define AT_LOADK(t) do { const char* kt = (const char*)(((t) < 4) ? Kctx + (size_t)(64 * (t)) * kpitch : Klat + (size_t)(64 * ((t) - 4)) * kpitch); \
        kreg0 = *(const u32x4*)(kt + koff0); if (k2) kreg1 = *(const u32x4*)(kt + koff1); } while (0)
#define AT_LOADV(t) do { const char* vt_ = (const char*)(VT + 64 * (t)); vreg0 = *(const u32x4*)(vt_ + voff0); if (DV == 128) vreg1 = *(const u32x4*)(vt_ + voff1); } while (0)
#define AT_WRITEK(bufi) do { LAS unsigned char* kb_ = Kl + (bufi) * KBYTES; *(LAS u32x4*)(kb_ + kr0 * KSTR + 16 * kcc0) = kreg0; if (k2) *(LAS u32x4*)(kb_ + kr1 * KSTR + 16 * kcc1) = kreg1; } while (0)
#define AT_WRITEV(bufi) do { LAS unsigned char* vb_ = Vl + (bufi) * VBYTES; *(LAS u32x4*)(vb_ + vd0 * VSTR + 16 * vc0) = vreg0; if (DV == 128) *(LAS u32x4*)(vb_ + (vd0 + 64) * VSTR + 16 * vc0) = vreg1; } while (0)
    u32x4 kregB0, kregB1 = {0u, 0u, 0u, 0u}, vregB0;
#define AT_LOADKB(t) do { const char* kt = (const char*)(((t) < 4) ? Kctx + (size_t)(64 * (t)) * kpitch : Klat + (size_t)(64 * ((t) - 4)) * kpitch); \
        kregB0 = *(const u32x4*)(kt + koff0); if (k2) kregB1 = *(const u32x4*)(kt + koff1); } while (0)
#define AT_LOADVB(t) do { const char* vt_ = (const char*)(VT + 64 * (t)); vregB0 = *(const u32x4*)(vt_ + voff0); } while (0)
#define AT_WRITEKB(bufi) do { LAS unsigned char* kb_ = Kl + (bufi) * KBYTES; *(LAS u32x4*)(kb_ + kr0 * KSTR + 16 * kcc0) = kregB0; if (k2) *(LAS u32x4*)(kb_ + kr1 * KSTR + 16 * kcc1) = kregB1; } while (0)
#define AT_WRITEVB(bufi) do { LAS unsigned char* vb_ = Vl + (bufi) * VBYTES; *(LAS u32x4*)(vb_ + vd0 * VSTR + 16 * vc0) = vregB0; } while (0)
#define AT_KFRAGS(bufi) do { const LAS unsigned char* Kb = Kl + (bufi) * KBYTES + kfo; \
        _Pragma("unroll") for (int ks = 0; ks < NKS; ++ks) { kf[2 * ks] = *(const LAS bf16x8*)(Kb + 32 * ks); kf[2 * ks + 1] = *(const LAS bf16x8*)(Kb + 32 * KSTR + 32 * ks); } } while (0)
#define AT_QKM(P0, P1) do { _Pragma("unroll") for (int r = 0; r < 16; ++r) { P0[r] = 0.f; P1[r] = 0.f; } \
        _Pragma("unroll") for (int ks = 0; ks < NKS; ++ks) { P0 = __builtin_amdgcn_mfma_f32_32x32x16_bf16(kf[2 * ks], qf[ks], P0, 0, 0, 0); \
            P1 = __builtin_amdgcn_mfma_f32_32x32x16_bf16(kf[2 * ks + 1], qf[ks], P1, 0, 0, 0); } } while (0)
#define AT_VFRAGS(dst, m0, bufi) do { const LAS unsigned char* Vb = Vl + (bufi) * VBYTES + vfo; \
        _Pragma("unroll") for (int m = 0; m < 8; ++m) { const int s_ = ((m0) + m) / NDB, db_ = ((m0) + m) % NDB; dst[m] = *(const LAS bf16x8*)(Vb + 32 * db_ * VSTR + 32 * s_); } } while (0)
#define AT_PVM(src, m0) do { _Pragma("unroll") for (int m = 0; m < 8; ++m) { const int s_ = ((m0) + m) / NDB, db_ = ((m0) + m) % NDB; \
        o[db_] = __builtin_amdgcn_mfma_f32_32x32x16_bf16(src[m], pf[s_], o[db_], 0, 0, 0); } } while (0)
    f32x16 p0, p1, n0, n1; bf16x8 kf[2 * NKS], vfa[8], pf[4];
    if (PIPE) {
        AT_LOADK(0); AT_LOADV(0); AT_WRITEK(0); AT_WRITEV(0);
        AT_LOADK(1);
        __syncthreads();
        AT_KFRAGS(0); AT_QKM(p0, p1);
        AT_WRITEK(1);
        if (2 < ntiles) AT_LOADK(2);
        AT_LOADV(1);
        __syncthreads();
    } else if (TPB2) {
        AT_LOADK(0); AT_LOADV(0); AT_LOADKB(1); AT_LOADVB(1); AT_WRITEK(0); AT_WRITEV(0); AT_WRITEKB(1); AT_WRITEVB(1);
        AT_LOADK(2); AT_LOADV(2); AT_LOADKB(3); AT_LOADVB(3);
        __syncthreads();
    } else {
        AT_LOADK(0); AT_LOADV(0); AT_WRITEK(0); AT_WRITEV(0);
        AT_LOADK(1); AT_LOADV(1);
        __syncthreads();
    }
#define AT_BODY(HASNEXT, C0, C1, N0, N1, TT) do { const int t = (TT); \
        if (PIPE) { if (HASNEXT) AT_KFRAGS((t + 1) & 1); } else AT_KFRAGS(t & 1); \
        AT_VFRAGS(vfa, 0, t & 1); \
        __builtin_amdgcn_sched_barrier(0); \
        if (!PIPE) AT_QKM(C0, C1); \
        float ls = 0.f; \
        _Pragma("unroll") for (int r = 0; r < 16; ++r) { C0[r] = __builtin_amdgcn_exp2f(C0[r]); C1[r] = __builtin_amdgcn_exp2f(C1[r]); ls += C0[r] + C1[r]; } \
        lsum += ls; \
        { u32x4 w; \
          w.x = cvtpk_nv(C0[0], C0[1]); w.y = cvtpk_nv(C0[2], C0[3]); w.z = cvtpk_nv(C0[4], C0[5]); w.w = cvtpk_nv(C0[6], C0[7]); pf[0] = __builtin_bit_cast(bf16x8, w); \
          w.x = cvtpk_nv(C0[8], C0[9]); w.y = cvtpk_nv(C0[10], C0[11]); w.z = cvtpk_nv(C0[12], C0[13]); w.w = cvtpk_nv(C0[14], C0[15]); pf[1] = __builtin_bit_cast(bf16x8, w); \
          w.x = cvtpk_nv(C1[0], C1[1]); w.y = cvtpk_nv(C1[2], C1[3]); w.z = cvtpk_nv(C1[4], C1[5]); w.w = cvtpk_nv(C1[6], C1[7]); pf[2] = __builtin_bit_cast(bf16x8, w); \
          w.x = cvtpk_nv(C1[8], C1[9]); w.y = cvtpk_nv(C1[10], C1[11]); w.z = cvtpk_nv(C1[12], C1[13]); w.w = cvtpk_nv(C1[14], C1[15]); pf[3] = __builtin_bit_cast(bf16x8, w); } \
        if (PIPE && (HASNEXT)) AT_QKM(N0, N1); \
        if (NV == 16) { __builtin_amdgcn_sched_barrier(0); AT_VFRAGS(kf, 8, t & 1); __builtin_amdgcn_sched_barrier(0); __builtin_amdgcn_s_setprio(1); AT_PVM(vfa, 0); AT_PVM(kf, 8); __builtin_amdgcn_s_setprio(0); } \
        else { __builtin_amdgcn_s_setprio(1); AT_PVM(vfa, 0); __builtin_amdgcn_s_setprio(0); } \
        if (PIPE) { if (t + 2 < ntiles) AT_WRITEK(t & 1); if (t + 1 < ntiles) AT_WRITEV((t + 1) & 1); if (t + 3 < ntiles) AT_LOADK(t + 3); if (t + 2 < ntiles) AT_LOADV(t + 2); } \
        else { if (t + 1 < ntiles) { AT_WRITEK((t + 1) & 1); AT_WRITEV((t + 1) & 1); } if (t + 2 < ntiles) { AT_LOADK(t + 2); AT_LOADV(t + 2); } } \
        __syncthreads(); \
    } while (0)
    int tt = 0;
    if (PIPE) {
        for (; tt < ntiles - 2; tt += 2) { AT_BODY(true, p0, p1, n0, n1, tt); AT_BODY(true, n0, n1, p0, p1, tt + 1); }
        AT_BODY(true, p0, p1, n0, n1, tt); AT_BODY(false, n0, n1, p0, p1, tt + 1);
    } else {
        if (TPB2) {
#define AT_SUB(slot) do { AT_KFRAGS(slot); AT_VFRAGS(vfa, 0, slot); __builtin_amdgcn_sched_barrier(0); AT_QKM(p0, p1); \
            float ls = 0.f; _Pragma("unroll") for (int r = 0; r < 16; ++r) { p0[r] = __builtin_amdgcn_exp2f(p0[r]); p1[r] = __builtin_amdgcn_exp2f(p1[r]); ls += p0[r] + p1[r]; } lsum += ls; \
            { u32x4 w; \
              w.x = cvtpk_nv(p0[0], p0[1]); w.y = cvtpk_nv(p0[2], p0[3]); w.z = cvtpk_nv(p0[4], p0[5]); w.w = cvtpk_nv(p0[6], p0[7]); pf[0] = __builtin_bit_cast(bf16x8, w); \
              w.x = cvtpk_nv(p0[8], p0[9]); w.y = cvtpk_nv(p0[10], p0[11]); w.z = cvtpk_nv(p0[12], p0[13]); w.w = cvtpk_nv(p0[14], p0[15]); pf[1] = __builtin_bit_cast(bf16x8, w); \
              w.x = cvtpk_nv(p1[0], p1[1]); w.y = cvtpk_nv(p1[2], p1[3]); w.z = cvtpk_nv(p1[4], p1[5]); w.w = cvtpk_nv(p1[6], p1[7]); pf[2] = __builtin_bit_cast(bf16x8, w); \
              w.x = cvtpk_nv(p1[8], p1[9]); w.y = cvtpk_nv(p1[10], p1[11]); w.z = cvtpk_nv(p1[12], p1[13]); w.w = cvtpk_nv(p1[14], p1[15]); pf[3] = __builtin_bit_cast(bf16x8, w); } \
            __builtin_amdgcn_s_setprio(1); AT_PVM(vfa, 0); __builtin_amdgcn_s_setprio(0); } while (0)
            for (int pp = 0; 2 * pp < ntiles; ++pp) { const int sb = (pp & 1) * 2;
                AT_SUB(sb); AT_SUB(sb + 1);
                if (2 * pp + 2 < ntiles) { AT_WRITEK(sb ^ 2); AT_WRITEV(sb ^ 2); AT_WRITEKB((sb ^ 2) + 1); AT_WRITEVB((sb ^ 2) + 1); }
                if (2 * pp + 4 < ntiles) { AT_LOADK(2 * pp + 4); AT_LOADV(2 * pp + 4); AT_LOADKB(2 * pp + 5); AT_LOADVB(2 * pp + 5); }
                __syncthreads();
            }
#undef AT_SUB
        } else
        for (; tt < ntiles; ++tt) AT_BODY(true, p0, p1, p0, p1, tt);
    }
#undef AT_BODY
#undef AT_LOADK
#undef AT_LOADV
#undef AT_WRITEK
#undef AT_WRITEV
#undef AT_KFRAGS
#undef AT_QKM
#undef AT_VFRAGS
#undef AT_PVM
}
template <int NDB>
__device__ __forceinline__ void attn_store(bf16* ATT, int row0, int col0, const f32x16 (&o)[NDB], float inv, int lane) {
    const int i = lane & 31, hh = lane >> 5; bf16* rp = ATT + (size_t)(row0 + i) * D + col0 + 4 * hh;
#pragma unroll
    for (int db = 0; db < NDB; ++db)
#pragma unroll
        for (int g4 = 0; g4 < 4; ++g4) { u32x2 w; w.x = pk2(o[db][4 * g4] * inv, o[db][4 * g4 + 1] * inv); w.y = pk2(o[db][4 * g4 + 2] * inv, o[db][4 * g4 + 3] * inv);
            *(u32x2*)(rp + 32 * db + 8 * g4) = w; }
}

#define XB_TMO      128
#define XB_XCNT(j)  (256  + 64 * (j))
#define XB_XSUB(j)  (1280 + 64 * (j))
#define XB_XGEN(j)  (2304 + 64 * (j))
#define XB_TOP      3328
#define XB_TOPGEN   3392
#define XCD_BAR_WORDS 3456
#define XB_SPIN_CAP (1u << 18)

__device__ __forceinline__ unsigned xb_ld(unsigned* p)              { return __hip_atomic_load(p, __ATOMIC_RELAXED, __HIP_MEMORY_SCOPE_AGENT); }
__device__ __forceinline__ unsigned xb_add(unsigned* p, unsigned v) { return __hip_atomic_fetch_add(p, v, __ATOMIC_RELAXED, __HIP_MEMORY_SCOPE_AGENT); }
__device__ __forceinline__ unsigned xb_xcc_id() { return (unsigned)__builtin_amdgcn_s_getreg((3 << 11) | 20) & 0xFu; }
#define XB_SPIN(cond, bar) do { unsigned _sp = 0; while (cond) { __builtin_amdgcn_s_sleep(1); \
    if ((++_sp & 255u) == 0u) { if (xb_ld(&(bar)[XB_TMO])) break; if (_sp > XB_SPIN_CAP) { atomicAdd(&(bar)[XB_TMO], 1u); break; } } } } while (0)

struct XcdBarrier {
    unsigned* bar; unsigned x;
    volatile LAS unsigned* st;
};

__device__ __forceinline__ XcdBarrier xcd_barrier_post(unsigned* bar, volatile LAS unsigned* st) {
    XcdBarrier b; b.bar = bar; b.x = xb_xcc_id(); b.st = st;
    if (threadIdx.x == 0) (void)xb_add(&bar[XB_XCNT(b.x)], 1u);
    return b;
}
__device__ __forceinline__ void xcd_barrier_complete(unsigned* bar, unsigned x, unsigned& nloc, unsigned& nx) {
    const unsigned G = gridDim.x * gridDim.y * gridDim.z;
    unsigned sum, cnt, mine, sp = 0u;
    for (;;) {
        sum = 0u; cnt = 0u; mine = 0u;
#pragma unroll
        for (unsigned j = 0; j < 16; ++j) { const unsigned c = xb_ld(&bar[XB_XCNT(j)]); sum += c; cnt += (c > 0u) ? 1u : 0u; mine = (j == x) ? c : mine; }
        if (sum == G) break;
        __builtin_amdgcn_s_sleep(1);
        if ((++sp & 255u) == 0u) { if (xb_ld(&bar[XB_TMO])) break; if (sp > XB_SPIN_CAP) { atomicAdd(&bar[XB_TMO], 1u); break; } }
    }
    nloc = mine > 0u ? mine : 1u; nx = cnt > 0u ? cnt : 1u;
}

__device__ __forceinline__ void xcd_barrier(const XcdBarrier& b, const int wave_s) {
    asm volatile("s_waitcnt vmcnt(0)" ::: "memory");
    __syncthreads();
    if (wave_s == 0 && fresh_lane() == 0) {
        unsigned* bar = b.bar; asm volatile("" : "+s"(bar));
        __builtin_amdgcn_s_waitcnt(0);
        unsigned nloc = b.st[0], nx = b.st[1];
        if (nloc == 0u) { xcd_barrier_complete(bar, b.x, nloc, nx); b.st[0] = nloc; b.st[1] = nx; }
        const unsigned old = xb_add(&bar[XB_XSUB(b.x)], 1u);
        const unsigned gen = old / nloc;
        if (old + 1u == (gen + 1u) * nloc) {
            __builtin_amdgcn_fence(__ATOMIC_RELEASE, "agent");
            asm volatile("s_waitcnt vmcnt(0)" ::: "memory");
            const unsigned og = xb_add(&bar[XB_TOP], 1u);
            const unsigned tg = og / nx;
            if (og + 1u == (tg + 1u) * nx) xb_add(&bar[XB_TOPGEN], 1u);
            else XB_SPIN(xb_ld(&bar[XB_TOPGEN]) == tg, bar);
            __builtin_amdgcn_fence(__ATOMIC_ACQUIRE, "agent");
            xb_add(&bar[XB_XGEN(b.x)], 1u);
            asm volatile("s_waitcnt vmcnt(0)" ::: "memory");
        } else {
            XB_SPIN(xb_ld(&bar[XB_XGEN(b.x)]) == gen, bar);
            __builtin_amdgcn_fence(__ATOMIC_ACQUIRE, "agent");
            asm volatile("s_waitcnt vmcnt(0)" ::: "memory");
        }
    }
    __syncthreads();
}

__device__ __forceinline__ int grab_unit(unsigned* ctr, volatile LAS unsigned* slot, int wave_s) {
    if (wave_s == 0 && fresh_lane() == 0) *slot = __hip_atomic_fetch_add(ctr, 1u, __ATOMIC_RELAXED, __HIP_MEMORY_SCOPE_AGENT);
    __syncthreads();
    const unsigned v = *slot;
    __syncthreads();
    return __builtin_amdgcn_readfirstlane((int)v);
}
__device__ __forceinline__ unsigned ticket_issue(unsigned* ctr, int wave_s, bool& mine) {
    mine = (wave_s == 0) && (fresh_lane() == 0); unsigned v = 0u;
    if (mine) v = __hip_atomic_fetch_add(ctr, 1u, __ATOMIC_RELAXED, __HIP_MEMORY_SCOPE_AGENT);
    return v;
}
__device__ __forceinline__ int ticket_publish(unsigned v, bool mine, volatile LAS unsigned* slot) {
    if (mine) *slot = v;
    __syncthreads();
    const unsigned r = *slot;
    __syncthreads();
    return __builtin_amdgcn_readfirstlane((int)r);
}
struct Args { const float* in[23]; float* out; unsigned char* ws; };

__global__ void __launch_bounds__(NTHR, 2) mega_fwd(Args args) {
    extern __shared__ __attribute__((aligned(16))) unsigned char lds_raw[];
    LAS unsigned char* lds = (LAS unsigned char*)lds_raw;
    cg::grid_group grid = cg::this_grid();
    const int wave_s = __builtin_amdgcn_readfirstlane(threadIdx.x >> 6);
    if (threadIdx.x < 16) ((LAS unsigned*)(lds + MISC_OFF))[threadIdx.x] = 0u;
    __syncthreads();
    const XcdBarrier xbar = xcd_barrier_post((unsigned*)(args.ws + WS_CTL), (volatile LAS unsigned*)(lds + MISC_OFF));
    const int G = gridDim.x, bx = blockIdx.x; const int vcu = (G % 8 == 0) ? (bx % 8) * (G / 8) + bx / 8 : bx;
    const int NGW = G * NWAVES;
    unsigned char* ws = args.ws;
    const float* x_in = args.in[0]; const float* c_in = args.in[1]; const float* ctx_in = args.in[2]; const float* cctx_in = args.in[3];
    const float* ada_w = args.in[4]; const float* ada_b = args.in[5]; const float* norm_mix = args.in[6]; const float* norm_mlp = args.in[7];
    float* MOD = (float*)(ws + WS_MOD); float* XCTX = (float*)(ws + WS_XCTX); bf16* H = (bf16*)(ws + WS_H); unsigned char* RG = ws + WS_R;
    float* XLAT = args.out;

    {   const int tid = threadIdx.x, lane = tid & 63, wave = __builtin_amdgcn_readfirstlane(tid >> 6);
        const bool split = G >= 96; const int NGW = split ? (G - 48) * NWAVES : G * NWAVES; const int gw = split ? ((bx >= 48) ? (bx - 48) * NWAVES + wave : NGW + wave) : bx * NWAVES + wave;
        if (bx < 48) {
            LAS float* S = (LAS float*)lds;
            for (int idx = tid; idx < 33 * 1024; idx += NTHR) { const int b = idx >> 10, k = idx & 1023; const float cv = (b < 32) ? c_in[b * 1024 + k] : cctx_in[k]; S[idx] = cv / (1.0f + __expf(-cv)); }
            __syncthreads();
            for (int item = bx; item < 48; item += G) {
                const int L = item / 12, col = (item % 12) * 512 + wave * 64 + lane; const float* wp = ada_w + (size_t)L * 1024 * 6144 + col;
                float acc[33];
#pragma unroll
                for (int b = 0; b < 33; ++b) acc[b] = 0.f;
                float wn[16];
#pragma unroll
                for (int e = 0; e < 16; ++e) wn[e] = wp[(size_t)e * 6144];
                for (int kb = 0; kb < 1024; kb += 16) {
                    float wc[16];
#pragma unroll
                    for (int e = 0; e < 16; ++e) wc[e] = wn[e];
                    if (kb + 16 < 1024) {
#pragma unroll
                        for (int e = 0; e < 16; ++e) wn[e] = wp[(size_t)(kb + 16 + e) * 6144]; }
#pragma unroll
                    for (int q4 = 0; q4 < 4; ++q4)
#pragma unroll
                        for (int b = 0; b < 33; ++b) { const f32x4 s = *(const LAS f32x4*)(S + b * 1024 + kb + 4 * q4); acc[b] += (s.x * wc[4 * q4] + s.y * wc[4 * q4 + 1]) + (s.z * wc[4 * q4 + 2] + s.w * wc[4 * q4 + 3]); }
                }
                const float bias = ada_b[L * 6144 + col];
#pragma unroll
                for (int b = 0; b < 33; ++b) MOD[((size_t)L * 33 + b) * 6144 + col] = acc[b] + bias;
            }
            __syncthreads();
        }
        LAS float* scr = (LAS float*)(lds + wave * 16384); int cur = 0;
        if (gw < NGW) {
        for (int i2 = 0; i2 < 2; ++i2) {
            unsigned char* we = ws + WS_W + (size_t)i2 * 8 * MiB; bf16* WinM = (bf16*)we; bf16* WinV = (bf16*)(we + 3584 * 1024); bf16* Wout = (bf16*)(we + 5 * MiB);
            const float* win = args.in[10] + (size_t)i2 * 1024 * 2304;
            xpose_seg(win, 1024, 2304, 0, 1024, false, WinM, 0, scr, gw, NGW, cur, lane);
            xpose_seg(win, 1024, 2304, 1536, 640, false, WinM, 1024, scr, gw, NGW, cur, lane);
            xpose_seg(win, 1024, 2304, 1024, 512, false, WinV, 0, scr, gw, NGW, cur, lane);
            xpose_seg(win, 1024, 2304, 2176, 128, false, WinV, 512, scr, gw, NGW, cur, lane);
            zero_rows(WinM, 1024, 1664, 128, gw, NGW, lane); zero_rows(WinV, 1024, 640, 128, gw, NGW, lane);
            xpose_seg(args.in[11] + (size_t)i2 * 1024 * 1024, 1024, 1024, 0, 1024, false, Wout, 0, scr, gw, NGW, cur, lane);
            unsigned char* wo = ws + WS_W + 16 * MiB + (size_t)i2 * 8 * MiB; bf16* MWin = (bf16*)wo; bf16* MQup = (bf16*)(wo + 2 * MiB); bf16* MKn = (bf16*)(wo + 3584 * 1024); bf16* MV = (bf16*)(wo + 4 * MiB); bf16* MWout = (bf16*)(wo + 4608 * 1024);
            xpose_seg(args.in[16] + (size_t)i2 * 1024 * 800, 1024, 800, 0, 800, false, MWin, 0, scr, gw, NGW, cur, lane);
            zero_rows(MWin, 1024, 800, 224, gw, NGW, lane);
            xpose_seg(args.in[18] + (size_t)i2 * 512 * 1536, 512, 1536, 0, 1536, false, MQup, 0, scr, gw, NGW, cur, lane);
            xpose_seg(args.in[20] + (size_t)i2 * 256 * 2048, 256, 2048, 0, 1024, true, MKn, 0, scr, gw, NGW, cur, lane);
            xpose_seg(args.in[20] + (size_t)i2 * 256 * 2048, 256, 2048, 64, 1024, true, MV, 0, scr, gw, NGW, cur, lane);
            xpose_seg(args.in[22] + (size_t)i2 * 1024 * 1024, 1024, 1024, 0, 1024, false, MWout, 0, scr, gw, NGW, cur, lane);
        }
        for (int L = 0; L < 4; ++L) {
            unsigned char* wm = ws + WS_W + 32 * MiB + (size_t)L * 16 * MiB;
            xpose_seg(args.in[8] + (size_t)L * 1024 * 4096, 1024, 4096, 0, 4096, false, (bf16*)wm, 0, scr, gw, NGW, cur, lane);
            xpose_seg(args.in[9] + (size_t)L * 4096 * 1024, 4096, 1024, 0, 1024, false, (bf16*)(wm + 8 * MiB), 0, scr, gw, NGW, cur, lane);
        }
        }
    }
    if (__builtin_expect(args.ws == nullptr, 0)) grid.sync();
    xcd_barrier(xbar, wave_s);
    {
        float* MOD = (float*)(ws + WS_MOD); bf16* SHB = (bf16*)(ws + WS_SHB); float* SSQ1 = (float*)(ws + WS_SSQ); float* SSQ2 = SSQ1 + 131072;
        const int lane = fresh_lane(); const int gw = vcu * NWAVES + wave_s;
        for (int idx = gw; idx < 264; idx += NGW) { const int L = idx / 66, rem = idx % 66, w = rem / 33, b = rem % 33;
            const float* src = MOD + ((size_t)L * 33 + b) * 6144 + (w ? 3072 : 0); bf16* dst = SHB + ((size_t)(2 * L + w) * 256 + b) * 1024;
#pragma unroll
            for (int j = 0; j < 4; ++j) { const f32x4 v = *(const f32x4*)(src + 256 * j + 4 * lane); u32x2 o; o.x = pk2(v.x, v.y); o.y = pk2(v.z, v.w); *(u32x2*)(dst + 256 * j + 4 * lane) = o; } }
        prep_phase(x_in, ctx_in, norm_mix, MOD, 1024, (bf16*)(ws + WS_H), SSQ1, vcu, NGW, wave_s);
        zero_f32(SSQ2, R, vcu, NGW, wave_s);
        zero_f32((float*)(ws + WS_SSQM), 262144, vcu, NGW, wave_s);
    }
    xcd_barrier(xbar, wave_s);
    {
        pg8::Gemm g{(const bf16*)(ws + WS_SHB), (const bf16*)(ws + WS_W), 2048, 256, 1024}; pg8::ShwOrder S{G, bx}; pg8::EpiShw E{(float*)(ws + WS_SHW)};
        pg8::gemm_phase<pg8::EpiShw, pg8::ShwOrder, true, true>(lds, g, S, E, wave_s);
    }
    xcd_barrier(xbar, wave_s);

    const int G0 = G, bx0 = bx, vcu0 = vcu; int dir = 0;
    for (int L = 0; L < 4; ++L) {
        int G = G0, bx = bx0, vcu = vcu0; asm volatile("" : "+s"(G), "+s"(bx), "+s"(vcu)); const int NGW = G * NWAVES;
        const __attribute__((address_space(4))) Args* ap = (const __attribute__((address_space(4))) Args*)__builtin_amdgcn_kernarg_segment_ptr(); asm volatile("" : "+s"(ap));
        unsigned char* ws = ap->ws; float* XLAT = ap->out; const float* x_in = ap->in[0]; const float* ctx_in = ap->in[2]; const float* norm_mix = ap->in[6]; const float* norm_mlp = ap->in[7];
        float* MOD = (float*)(ws + WS_MOD); float* XCTX = (float*)(ws + WS_XCTX); bf16* H = (bf16*)(ws + WS_H); unsigned char* RG = ws + WS_R;
        const int i2 = L >> 1; const bool last = (L == 3);
        const float* modl = MOD + (size_t)L * 33 * 6144;
        const float* xl = (L == 0) ? x_in : XLAT; const float* xc = (L == 0) ? ctx_in : XCTX;
        float* SSQ1 = (float*)(ws + WS_SSQ); float* SSQ2 = SSQ1 + 131072; const float* SHWin = (const float*)(ws + WS_SHW) + (size_t)L * 33 * 8192; const float* SHW1 = SHWin + 33 * 4096;
        const int Ln = (L < 3) ? L + 1 : 3;
        bf16* ATT;
        if ((L & 1) == 0) {
            unsigned char* we = ws + WS_W + (size_t)i2 * 8 * MiB; const bf16* WinM = (const bf16*)we; const bf16* WinV = (const bf16*)(we + 3584 * 1024); const bf16* Wout = (const bf16*)(we + 5 * MiB);
            bf16* RAW = (bf16*)RG; bf16* VT = (bf16*)(RG + 252 * MiB); ATT = (bf16*)(RG + 576 * MiB);
            {   pg8::Gemm g{H, WinM, R, 1792, 1024}; pg8::StaticOrder S; S.init(R, 1792, G, bx); S.rev = dir; pg8::EpiEvenIn E{RAW, SSQ1, SHWin, ap->in[12] + i2 * 128 + 64, ap->in[15] + i2 * 128 + 64};
                pg8::gemm_phase<pg8::EpiEvenIn, pg8::StaticOrder, true, true>(lds, g, S, E, wave_s); }
            {   pg8::Gemm g{WinV, H, 768, R, 1024}; pg8::StaticOrder S; S.init(768, R, G, bx); S.rev = dir; pg8::EpiVT<true> E{VT, 768, SSQ1, SHWin + 1792, 2560, 1.0f / 1024.0f};
                pg8::gemm_phase<pg8::EpiVT<true>, pg8::StaticOrder, true, true>(lds, g, S, E, wave_s); }
            { xcd_barrier(xbar, wave_s); dir ^= 1; }
            {
                const int lane = fresh_lane(), wave = wave_s;
                const float* lamp = ap->in[13] + i2 * 256;
                const float lam_init = 0.8f - 0.6f * __expf(-0.3f * (float)L);
                const float lam_v = __expf(wave_sum(lamp[lane] * lamp[64 + lane], lane)) - __expf(wave_sum(lamp[128 + lane] * lamp[192 + lane], lane)) + lam_init;
                const float lam = __builtin_bit_cast(float, __builtin_amdgcn_readfirstlane(__builtin_bit_cast(int, lam_v)));
                const float* subln = ap->in[14] + i2 * 128;
                const int nlat_d = 1024, nctx_d = 128, nlat_g = 2048, nctx_g = 256;
#ifndef NO_DIFF
                unsigned* ctrs = (unsigned*)(ws + WS_CTL) + 3584 + 8 * L; volatile LAS unsigned* slot = (volatile LAS unsigned*)(lds + MISC_OFF) + 8;
                for (int u = grab_unit(ctrs, slot, wave_s); u < nlat_d + nctx_d; ) { bool tk_mine; const unsigned tk_next = ticket_issue(ctrs, wave_s, tk_mine);
                    int b, h, row0, nt;
                    if (u < nlat_d) { const int ur = dir ? (nlat_d - 1 - u) : u; const int qb = ur & 7; h = (ur >> 3) & 3; b = ur >> 5; row0 = b * 2048 + qb * 256 + wave * 32; nt = 36; }
                    else { const int uu = u - nlat_d; h = uu & 3; b = uu >> 2; row0 = NLAT + b * 256 + wave * 32; nt = 4; }
                    f32x16 o[4]; float l;
                    const bf16* vt = VT + ((size_t)b * 768 + h * 128) * KV;
                    attn_pass<64, 128, false>(lds, RAW + (size_t)row0 * RAWP + (h * 2) * 64, RAWP, RAW + (size_t)(NLAT + b * 256) * RAWP + 512 + (h * 2) * 64, RAW + (size_t)(b * 2048) * RAWP + 512 + (h * 2) * 64, RAWP, vt, nt, ap->in[12] + i2 * 128, row0, 0.125f * LOG2E, o, l, wave_s);
                    { const int ln = fresh_lane(); LAS unsigned* o1s = (LAS unsigned*)(lds + 57344 + wave_s * 8192) + ln; const float inv = 1.0f / (l + shx(l, 32, ln));
#pragma unroll
                      for (int db = 0; db < 4; ++db)
#pragma unroll
                          for (int j = 0; j < 8; ++j) o1s[(db * 8 + j) * 64] = pg8::cvt_pk_bf16(o[db][2 * j] * inv, o[db][2 * j + 1] * inv); }
                    attn_pass<64, 128, false>(lds, RAW + (size_t)row0 * RAWP + (h * 2 + 1) * 64, RAWP, RAW + (size_t)(NLAT + b * 256) * RAWP + 512 + (h * 2 + 1) * 64, RAW + (size_t)(b * 2048) * RAWP + 512 + (h * 2 + 1) * 64, RAWP, vt, nt, ap->in[12] + i2 * 128, row0, 0.125f * LOG2E, o, l, wave_s);
                    { const int ln = fresh_lane(), i = ln & 31, hh = ln >> 5; LAS unsigned* o1s = (LAS unsigned*)(lds + 57344 + wave_s * 8192) + ln; const float inv = lam / (l + shx(l, 32, ln)); float ss = 0.f;
#pragma unroll
                      for (int db = 0; db < 4; ++db)
#pragma unroll
                          for (int j = 0; j < 8; ++j) { const unsigned pk = o1s[(db * 8 + j) * 64]; const float a0 = bflo(pk) - o[db][2 * j] * inv, a1 = bfhi(pk) - o[db][2 * j + 1] * inv; o[db][2 * j] = a0; o[db][2 * j + 1] = a1; ss += a0 * a0 + a1 * a1; }
                      ss += shx(ss, 32, ln);
                      const float rinv = (1.0f - lam_init) / sqrtf(ss * (1.0f / 128) + EPS);
                      bf16* rp = ATT + (size_t)(row0 + i) * D + h * 128 + 4 * hh;
#pragma unroll
                      for (int db = 0; db < 4; ++db)
#pragma unroll
                          for (int g4 = 0; g4 < 4; ++g4) { const f32x4 sg = *(const f32x4*)(subln + 32 * db + 8 * g4 + 4 * hh);
                              u32x2 w; w.x = pk2(o[db][4 * g4] * rinv * sg.x, o[db][4 * g4 + 1] * rinv * sg.y); w.y = pk2(o[db][4 * g4 + 2] * rinv * sg.z, o[db][4 * g4 + 3] * rinv * sg.w);
                              *(u32x2*)(rp + 32 * db + 8 * g4) = w; } }
                    u = ticket_publish(tk_next, tk_mine, slot);
                }
#endif
#ifndef NO_GQA
                for (int u = grab_unit(ctrs + 1, slot, wave_s); u < nlat_g + nctx_g; ) { bool tk_mine; const unsigned tk_next = ticket_issue(ctrs + 1, wave_s, tk_mine);
                    int b, hq, row0, nt;
                    if (u < nlat_g) { const int ur = dir ? (nlat_g - 1 - u) : u; const int qb = ur & 7; hq = (ur >> 3) & 7; b = ur >> 6; row0 = b * 2048 + qb * 256 + wave * 32; nt = 36; }
                    else { const int uu = u - nlat_g; hq = uu & 7; b = uu >> 3; row0 = NLAT + b * 256 + wave * 32; nt = 4; }
                    const int kvh = hq >> 2; f32x16 o[2]; float l;
                    attn_pass<64, 64, false>(lds, RAW + (size_t)row0 * RAWP + 1024 + hq * 64, RAWP, RAW + (size_t)(NLAT + b * 256) * RAWP + 1536 + kvh * 64, RAW + (size_t)(b * 2048) * RAWP + 1536 + kvh * 64, RAWP,
                                      VT + ((size_t)b * 768 + 512 + kvh * 64) * KV, nt, ap->in[15] + i2 * 128, row0, 0.125f * LOG2E, o, l, wave_s);
                    { const int ln = fresh_lane(); attn_store<2>(ATT, row0, 512 + hq * 64, o, 1.0f / (l + shx(l, 32, ln)), ln); }
                    u = ticket_publish(tk_next, tk_mine, slot);
                }
#endif
            }
            { xcd_barrier(xbar, wave_s); dir ^= 1; }
            {   pg8::Gemm g{ATT, Wout, R, 1024, 1024}; pg8::StaticOrder S; S.init(R, 1024, G, bx); S.rev = dir; pg8::EpiResid E{xl, xc, XLAT, XCTX, modl + 2048, H, norm_mlp + L * 1024, modl + 4096, SSQ2};
                zero_f32(SSQ1, R, vcu, NGW, wave_s);
                pg8::gemm_phase<pg8::EpiResid, pg8::StaticOrder, true, true>(lds, g, S, E, wave_s); }
        } else {
            unsigned char* wo = ws + WS_W + 16 * MiB + (size_t)i2 * 8 * MiB; const bf16* MWin = (const bf16*)wo; const bf16* MQup = (const bf16*)(wo + 2 * MiB); const bf16* MKn = (const bf16*)(wo + 3584 * 1024);
            const bf16* MV = (const bf16*)(wo + 4 * MiB); const bf16* MWout = (const bf16*)(wo + 4608 * 1024);
            bf16* MRAW = (bf16*)RG; ATT = (bf16*)RG; bf16* Q = (bf16*)(RG + 144 * MiB); bf16* Kb = (bf16*)(RG + 360 * MiB); bf16* VT = (bf16*)(RG + 576 * MiB);
            bf16* QCn = (bf16*)RG; bf16* KVCn = (bf16*)(RG + 72 * MiB); bf16* KR = (bf16*)(RG + 108 * MiB);
            float* SSQq = (float*)(ws + WS_SSQM); float* SSQkv = SSQq + 131072; const float* ZSH = SSQq + 229376;
            {   pg8::Gemm g{H, MWin, R, 1024, 1024}; pg8::StaticOrder S; S.init(R, 1024, G, bx); S.rev = dir; pg8::EpiMlaIn E{SSQ1, SHWin, QCn, KVCn, KR, ap->in[17] + i2 * 512, ap->in[19] + i2 * 256, SSQq, SSQkv};
                pg8::gemm_phase<pg8::EpiMlaIn, pg8::StaticOrder, true, true>(lds, g, S, E, wave_s); }
            { xcd_barrier(xbar, wave_s); dir ^= 1; }
            {   pg8::Gemm g{QCn, MQup, last ? NLAT : R, 1536, 512}; pg8::StaticOrder S; S.init(last ? NLAT : R, 1536, G, bx); S.rev = dir; pg8::EpiStore<0, 0, true> E{Q, MQP, SSQq, ZSH, 0, 1.0f / 512.0f};
                pg8::gemm_phase<pg8::EpiStore<0, 0, true>, pg8::StaticOrder, true, true>(lds, g, S, E, wave_s); }
            {   pg8::Gemm g{KVCn, MKn, R, 1024, 256}; pg8::StaticOrder S; S.init(R, 1024, G, bx); S.rev = dir; pg8::EpiMlaKn E{Kb, SSQkv, KR, ap->in[21] + i2 * 192 + 96};
                pg8::gemm_phase<pg8::EpiMlaKn, pg8::StaticOrder, true, true>(lds, g, S, E, wave_s); }
            {   pg8::Gemm g{MV, KVCn, 1024, R, 256}; pg8::StaticOrder S; S.init(1024, R, G, bx); S.rev = dir; pg8::EpiVT<true> E{VT, 1024, SSQkv, ZSH, 0, 1.0f / 256.0f};
                pg8::gemm_phase<pg8::EpiVT<true>, pg8::StaticOrder, true, true>(lds, g, S, E, wave_s); }
            { xcd_barrier(xbar, wave_s); dir ^= 1; }
            {   const float* gq = ap->in[21] + i2 * 192; const float* gk = gq + 96;
                const int lane = fresh_lane(), wave = wave_s;
                const int nlat = 4096, nctx = last ? 0 : 512;
#ifndef NO_MLA
                unsigned* ctrs = (unsigned*)(ws + WS_CTL) + 3584 + 8 * L; volatile LAS unsigned* slot = (volatile LAS unsigned*)(lds + MISC_OFF) + 8;
                for (int u = grab_unit(ctrs, slot, wave_s); u < nlat + nctx; ) { bool tk_mine; const unsigned tk_next = ticket_issue(ctrs, wave_s, tk_mine);
                    int b, h, row0, nt;
                    if (u < nlat) { const int ur = dir ? (nlat - 1 - u) : u; const int qb = ur & 7; h = (ur >> 3) & 15; b = ur >> 7; row0 = b * 2048 + qb * 256 + wave * 32; nt = 36; }
                    else { const int uu = u - nlat; h = uu & 15; b = uu >> 4; row0 = NLAT + b * 256 + wave * 32; nt = 4; }
                    f32x16 o[2]; float l;
                    attn_pass<96, 64, false>(lds, Q + (size_t)row0 * MQP + h * 96, MQP, Kb + (size_t)(NLAT + b * 256) * MQP + h * 96, Kb + (size_t)(b * 2048) * MQP + h * 96, MQP,
                                      VT + ((size_t)b * 1024 + h * 64) * KV, nt, gq, row0, 0.10206207261596577f * LOG2E, o, l, wave_s);
                    { const int ln = fresh_lane(); attn_store<2>(ATT, row0, h * 64, o, 1.0f / (l + shx(l, 32, ln)), ln); }
                    u = ticket_publish(tk_next, tk_mine, slot);
                }
#endif
            }
            { xcd_barrier(xbar, wave_s); dir ^= 1; }
            {   const int Mr = last ? NLAT : R;
                pg8::Gemm g{ATT, MWout, Mr, 1024, 1024}; pg8::StaticOrder S; S.init(Mr, 1024, G, bx); S.rev = dir; pg8::EpiResid E{xl, xc, XLAT, XCTX, modl + 2048, H, norm_mlp + L * 1024, modl + 4096, SSQ2};
                zero_f32(SSQ1, R, vcu, NGW, wave_s);
                pg8::gemm_phase<pg8::EpiResid, pg8::StaticOrder, true, true>(lds, g, S, E, wave_s); }
        }
        { xcd_barrier(xbar, wave_s); dir ^= 1; }
        {   const int Mr = last ? NLAT : R; unsigned char* wm = ws + WS_W + 32 * MiB + (size_t)L * 16 * MiB; bf16* HID = (bf16*)RG;
            {   pg8::Gemm g{H, (const bf16*)wm, Mr, FF, 1024}; pg8::StaticOrder S; S.init(Mr, FF, G, bx); S.rev = dir; pg8::EpiStore<1, 0, true> E{HID, FF, SSQ2, SHW1, 4096, 1.0f / 1024.0f};
                pg8::gemm_phase<pg8::EpiStore<1, 0, true>, pg8::StaticOrder, true, true>(lds, g, S, E, wave_s); }
            { xcd_barrier(xbar, wave_s); dir ^= 1; }
            {   pg8::Gemm g{HID, (const bf16*)(wm + 8 * MiB), Mr, 1024, FF}; pg8::StaticOrder S; S.init(Mr, 1024, G, bx); S.rev = dir; pg8::EpiResid E{XLAT, XCTX, XLAT, XCTX, modl + 5120, H, norm_mix + Ln * 1024, MOD + (size_t)Ln * 33 * 6144 + 1024, SSQ1};
                zero_f32(SSQ2, R, vcu, NGW, wave_s); zero_f32((float*)(ws + WS_SSQM), 229376, vcu, NGW, wave_s);
                pg8::gemm_phase<pg8::EpiResid, pg8::StaticOrder, true, true>(lds, g, S, E, wave_s); }
        }
        { xcd_barrier(xbar, wave_s); dir ^= 1; }
    }
}

extern "C" void kernel_launch(void* const* d_in, const int* in_sizes, int n_in, void* d_out, int out_size, void* d_ws, size_t ws_size, hipStream_t stream) {
    static int grid = 0;
    if (grid == 0) {
        if (n_in != 23 || out_size != NLAT * D || ws_size < WS_END) { fprintf(stderr, "kernel_launch: unexpected shapes (n_in %d, out %d, ws %zu)\n", n_in, out_size, ws_size); grid = -1; return; }
        int dev = 0, cus = 0, per_cu = 0;
        hipGetDevice(&dev); hipDeviceGetAttribute(&cus, hipDeviceAttributeMultiprocessorCount, dev);
        if (hipFuncSetAttribute((const void*)mega_fwd, hipFuncAttributeMaxDynamicSharedMemorySize, LDS_BYTES) != hipSuccess) { fprintf(stderr, "kernel_launch: hipFuncSetAttribute failed\n"); grid = -1; return; }
        if (hipOccupancyMaxActiveBlocksPerMultiprocessor(&per_cu, (const void*)mega_fwd, NTHR, LDS_BYTES) != hipSuccess || per_cu < 1) { fprintf(stderr, "kernel_launch: occupancy query says %d\n", per_cu); per_cu = 1; }
        (void)hipGetLastError();
        grid = cus;
    }
    if (grid < 0) return;
    if (hipMemsetAsync((char*)d_ws + WS_CTL, 0, CTL_BYTES, stream) != hipSuccess) { fprintf(stderr, "kernel_launch: memset failed\n"); return; }
    Args a{};
    for (int i = 0; i < 23; ++i) a.in[i] = (const float*)d_in[i];
    a.out = (float*)d_out; a.ws = (unsigned char*)d_ws;
    void* kargs[] = {&a};
    hipError_t e = hipLaunchCooperativeKernel((const void*)mega_fwd, dim3(grid), dim3(NTHR), kargs, LDS_BYTES, stream);
    if (e != hipSuccess) fprintf(stderr, "kernel_launch: cooperative launch failed: %s (grid %d)\n", hipGetErrorString(e), grid);
}
```

```cpp
#include <hip/hip_runtime.h>
#include <hip/hip_cooperative_groups.h>
#include <cstdio>
#include <cstdint>
#include <cmath>
namespace cg = cooperative_groups;
__device__ __forceinline__ int fresh_lane() { int m1 = -1; asm volatile("" : "+s"(m1)); return __builtin_amdgcn_mbcnt_hi(m1, __builtin_amdgcn_mbcnt_lo(m1, 0)); }
namespace pg8 {
#define PG8_LAS __attribute__((address_space(3)))
typedef unsigned short bf16_t;
typedef short bf16x8 __attribute__((ext_vector_type(8)));
typedef float f32x4 __attribute__((ext_vector_type(4)));
typedef unsigned u32x4 __attribute__((ext_vector_type(4)));
constexpr int BM = 256, BK = 64, HALF = 128, HTB = HALF * BK * 2  , STAGE_BYTES = 8 * HTB, NXCD = 8, WGM = 8;

__host__ __device__ __forceinline__ int lds_byte(int r, int c) { const int st = (r >> 4) * 2 + (c >> 5), rr = r & 15, cc = c & 31, ob = rr * 64 + cc * 2; return st * 1024 + (ob ^ (((ob >> 9) & 1) << 5)); }
__host__ __device__ __forceinline__ void stage_rc(int b, int& R, int& C) { const int st = b / 1024, sb = b % 1024, swz = sb ^ (((sb >> 9) & 1) << 5); R = (st >> 1) * 16 + swz / 64; C = (st & 1) * 32 + (swz % 64) / 2; }
__host__ __device__ __forceinline__ int perm32(int rho) { const int n = rho >> 4, i = rho & 15; return 8 * (i >> 2) + 4 * n + (i & 3); }

struct Unit { int pm, pn; };
struct Gemm { const bf16_t* A; const bf16_t* Bt; int M, N, K; };

struct StaticOrder {
    int nM, nN, nwg, G, c, rev;
    __host__ __device__ void init(int M, int N, int G_, int c_) { nM = M / BM; nN = N / BM; nwg = nM * nN; G = G_; c = c_; rev = 0; }
    __host__ __device__ bool next(int i, Unit& u) const {
        const long L = (long)i * G + c; if (L >= nwg) return false;
        int wgid = (int)L; { const int q = nwg / NXCD, r = nwg % NXCD, xcd = wgid % NXCD, off = wgid / NXCD; wgid = (xcd < r ? xcd * (q + 1) : r * (q + 1) + (xcd - r) * q) + off; }
        if (rev) wgid = nwg - 1 - wgid;
        const int nig = WGM * nN, gid = wgid / nig, fm = gid * WGM, gsz = (nM - fm) < WGM ? (nM - fm) : WGM;
        u.pm = fm + ((wgid % nig) % gsz); u.pn = (wgid % nig) / gsz; return true;
    }
    __device__ __forceinline__ void a_ready(const Unit&) const {}
    __device__ __forceinline__ void done(const Unit&) const {}
};

__device__ __forceinline__ unsigned cvt_pk_bf16(float lo, float hi) { unsigned r; asm volatile("v_cvt_pk_bf16_f32 %0, %1, %2" : "=v"(r) : "v"(lo), "v"(hi)); return r; }
typedef float f32x2 __attribute__((ext_vector_type(2)));
typedef unsigned u32x2 __attribute__((ext_vector_type(2)));
__device__ __forceinline__ float rinv_of(float ssq, float invn) { return 1.0f / sqrtf(ssq * invn + 1e-6f); }
__device__ __forceinline__ int mi_of_tile(int r0) { return r0 < 65536 ? (r0 >> 11) : 32; }
template <int ACT, int HEADMAP, bool NORM> struct EpiStore {
    static constexpr bool PERM = true, AFTER_DRAIN = false, HEAD64 = false;
    bf16_t* O; int ldc; const float* ssq; const float* shw; int ldshw; float invn;
    __device__ __forceinline__ void operator()(const f32x4 (&acc)[2][2][4][2], const Unit& u, int wr, int wc, int fr, int fq) const {
        { const int t_ = fresh_lane(); fr = t_ & 15; fq = (t_ >> 4) & 3; }
        const int row0 = u.pm * BM + wr * 64 + fr; const int colb = u.pn * BM + wc * 32 + 8 * fq;
        f32x4 sw[2][2];
        if (NORM) { const float* sp = shw + (size_t)mi_of_tile(u.pm * BM) * ldshw + colb;
#pragma unroll
            for (int bj = 0; bj < 2; ++bj) { sw[bj][0] = *(const f32x4*)(sp + bj * HALF); sw[bj][1] = *(const f32x4*)(sp + bj * HALF + 4); } }
        float riv[2][4];
#pragma unroll
        for (int ai = 0; ai < 2; ++ai)
#pragma unroll
            for (int m = 0; m < 4; ++m) riv[ai][m] = NORM ? ssq[row0 + ai * HALF + m * 16] : 0.f;
#pragma unroll
        for (int ai = 0; ai < 2; ++ai)
#pragma unroll
            for (int m = 0; m < 4; ++m) { const int row = row0 + ai * HALF + m * 16; bf16_t* rowp = O + (size_t)row * ldc;
                float ri = 1.0f; if (NORM) ri = rinv_of(riv[ai][m], invn);
#pragma unroll
                for (int bj = 0; bj < 2; ++bj) { const int c = colb + bj * HALF; const int dc = HEADMAP ? ((c >> 6) * 96 + (c & 63)) : c;
                    f32x4 v0 = acc[ai][bj][m][0], v1 = acc[ai][bj][m][1];
                    if (NORM) { v0 = v0 * ri + sw[bj][0]; v1 = v1 * ri + sw[bj][1]; }
                    if (ACT == 1) {
#pragma unroll
                        for (int e = 0; e < 4; ++e) { float a = v0[e] > 0.f ? v0[e] : 0.f; v0[e] = a * a; float b = v1[e] > 0.f ? v1[e] : 0.f; v1[e] = b * b; } }
                    u32x4 w; w.x = cvt_pk_bf16(v0[0], v0[1]); w.y = cvt_pk_bf16(v0[2], v0[3]); w.z = cvt_pk_bf16(v1[0], v1[1]); w.w = cvt_pk_bf16(v1[2], v1[3]);
                    *(u32x4*)(rowp + dc) = w; } }
    }
};
template <bool NORM> struct EpiVT {
    static constexpr bool PERM = true, AFTER_DRAIN = false, HEAD64 = false;
    bf16_t* VT; int NF; const float* ssq; const float* shw; int ldshw; float invn;
    __device__ __forceinline__ void operator()(const f32x4 (&acc)[2][2][4][2], const Unit& u, int wr, int wc, int fr, int fq) const {
        { const int t_ = fresh_lane(); fr = t_ & 15; fq = (t_ >> 4) & 3; }
        const int r0 = u.pn * BM; int b, kv0; if (r0 < 65536) { b = r0 >> 11; kv0 = 256 + (r0 & 2047); } else { b = (r0 - 65536) >> 8; kv0 = 0; }
        const int f0 = u.pm * BM + wr * 64 + fr;
        f32x4 ri[2][2];
        if (NORM) {
#pragma unroll
            for (int bj = 0; bj < 2; ++bj)
#pragma unroll
                for (int n = 0; n < 2; ++n) { const f32x4 s = *(const f32x4*)(ssq + r0 + bj * HALF + wc * 32 + 8 * fq + 4 * n); ri[bj][n] = (f32x4){rinv_of(s.x, invn), rinv_of(s.y, invn), rinv_of(s.z, invn), rinv_of(s.w, invn)}; } }
        const float* sp = NORM ? shw + (size_t)mi_of_tile(r0) * ldshw : nullptr;
        float shv[2][4];
#pragma unroll
        for (int ai = 0; ai < 2; ++ai)
#pragma unroll
            for (int m = 0; m < 4; ++m) shv[ai][m] = NORM ? sp[f0 + ai * HALF + m * 16] : 0.f;
#pragma unroll
        for (int ai = 0; ai < 2; ++ai)
#pragma unroll
            for (int m = 0; m < 4; ++m) { const int f = f0 + ai * HALF + m * 16; bf16_t* rowp = VT + ((size_t)b * NF + f) * 2304 + kv0;
                const float sh = shv[ai][m];
#pragma unroll
                for (int bj = 0; bj < 2; ++bj) { const int cw = bj * HALF + wc * 32 + 8 * fq; const int gb = cw & ~15, o = cw & 15;
#pragma unroll
                    for (int n = 0; n < 2; ++n) { const int o4 = o + 4 * n; const int pos = (o4 & 3) | (((o4 >> 2) & 1) << 3) | (((o4 >> 3) & 1) << 2);
                        f32x4 v = acc[ai][bj][m][n]; if (NORM) v = v * ri[bj][n] + sh;
                        u32x2 w; w.x = cvt_pk_bf16(v[0], v[1]); w.y = cvt_pk_bf16(v[2], v[3]);
                        *(u32x2*)(rowp + gb + pos) = w; } } }
    }
};
struct EpiMlaIn {
    static constexpr bool PERM = true, AFTER_DRAIN = false, HEAD64 = false;
    const float* ssq; const float* shw; bf16_t* QCg; bf16_t* KVCg; bf16_t* KR; const float* gq; const float* gkv; float* ssq_q; float* ssq_kv;
    __device__ __forceinline__ void operator()(const f32x4 (&acc)[2][2][4][2], const Unit& u, int wr, int wc, int fr, int fq) const {
        const int ln_ = fresh_lane(); fr = ln_ & 15; fq = (ln_ >> 4) & 3;
        const int row0 = u.pm * BM + wr * 64 + fr; const int colb = u.pn * BM + wc * 32 + 8 * fq;
        const float* sp = shw + (size_t)mi_of_tile(u.pm * BM) * 1024 + colb;
        f32x4 sw[2][2], gg[2][2];
#pragma unroll
        for (int bj = 0; bj < 2; ++bj) { sw[bj][0] = *(const f32x4*)(sp + bj * HALF); sw[bj][1] = *(const f32x4*)(sp + bj * HALF + 4);
            const int c = colb + bj * HALF;
            if (u.pn < 2) { gg[bj][0] = *(const f32x4*)(gq + c); gg[bj][1] = *(const f32x4*)(gq + c + 4); }
            else if (u.pn == 2) { gg[bj][0] = *(const f32x4*)(gkv + c - 512); gg[bj][1] = *(const f32x4*)(gkv + c - 508); }
            else { gg[bj][0] = (f32x4){1.f, 1.f, 1.f, 1.f}; gg[bj][1] = gg[bj][0]; } }
        float riv[2][4];
#pragma unroll
        for (int ai = 0; ai < 2; ++ai)
#pragma unroll
            for (int m = 0; m < 4; ++m) riv[ai][m] = ssq[row0 + ai * HALF + m * 16];
#pragma unroll
        for (int ai = 0; ai < 2; ++ai)
#pragma unroll
            for (int m = 0; m < 4; ++m) { const int row = row0 + ai * HALF + m * 16; const float ri = rinv_of(riv[ai][m], 1.0f / 1024.0f); float ps = 0.f;
#pragma unroll
                for (int bj = 0; bj < 2; ++bj) { const int c = colb + bj * HALF;
                    const f32x4 v0 = acc[ai][bj][m][0] * ri + sw[bj][0], v1 = acc[ai][bj][m][1] * ri + sw[bj][1];
                    ps += ((v0[0] * v0[0] + v0[1] * v0[1]) + (v0[2] * v0[2] + v0[3] * v0[3])) + ((v1[0] * v1[0] + v1[1] * v1[1]) + (v1[2] * v1[2] + v1[3] * v1[3]));
                    const f32x4 a0 = v0 * gg[bj][0], a1 = v1 * gg[bj][1];
                    u32x4 w; w.x = cvt_pk_bf16(a0[0], a0[1]); w.y = cvt_pk_bf16(a0[2], a0[3]); w.z = cvt_pk_bf16(a1[0], a1[1]); w.w = cvt_pk_bf16(a1[2], a1[3]);
                    if (u.pn < 2) *(u32x4*)(QCg + (size_t)row * 512 + c) = w;
                    else if (u.pn == 2) *(u32x4*)(KVCg + (size_t)row * 256 + (c - 512)) = w;
                    else if (c < 800) *(u32x4*)(KR + (size_t)row * 32 + (c - 768)) = w; }
                if (u.pn < 3) {
                    ps += __builtin_bit_cast(float, __builtin_amdgcn_ds_bpermute((ln_ ^ 16) << 2, __builtin_bit_cast(int, ps)));
                    ps += __builtin_bit_cast(float, __builtin_amdgcn_ds_bpermute((ln_ ^ 32) << 2, __builtin_bit_cast(int, ps)));
                    if (fq == 0) atomicAdd((u.pn < 2 ? ssq_q : ssq_kv) + row, ps); } }
    }
};
__device__ __forceinline__ void cs_rev(float a, float& c, float& s) {
    double rev = (double)a * 0.15915494309189535; rev -= floor(rev); const float rf = (float)rev; c = __builtin_amdgcn_cosf(rf); s = __builtin_amdgcn_sinf(rf); }
__device__ __forceinline__ float shx32(float v, int o, int lane) { return __builtin_bit_cast(float, __builtin_amdgcn_ds_bpermute((lane ^ o) << 2, __builtin_bit_cast(int, v))); }
struct EpiEvenIn {
    static constexpr bool PERM = true, AFTER_DRAIN = false, HEAD64 = true;
    bf16_t* O; const float* ssq; const float* shw; const float* gdk; const float* ggk;
    __device__ __forceinline__ void operator()(const f32x4 (&acc)[2][2][4][2], const Unit& u, int wr, int wc, int fr, int fq) const {
        const int ln_ = fresh_lane(); fr = ln_ & 15; fq = (ln_ >> 4) & 3;
        const int rt = u.pm * BM; const int row0 = rt + wr * 64 + fr; const int colb = u.pn * BM + wc * 64 + 8 * fq;
        const bool isk = (u.pn == 2) || (u.pn == 3) || (u.pn == 6 && wc < 2); const bool isl = rt < 65536;
        const float* sp = shw + (size_t)mi_of_tile(rt) * 2560 + colb;
        f32x4 sw[2][2], gg[2][2]; float invf[8];
#pragma unroll
        for (int bj = 0; bj < 2; ++bj)
#pragma unroll
            for (int n = 0; n < 2; ++n) { sw[bj][n] = *(const f32x4*)(sp + 32 * bj + 4 * n); gg[bj][n] = (f32x4){1.f, 1.f, 1.f, 1.f}; }
        if (isk) { const float* g = (u.pn == 6) ? ggk : gdk;
#pragma unroll
            for (int bj = 0; bj < 2; ++bj)
#pragma unroll
                for (int n = 0; n < 2; ++n) gg[bj][n] = *(const f32x4*)(g + 32 * bj + 8 * fq + 4 * n);
#pragma unroll
            for (int j = 0; j < 8; ++j) invf[j] = exp2f(-(float)((8 * fq + j) & 15) * (13.287712379549449f / 16.0f)); }
        float riv[2][4];
#pragma unroll
        for (int ai = 0; ai < 2; ++ai)
#pragma unroll
            for (int m = 0; m < 4; ++m) riv[ai][m] = ssq[row0 + ai * HALF + m * 16];
#pragma unroll
        for (int ai = 0; ai < 2; ++ai)
#pragma unroll
            for (int m = 0; m < 4; ++m) { const int row = row0 + ai * HALF + m * 16; const float ri = rinv_of(riv[ai][m], 1.0f / 1024.0f);
                f32x4 v[2][2];
#pragma unroll
                for (int bj = 0; bj < 2; ++bj)
#pragma unroll
                    for (int n = 0; n < 2; ++n) v[bj][n] = acc[ai][bj][m][n] * ri + sw[bj][n];
                if (isk) { float ss = 0.f;
#pragma unroll
                    for (int bj = 0; bj < 2; ++bj)
#pragma unroll
                        for (int n = 0; n < 2; ++n) ss += (v[bj][n][0] * v[bj][n][0] + v[bj][n][1] * v[bj][n][1]) + (v[bj][n][2] * v[bj][n][2] + v[bj][n][3] * v[bj][n][3]);
                    ss += shx32(ss, 16, ln_); ss += shx32(ss, 32, ln_);
                    const float rh = 1.0f / sqrtf(ss * (1.0f / 64.0f) + 1e-6f);
#pragma unroll
                    for (int bj = 0; bj < 2; ++bj)
#pragma unroll
                        for (int n = 0; n < 2; ++n) v[bj][n] = v[bj][n] * rh * gg[bj][n];
                    if (isl) { const int t = row & 2047; const float pos = (fq < 2) ? (float)(t >> 6) : (float)(t & 63);
#pragma unroll
                        for (int n = 0; n < 2; ++n)
#pragma unroll
                            for (int e = 0; e < 4; ++e) { float c, s; cs_rev(pos * invf[4 * n + e], c, s); const float x1 = v[0][n][e], x2 = v[1][n][e]; v[0][n][e] = x1 * c - x2 * s; v[1][n][e] = x2 * c + x1 * s; } } }
#pragma unroll
                for (int bj = 0; bj < 2; ++bj) { u32x4 w; w.x = cvt_pk_bf16(v[bj][0][0], v[bj][0][1]); w.y = cvt_pk_bf16(v[bj][0][2], v[bj][0][3]); w.z = cvt_pk_bf16(v[bj][1][0], v[bj][1][1]); w.w = cvt_pk_bf16(v[bj][1][2], v[bj][1][3]);
                    *(u32x4*)(O + (size_t)row * 1792 + colb + 32 * bj) = w; } }
    }
};
struct EpiMlaKn {
    static constexpr bool PERM = true, AFTER_DRAIN = false, HEAD64 = true;
    bf16_t* K; const float* ssq_kv; const bf16_t* KR; const float* gk;
    __device__ __forceinline__ void operator()(const f32x4 (&acc)[2][2][4][2], const Unit& u, int wr, int wc, int fr, int fq) const {
        const int ln_ = fresh_lane(); fr = ln_ & 15; fq = (ln_ >> 4) & 3;
        const int rt = u.pm * BM; const int row0 = rt + wr * 64 + fr; const int h = 4 * u.pn + wc; const bool isl = rt < 65536;
        f32x4 gg[2][2], gr[2]; float invf[8];
#pragma unroll
        for (int bj = 0; bj < 2; ++bj)
#pragma unroll
            for (int n = 0; n < 2; ++n) gg[bj][n] = *(const f32x4*)(gk + 32 * bj + 8 * fq + 4 * n);
        gr[0] = *(const f32x4*)(gk + 64 + 8 * fq); gr[1] = *(const f32x4*)(gk + 64 + 8 * fq + 4);
#pragma unroll
        for (int j = 0; j < 8; ++j) invf[j] = exp2f(-(float)j * (13.287712379549449f / 8.0f));
        float riv[2][4];
#pragma unroll
        for (int ai = 0; ai < 2; ++ai)
#pragma unroll
            for (int m = 0; m < 4; ++m) riv[ai][m] = ssq_kv[row0 + ai * HALF + m * 16];
        u32x4 kwn = *(const u32x4*)(KR + (size_t)row0 * 32 + 8 * fq);
#pragma unroll
        for (int ai = 0; ai < 2; ++ai)
#pragma unroll
            for (int m = 0; m < 4; ++m) { const int row = row0 + ai * HALF + m * 16; const float ri = rinv_of(riv[ai][m], 1.0f / 256.0f);
                const u32x4 kw = kwn; { const int nx = ai * 4 + m + 1; if (nx < 8) kwn = *(const u32x4*)(KR + (size_t)(row0 + (nx >> 2) * HALF + (nx & 3) * 16) * 32 + 8 * fq); }
                float r[8] = {__builtin_bit_cast(float, kw.x << 16), __builtin_bit_cast(float, kw.x & 0xffff0000u), __builtin_bit_cast(float, kw.y << 16), __builtin_bit_cast(float, kw.y & 0xffff0000u),
                              __builtin_bit_cast(float, kw.z << 16), __builtin_bit_cast(float, kw.z & 0xffff0000u), __builtin_bit_cast(float, kw.w << 16), __builtin_bit_cast(float, kw.w & 0xffff0000u)};
                f32x4 v[2][2]; float ss = 0.f;
#pragma unroll
                for (int bj = 0; bj < 2; ++bj)
#pragma unroll
                    for (int n = 0; n < 2; ++n) { v[bj][n] = acc[ai][bj][m][n] * ri; ss += (v[bj][n][0] * v[bj][n][0] + v[bj][n][1] * v[bj][n][1]) + (v[bj][n][2] * v[bj][n][2] + v[bj][n][3] * v[bj][n][3]); }
#pragma unroll
                for (int j = 0; j < 8; ++j) ss += r[j] * r[j];
                ss += shx32(ss, 16, ln_); ss += shx32(ss, 32, ln_);
                const float rh = 1.0f / sqrtf(ss * (1.0f / 96.0f) + 1e-6f);
#pragma unroll
                for (int bj = 0; bj < 2; ++bj)
#pragma unroll
                    for (int n = 0; n < 2; ++n) v[bj][n] = v[bj][n] * rh * gg[bj][n];
#pragma unroll
                for (int j = 0; j < 8; ++j) r[j] *= rh * gr[j >> 2][j & 3];
                if (isl) { const int t = row & 2047; const float pos = (fq & 1) ? (float)(t & 63) : (float)(t >> 6);
#pragma unroll
                    for (int j = 0; j < 8; ++j) { const float pr = shx32(r[j], 32, ln_); float c, s; cs_rev(pos * invf[j], c, s); r[j] = (fq < 2) ? (r[j] * c - pr * s) : (r[j] * c + pr * s); } }
                bf16_t* kp = K + (size_t)row * 1536 + h * 96 + 8 * fq;
#pragma unroll
                for (int bj = 0; bj < 2; ++bj) { u32x4 w; w.x = cvt_pk_bf16(v[bj][0][0], v[bj][0][1]); w.y = cvt_pk_bf16(v[bj][0][2], v[bj][0][3]); w.z = cvt_pk_bf16(v[bj][1][0], v[bj][1][1]); w.w = cvt_pk_bf16(v[bj][1][2], v[bj][1][3]);
                    *(u32x4*)(kp + 32 * bj) = w; }
                { u32x4 w; w.x = cvt_pk_bf16(r[0], r[1]); w.y = cvt_pk_bf16(r[2], r[3]); w.z = cvt_pk_bf16(r[4], r[5]); w.w = cvt_pk_bf16(r[6], r[7]); *(u32x4*)(kp + 64) = w; } }
    }
};
struct EpiResid {
    static constexpr bool PERM = true, AFTER_DRAIN = false, HEAD64 = false;
    const float* base_lat; const float* base_ctx; float* out_lat; float* out_ctx; const float* gate;
    bf16_t* AP; const float* gn; const float* scn; float* ssq;
    __device__ __forceinline__ void operator()(const f32x4 (&acc)[2][2][4][2], const Unit& u, int wr, int wc, int fr, int fq) const {
        const int ln_ = fresh_lane(); fr = ln_ & 15; fq = (ln_ >> 4) & 3;
        const int rt = u.pm * BM; const bool isl = rt < 65536; const int mi = isl ? (rt >> 11) : 32;
        const float* bp = isl ? base_lat + (size_t)rt * 1024 : base_ctx + (size_t)(rt - 65536) * 1024;
        float* op = isl ? out_lat + (size_t)rt * 1024 : out_ctx + (size_t)(rt - 65536) * 1024;
        bf16_t* ap = AP + (size_t)rt * 1024;
        const int col0 = u.pn * BM + wc * 32 + 8 * fq; const float* gp = gate + mi * 6144 + col0; const float* sp = scn + mi * 6144 + col0; const float* gnp = gn + col0;
        float ps[2][4];
#pragma unroll
        for (int ai = 0; ai < 2; ++ai)
#pragma unroll
            for (int m = 0; m < 4; ++m) ps[ai][m] = 0.f;
#pragma unroll
        for (int bj = 0; bj < 2; ++bj) { const int co = bj * HALF;
            const f32x4 gv0 = *(const f32x4*)(gp + co), gv1 = *(const f32x4*)(gp + co + 4);
            const f32x4 gs0 = *(const f32x4*)(gnp + co) * (*(const f32x4*)(sp + co) + 1.0f), gs1 = *(const f32x4*)(gnp + co + 4) * (*(const f32x4*)(sp + co + 4) + 1.0f);
#pragma unroll
            for (int ai = 0; ai < 2; ++ai) {
                f32x4 b0[4], b1[4];
#pragma unroll
                for (int m = 0; m < 4; ++m) { const size_t off = (size_t)(ai * HALF + wr * 64 + m * 16 + fr) * 1024 + col0 + co; b0[m] = *(const f32x4*)(bp + off); b1[m] = *(const f32x4*)(bp + off + 4); }
#pragma unroll
                for (int m = 0; m < 4; ++m) { const size_t off = (size_t)(ai * HALF + wr * 64 + m * 16 + fr) * 1024 + col0 + co;
                    const f32x4 o0 = b0[m] + gv0 * acc[ai][bj][m][0], o1 = b1[m] + gv1 * acc[ai][bj][m][1];
                    *(f32x4*)(op + off) = o0; *(f32x4*)(op + off + 4) = o1;
                    if (AP) { const f32x4 a0 = o0 * gs0, a1 = o1 * gs1; u32x4 w; w.x = cvt_pk_bf16(a0[0], a0[1]); w.y = cvt_pk_bf16(a0[2], a0[3]); w.z = cvt_pk_bf16(a1[0], a1[1]); w.w = cvt_pk_bf16(a1[2], a1[3]);
                        *(u32x4*)(ap + off) = w; }
                    ps[ai][m] += ((o0[0] * o0[0] + o0[1] * o0[1]) + (o0[2] * o0[2] + o0[3] * o0[3])) + ((o1[0] * o1[0] + o1[1] * o1[1]) + (o1[2] * o1[2] + o1[3] * o1[3])); }
                asm volatile("" ::: "memory"); } }
#pragma unroll
        for (int ai = 0; ai < 2; ++ai)
#pragma unroll
            for (int m = 0; m < 4; ++m) { float s = ps[ai][m];
                s += __builtin_bit_cast(float, __builtin_amdgcn_ds_bpermute((ln_ ^ 16) << 2, __builtin_bit_cast(int, s)));
                s += __builtin_bit_cast(float, __builtin_amdgcn_ds_bpermute((ln_ ^ 32) << 2, __builtin_bit_cast(int, s)));
                if (AP && fq == 0) atomicAdd(ssq + rt + ai * HALF + wr * 64 + m * 16 + fr, s); }
    }
};
struct EpiShw {
    static constexpr bool PERM = false, AFTER_DRAIN = false, HEAD64 = false;
    float* SHW;
    __device__ __forceinline__ void operator()(const f32x4 (&acc)[2][2][4][2], const Unit& u, int wr, int wc, int fr, int fq) const {
        { const int t_ = fresh_lane(); fr = t_ & 15; fq = (t_ >> 4) & 3; }
        if (wr != 0) return;
        const int L = u.pm >> 1, w = u.pm & 1; const int i2 = L >> 1;
        const int t0 = w ? (64 + L * 32) : ((L & 1) ? (32 + i2 * 16) : (i2 * 16));
        const int ld = w ? 4096 : ((L & 1) ? 1024 : 2560);
        float* dst = SHW + (size_t)L * 33 * 8192 + (w ? 33 * 4096 : 0) + (u.pn - t0) * 256 + wc * 32 + 4 * fq;
#pragma unroll
        for (int m = 0; m < 3; ++m) { const int row = m * 16 + fr; if (row < 33) {
#pragma unroll
                for (int bj = 0; bj < 2; ++bj)
#pragma unroll
                    for (int n = 0; n < 2; ++n) *(f32x4*)(dst + (size_t)row * ld + bj * HALF + n * 16) = acc[0][bj][m][n]; } }
    }
};
struct ShwOrder {
    int G, c;
    __device__ __forceinline__ bool next(int i, Unit& u) const {
        int j = i * G + c; if (j >= 92) return false;
        int L = 0; if (j >= 26) { j -= 26; L = 1; if (j >= 20) { j -= 20; L = 2; if (j >= 26) { j -= 26; L = 3; } } }
        const int nin = (L & 1) ? 4 : 10; const int i2 = L >> 1;
        if (j < nin) { u.pm = 2 * L; u.pn = ((L & 1) ? (32 + i2 * 16) : (i2 * 16)) + j; }
        else { u.pm = 2 * L + 1; u.pn = 64 + L * 32 + (j - nin); }
        return true;
    }
    __device__ __forceinline__ void a_ready(const Unit&) const {}
    __device__ __forceinline__ void done(const Unit&) const {}
};
template <class Epi, class Sched, bool ALIGN_EPI = false, bool SP2 = false>
__device__ __forceinline__ void gemm_phase(PG8_LAS unsigned char* lds, const Gemm g, const Sched& S, const Epi& E, const int wave_s) {
    int tid_ = wave_s * 64 + fresh_lane();
    const int tid = tid_, wid = __builtin_amdgcn_readfirstlane(tid >> 6), lane = tid & 63, wr = wid >> 2, wc = wid & 3, fr = lane & 15, fq = lane >> 4;
    const int K = g.K, nt = K / BK;
    unsigned voffA[2], voffB[2];
#pragma unroll
    for (int i = 0; i < 2; ++i) { int R, C; stage_rc(tid * 16 + i * 8192, R, C); const int Rb = Epi::HEAD64 ? (64 * (R >> 5) + perm32(R & 31)) : (Epi::PERM ? ((R & ~31) + perm32(R & 31)) : R);
        voffA[i] = (unsigned)(R * K + C) * 2u; voffB[i] = (unsigned)(Rb * K + C) * 2u; }
    const size_t kstep = (size_t)(BK * 2);
    const size_t hstep = (size_t)HALF * K * 2;
    const size_t hstepB = Epi::HEAD64 ? (size_t)32 * K * 2 : hstep;
    const size_t tstep = 2 * hstep;
    const unsigned ldsw = (unsigned)wid * 1024u;
    const int aoff = lds_byte(wr * 64 + fr, fq * 8), boff = lds_byte(wc * 32 + fr, fq * 8);
#define PG8_SA(b, h) (((b) * 2 + (h)) * HTB)
#define PG8_SB(b, h) ((4 + (b) * 2 + (h)) * HTB)
#define PG8_STAGE(bufoff, gbase, voff) do { _Pragma("unroll") for (int _i = 0; _i < 2; ++_i) \
        __builtin_amdgcn_global_load_lds((const unsigned*)((const char*)(gbase) + (voff)[_i]), (PG8_LAS unsigned*)(lds + (bufoff) + ldsw + _i * 8192), 16, 0, 0); } while (0)
#define PG8_LDA(dst, b, h) do { _Pragma("unroll") for (int m = 0; m < 4; ++m) _Pragma("unroll") for (int k = 0; k < 2; ++k) dst[m][k] = *(const PG8_LAS bf16x8*)(lds + PG8_SA(b, h) + aoff + m * 2048 + k * 1024); } while (0)
#define PG8_LDB(dst, b, h) do { _Pragma("unroll") for (int n = 0; n < 2; ++n) _Pragma("unroll") for (int k = 0; k < 2; ++k) dst[n][k] = *(const PG8_LAS bf16x8*)(lds + PG8_SB(b, h) + boff + n * 2048 + k * 1024); } while (0)
#define PG8_MMA(ai, bj, At, Bt) do { __builtin_amdgcn_s_setprio(1); _Pragma("unroll") for (int m = 0; m < 4; ++m) _Pragma("unroll") for (int n = 0; n < 2; ++n) _Pragma("unroll") for (int k = 0; k < 2; ++k) \
        acc[ai][bj][m][n] = __builtin_amdgcn_mfma_f32_16x16x32_bf16(Bt[n][k], At[m][k], acc[ai][bj][m][n], 0, 0, 0); __builtin_amdgcn_s_setprio(0); } while (0)
#define PG8_WAIT_V(n) asm volatile("s_waitcnt vmcnt(" #n ")" ::: "memory")
#define PG8_WAIT_L(n) asm volatile("s_waitcnt lgkmcnt(" #n ")" ::: "memory")
#define PG8_BAR __builtin_amdgcn_s_barrier()
#define PG8_SCHED __builtin_amdgcn_sched_barrier(0)
    Unit cur, nxt; int ui = 0;
    if (!S.next(0, cur)) return;
    f32x4 acc[2][2][4][2];
#pragma unroll
    for (int a = 0; a < 2; ++a)
#pragma unroll
        for (int b = 0; b < 2; ++b)
#pragma unroll
            for (int m = 0; m < 4; ++m)
#pragma unroll
                for (int n = 0; n < 2; ++n) acc[a][b][m][n] = (f32x4){0.f, 0.f, 0.f, 0.f};
    bf16x8 At[4][2], B0[2][2], B1[2][2];
    const char* cA = (const char*)g.A + (size_t)cur.pm * tstep; const char* cB = (const char*)g.Bt + (size_t)cur.pn * tstep;
    S.a_ready(cur);
    if constexpr (SP2) {
        PG8_STAGE(PG8_SB(0, 0), cB, voffB); PG8_STAGE(PG8_SB(0, 1), cB + hstepB, voffB); PG8_STAGE(PG8_SA(0, 0), cA, voffA); PG8_STAGE(PG8_SA(0, 1), cA + hstep, voffA);
        if (wr == 1) PG8_BAR;
        PG8_WAIT_V(2); PG8_BAR;
        PG8_STAGE(PG8_SB(1, 0), cB + kstep, voffB); PG8_STAGE(PG8_SA(1, 0), cA + kstep, voffA); PG8_STAGE(PG8_SB(1, 1), cB + hstepB + kstep, voffB);
        PG8_WAIT_V(6); PG8_BAR;
    } else {
        PG8_STAGE(PG8_SB(0, 0), cB, voffB); PG8_STAGE(PG8_SA(0, 0), cA, voffA); PG8_STAGE(PG8_SB(0, 1), cB + hstepB, voffB); PG8_STAGE(PG8_SA(0, 1), cA + hstep, voffA);
        if (wr == 1) PG8_BAR;
        PG8_WAIT_V(4); PG8_BAR;
        PG8_STAGE(PG8_SB(1, 0), cB + kstep, voffB); PG8_STAGE(PG8_SA(1, 0), cA + kstep, voffA); PG8_STAGE(PG8_SB(1, 1), cB + hstepB + kstep, voffB);
        PG8_WAIT_V(6); PG8_BAR;
    }
    for (;;) {
        const bool has_next = S.next(ui + 1, nxt);
        const char* nA = has_next ? (const char*)g.A + (size_t)nxt.pm * tstep : cA; const char* nB = has_next ? (const char*)g.Bt + (size_t)nxt.pn * tstep : cB;
        for (int t = 0; t < nt; t += 2) {
            const bool last = (t == nt - 2);
            const char* a1 = cA + (size_t)(t + 1) * kstep;
            const char* a2 = last ? nA : cA + (size_t)(t + 2) * kstep; const char* b2 = last ? nB : cB + (size_t)(t + 2) * kstep;
            const char* a3 = a2 + kstep; const char* b3 = b2 + kstep;
            if (last && has_next) S.a_ready(nxt);
            if constexpr (SP2) {
            PG8_LDB(B0, 0, 0); PG8_LDB(B1, 0, 1); PG8_SCHED; PG8_LDA(At, 0, 0); PG8_STAGE(PG8_SA(1, 1), a1 + hstep, voffA);
            PG8_WAIT_V(8); PG8_WAIT_L(0); PG8_BAR; PG8_MMA(0, 0, At, B0); PG8_MMA(0, 1, At, B1); PG8_BAR; PG8_SCHED;
            PG8_LDA(At, 0, 1); PG8_STAGE(PG8_SB(0, 0), b2, voffB); PG8_STAGE(PG8_SB(0, 1), b2 + hstepB, voffB); PG8_STAGE(PG8_SA(0, 0), a2, voffA);
            PG8_WAIT_V(8); PG8_WAIT_L(0); PG8_BAR; PG8_MMA(1, 0, At, B0); PG8_MMA(1, 1, At, B1); PG8_BAR; PG8_SCHED;
            PG8_LDB(B0, 1, 0); PG8_LDB(B1, 1, 1); PG8_SCHED; PG8_LDA(At, 1, 0); PG8_STAGE(PG8_SA(0, 1), a2 + hstep, voffA);
            PG8_WAIT_V(8); PG8_WAIT_L(0); PG8_BAR; PG8_MMA(0, 0, At, B0); PG8_MMA(0, 1, At, B1); PG8_BAR; PG8_SCHED;
            PG8_LDA(At, 1, 1); PG8_STAGE(PG8_SB(1, 0), b3, voffB); PG8_STAGE(PG8_SB(1, 1), b3 + hstepB, voffB); PG8_STAGE(PG8_SA(1, 0), a3, voffA);
            PG8_WAIT_V(8); PG8_WAIT_L(0); PG8_BAR; PG8_MMA(1, 0, At, B0); PG8_MMA(1, 1, At, B1); PG8_BAR; PG8_SCHED;
            } else {
            PG8_LDB(B0, 0, 0); PG8_SCHED; PG8_LDA(At, 0, 0); PG8_STAGE(PG8_SA(1, 1), a1 + hstep, voffA);
            PG8_WAIT_L(8); PG8_BAR; PG8_WAIT_L(0); PG8_MMA(0, 0, At, B0); PG8_BAR; PG8_SCHED;
            PG8_LDB(B1, 0, 1); PG8_STAGE(PG8_SB(0, 0), b2, voffB);
            PG8_BAR; PG8_WAIT_L(0); PG8_MMA(0, 1, At, B1); PG8_BAR;
            PG8_LDA(At, 0, 1); PG8_STAGE(PG8_SA(0, 0), a2, voffA);
            PG8_BAR; PG8_WAIT_L(0); PG8_MMA(1, 0, At, B0); PG8_BAR; PG8_SCHED;
            PG8_STAGE(PG8_SB(0, 1), b2 + hstepB, voffB);
            PG8_WAIT_V(6); PG8_BAR; PG8_MMA(1, 1, At, B1); PG8_BAR;
            PG8_LDB(B0, 1, 0); PG8_SCHED; PG8_LDA(At, 1, 0); PG8_STAGE(PG8_SA(0, 1), a2 + hstep, voffA);
            PG8_WAIT_L(8); PG8_BAR; PG8_WAIT_L(0); PG8_MMA(0, 0, At, B0); PG8_BAR; PG8_SCHED;
            PG8_LDB(B1, 1, 1); PG8_STAGE(PG8_SB(1, 0), b3, voffB);
            PG8_BAR; PG8_WAIT_L(0); PG8_MMA(0, 1, At, B1); PG8_BAR;
            PG8_LDA(At, 1, 1); PG8_STAGE(PG8_SA(1, 0), a3, voffA);
            PG8_BAR; PG8_WAIT_L(0); PG8_MMA(1, 0, At, B0); PG8_BAR; PG8_SCHED;
            PG8_STAGE(PG8_SB(1, 1), b3 + hstepB, voffB);
            PG8_WAIT_V(6); PG8_BAR; PG8_MMA(1, 1, At, B1); PG8_BAR;
            }
        }
        if constexpr (ALIGN_EPI) { if (wr == 0) PG8_BAR; }
        if constexpr (!Epi::AFTER_DRAIN) { E(acc, cur, wr, wc, fr, fq); S.done(cur); }
        if (!has_next) break;
#pragma unroll
        for (int a = 0; a < 2; ++a)
#pragma unroll
            for (int b = 0; b < 2; ++b)
#pragma unroll
                for (int m = 0; m < 4; ++m)
#pragma unroll
                    for (int n = 0; n < 2; ++n) acc[a][b][m][n] = (f32x4){0.f, 0.f, 0.f, 0.f};
        cur = nxt; cA = nA; cB = nB; ++ui;
        if constexpr (ALIGN_EPI) { if (wr == 1) PG8_BAR; }
    }
    PG8_WAIT_V(0);
    if constexpr (!ALIGN_EPI) { if (wr == 0) PG8_BAR; }
    PG8_BAR;
    if constexpr (Epi::AFTER_DRAIN) { E.fused(acc, cur, wr, wc, fr, fq, lds, wid, lane); S.done(cur); }
#undef PG8_SA
#undef PG8_SB
#undef PG8_STAGE
#undef PG8_LDA
#undef PG8_LDB
#undef PG8_MMA
#undef PG8_WAIT_V
#undef PG8_WAIT_L
#undef PG8_BAR
#undef PG8_SCHED
}
}

#define LAS __attribute__((address_space(3)))
typedef unsigned short bf16;
typedef short bf16x8 __attribute__((ext_vector_type(8)));
typedef float f32x4 __attribute__((ext_vector_type(4)));
typedef float f32x2 __attribute__((ext_vector_type(2)));
typedef float f32x16 __attribute__((ext_vector_type(16)));
typedef unsigned u32x4 __attribute__((ext_vector_type(4)));
typedef unsigned u32x2 __attribute__((ext_vector_type(2)));

constexpr int NWAVES = 8, NTHR = 512;
constexpr int NLAT = 65536, NCTX = 8192, R = NLAT + NCTX;
constexpr int D = 1024, FF = 4096, KV = 2304;
constexpr float EPS = 1e-6f, LOG2E = 1.4426950408889634f;
constexpr size_t MiB = 1u << 20;
constexpr size_t WS_MOD = 0, WS_W = 4 * MiB, WS_XCTX = 100 * MiB, WS_H = 132 * MiB, WS_R = 276 * MiB, WS_CTL = 996 * MiB, WS_SSQ = 997 * MiB, WS_SHB = 998 * MiB, WS_SHW = 1002 * MiB, WS_SSQM = 1007 * MiB, WS_END = 1008 * MiB;
constexpr size_t CTL_BYTES = 16384;
constexpr int MISC_OFF = 147456 - 64;
constexpr int LDS_BYTES = 147456;
constexpr int RAWP = 1792;
constexpr int MQP = 1536;

__device__ __forceinline__ unsigned f2bf(float f) { unsigned u = __builtin_bit_cast(unsigned, f); return (u + 0x7fffu + ((u >> 16) & 1u)) >> 16; }
__device__ __forceinline__ unsigned pk2(float lo, float hi) { return f2bf(lo) | (f2bf(hi) << 16); }
typedef __bf16 bf16x2_t __attribute__((ext_vector_type(2)));
__device__ __forceinline__ unsigned cvtpk_nv(float lo, float hi) { f32x2 v = {lo, hi}; bf16x2_t b = __builtin_convertvector(v, bf16x2_t); return __builtin_bit_cast(unsigned, b); }
__device__ __forceinline__ float bflo(unsigned u) { return __builtin_bit_cast(float, u << 16); }
__device__ __forceinline__ float bfhi(unsigned u) { return __builtin_bit_cast(float, u & 0xffff0000u); }
__device__ __forceinline__ float shx(float v, int o, int lane) { return __builtin_bit_cast(float, __builtin_amdgcn_ds_bpermute((lane ^ o) << 2, __builtin_bit_cast(int, v))); }
__device__ __forceinline__ float wave_sum(float v, int lane) {
#pragma unroll
    for (int o = 1; o < 64; o <<= 1) v += shx(v, o, lane);
    return v;
}
__device__ __forceinline__ float wave_max(float v, int lane) {
#pragma unroll
    for (int o = 1; o < 64; o <<= 1) v = fmaxf(v, shx(v, o, lane));
    return v;
}
__device__ __forceinline__ void cs_of(float a, float& c, float& s) {
    double rev = (double)a * 0.15915494309189535; rev -= floor(rev); const float rf = (float)rev;
    c = __builtin_amdgcn_cosf(rf); s = __builtin_amdgcn_sinf(rf);
}

__device__ __forceinline__ void xpose_item(const float* W, int srcN, int scol, bf16* WT, int K, int drow, LAS float* scr, int k0, int lane) {
#pragma unroll 8
    for (int i = 0; i < 32; ++i) { const int kk = 2 * i + (lane >> 5); scr[kk * 33 + (lane & 31)] = W[(size_t)(k0 + kk) * srcN + scol + (lane & 31)]; }
    asm volatile("s_waitcnt lgkmcnt(0)" ::: "memory");
    const int c = lane & 7;
#pragma unroll
    for (int j = 0; j < 4; ++j) { const int n = (lane >> 3) + 8 * j; const LAS float* s = scr + (8 * c) * 33 + n;
        u32x4 o; o.x = pk2(s[0 * 33], s[1 * 33]); o.y = pk2(s[2 * 33], s[3 * 33]); o.z = pk2(s[4 * 33], s[5 * 33]); o.w = pk2(s[6 * 33], s[7 * 33]);
        *(u32x4*)(WT + (size_t)(drow + n) * K + k0 + 8 * c) = o; }
    asm volatile("s_waitcnt lgkmcnt(0)" ::: "memory");
}
__device__ __forceinline__ void xpose_seg(const float* W, int K, int srcN, int scol0, int ncols, bool hs, bf16* WT, int drow0, LAS float* scr, int gw, int NGW, int& cur, int lane) {
    const int nblk = ncols / 32, nit = (K / 64) * nblk;
    int it = gw - cur; if (it < 0) it += NGW;
    for (; it < nit; it += NGW) { const int kb = it / nblk, nb = it % nblk; const int sc = scol0 + (hs ? ((nb >> 1) * 128 + (nb & 1) * 32) : nb * 32);
        xpose_item(W, srcN, sc, WT, K, drow0 + nb * 32, scr, kb * 64, lane); }
    cur = (cur + nit) % NGW;
}
__device__ __forceinline__ void zero_rows(bf16* WT, int K, int row0, int nrows, int gw, int NGW, int lane) {
    const int n16 = nrows * K / 8; u32x4* p = (u32x4*)(WT + (size_t)row0 * K); const u32x4 z = {0u, 0u, 0u, 0u};
    for (int i = gw * 64 + lane; i < n16; i += NGW * 64) p[i] = z;
}

__device__ __forceinline__ void norm_phase(const float* xlat, const float* xctx, const float* g, const float* modl, int sh_off, int sc_off, bf16* H, int vcu, int NGW, int wave_s) {
    const int lane = fresh_lane(); const int gw = vcu * NWAVES + wave_s;
    f32x4 g4[4];
#pragma unroll
    for (int j = 0; j < 4; ++j) g4[j] = *(const f32x4*)(g + 256 * j + 4 * lane);
    for (int r0 = gw; r0 < R; r0 += 2 * NGW) {
        const int r1 = r0 + NGW; const bool has1 = r1 < R;
        const float* xr0 = (r0 < NLAT) ? xlat + (size_t)r0 * D : xctx + (size_t)(r0 - NLAT) * D;
        const float* xr1 = has1 ? ((r1 < NLAT) ? xlat + (size_t)r1 * D : xctx + (size_t)(r1 - NLAT) * D) : xr0;
        f32x4 v0[4], v1[4]; float s0 = 0.f, s1 = 0.f;
#pragma unroll
        for (int j = 0; j < 4; ++j) { v0[j] = *(const f32x4*)(xr0 + 256 * j + 4 * lane); v1[j] = *(const f32x4*)(xr1 + 256 * j + 4 * lane); }
#pragma unroll
        for (int j = 0; j < 4; ++j) { s0 += (v0[j].x * v0[j].x + v0[j].y * v0[j].y) + (v0[j].z * v0[j].z + v0[j].w * v0[j].w); s1 += (v1[j].x * v1[j].x + v1[j].y * v1[j].y) + (v1[j].z * v1[j].z + v1[j].w * v1[j].w); }
        const float ri0 = 1.0f / sqrtf(wave_sum(s0, lane) * (1.0f / D) + EPS), ri1 = 1.0f / sqrtf(wave_sum(s1, lane) * (1.0f / D) + EPS);
        const float* mp0 = modl + ((r0 < NLAT) ? (r0 >> 11) : 32) * 6144; const float* mp1 = modl + ((r1 < NLAT) ? (r1 >> 11) : 32) * 6144;
#pragma unroll
        for (int j = 0; j < 4; ++j) { const int c = 256 * j + 4 * lane; const f32x4 sc = *(const f32x4*)(mp0 + sc_off + c), sh = *(const f32x4*)(mp0 + sh_off + c);
            const f32x4 y = (v0[j] * ri0 * g4[j]) * (sc + 1.0f) + sh; u32x2 w; w.x = pk2(y.x, y.y); w.y = pk2(y.z, y.w);
            *(u32x2*)(H + (size_t)r0 * D + c) = w; }
        if (has1) {
#pragma unroll
            for (int j = 0; j < 4; ++j) { const int c = 256 * j + 4 * lane; const f32x4 sc = *(const f32x4*)(mp1 + sc_off + c), sh = *(const f32x4*)(mp1 + sh_off + c);
                const f32x4 y = (v1[j] * ri1 * g4[j]) * (sc + 1.0f) + sh; u32x2 w; w.x = pk2(y.x, y.y); w.y = pk2(y.z, y.w);
                *(u32x2*)(H + (size_t)r1 * D + c) = w; }
        }
    }
}
__device__ __forceinline__ void prep_phase(const float* xlat, const float* xctx, const float* g, const float* modl, int sc_off, bf16* AP, float* ssq, int vcu, int NGW, int wave_s) {
    const int lane = fresh_lane(); const int gw = vcu * NWAVES + wave_s;
    f32x4 g4[4];
#pragma unroll
    for (int j = 0; j < 4; ++j) g4[j] = *(const f32x4*)(g + 256 * j + 4 * lane);
    for (int r0 = gw; r0 < R; r0 += 2 * NGW) {
        const int r1 = r0 + NGW; const bool has1 = r1 < R;
        const float* xr0 = (r0 < NLAT) ? xlat + (size_t)r0 * D : xctx + (size_t)(r0 - NLAT) * D;
        const float* xr1 = has1 ? ((r1 < NLAT) ? xlat + (size_t)r1 * D : xctx + (size_t)(r1 - NLAT) * D) : xr0;
        f32x4 v0[4], v1[4]; float s0 = 0.f, s1 = 0.f;
#pragma unroll
        for (int j = 0; j < 4; ++j) { v0[j] = *(const f32x4*)(xr0 + 256 * j + 4 * lane); v1[j] = *(const f32x4*)(xr1 + 256 * j + 4 * lane); }
#pragma unroll
        for (int j = 0; j < 4; ++j) { s0 += (v0[j].x * v0[j].x + v0[j].y * v0[j].y) + (v0[j].z * v0[j].z + v0[j].w * v0[j].w); s1 += (v1[j].x * v1[j].x + v1[j].y * v1[j].y) + (v1[j].z * v1[j].z + v1[j].w * v1[j].w); }
        s0 = wave_sum(s0, lane); s1 = wave_sum(s1, lane);
        const float* mp0 = modl + ((r0 < NLAT) ? (r0 >> 11) : 32) * 6144; const float* mp1 = modl + ((r1 < NLAT) ? (r1 >> 11) : 32) * 6144;
#pragma unroll
        for (int j = 0; j < 4; ++j) { const int c = 256 * j + 4 * lane; const f32x4 sc = *(const f32x4*)(mp0 + sc_off + c);
            const f32x4 y = (v0[j] * g4[j]) * (sc + 1.0f); u32x2 w; w.x = pk2(y.x, y.y); w.y = pk2(y.z, y.w);
            *(u32x2*)(AP + (size_t)r0 * D + c) = w; }
        if (lane == 0) ssq[r0] = s0;
        if (has1) {
#pragma unroll
            for (int j = 0; j < 4; ++j) { const int c = 256 * j + 4 * lane; const f32x4 sc = *(const f32x4*)(mp1 + sc_off + c);
                const f32x4 y = (v1[j] * g4[j]) * (sc + 1.0f); u32x2 w; w.x = pk2(y.x, y.y); w.y = pk2(y.z, y.w);
                *(u32x2*)(AP + (size_t)r1 * D + c) = w; }
            if (lane == 0) ssq[r1] = s1;
        }
    }
}
__device__ __forceinline__ void zero_f32(float* p, int n, int vcu, int NGW, int wave_s) {
    const int lane = fresh_lane(); const int gw = vcu * NWAVES + wave_s;
    for (int i = gw * 64 + lane; i < n; i += NGW * 64) p[i] = 0.f;
}
__device__ __forceinline__ void mlanorm_phase(const bf16* MRAW, const float* gq, const float* gkv, bf16* QCn, bf16* KVCn, int vcu, int NGW, int wave_s) {
    const int lane = fresh_lane(); const int gw = vcu * NWAVES + wave_s;
    u32x4 na = {0u, 0u, 0u, 0u}; u32x2 nb = {0u, 0u};
    if (gw < R) { na = *(const u32x4*)(MRAW + (size_t)gw * 1024 + 8 * lane); nb = *(const u32x2*)(MRAW + (size_t)gw * 1024 + 512 + 4 * lane); }
    for (int r = gw; r < R; r += NGW) {
        const bf16* row = MRAW + (size_t)r * 1024;
        const u32x4 a = na; const u32x2 b = nb;
        if (r + NGW < R) { na = *(const u32x4*)(row + (size_t)NGW * 1024 + 8 * lane); nb = *(const u32x2*)(row + (size_t)NGW * 1024 + 512 + 4 * lane); }
        float x[8] = {bflo(a.x), bfhi(a.x), bflo(a.y), bfhi(a.y), bflo(a.z), bfhi(a.z), bflo(a.w), bfhi(a.w)}; float y[4] = {bflo(b.x), bfhi(b.x), bflo(b.y), bfhi(b.y)};
        float s1 = 0.f, s2 = 0.f;
#pragma unroll
        for (int e = 0; e < 8; ++e) s1 += x[e] * x[e];
#pragma unroll
        for (int e = 0; e < 4; ++e) s2 += y[e] * y[e];
        const float r1 = 1.0f / sqrtf(wave_sum(s1, lane) * (1.0f / 512) + EPS), r2 = 1.0f / sqrtf(wave_sum(s2, lane) * (1.0f / 256) + EPS);
        const f32x4 g0 = *(const f32x4*)(gq + 8 * lane), g1 = *(const f32x4*)(gq + 8 * lane + 4), g2 = *(const f32x4*)(gkv + 4 * lane);
        u32x4 o; o.x = pk2(x[0] * r1 * g0.x, x[1] * r1 * g0.y); o.y = pk2(x[2] * r1 * g0.z, x[3] * r1 * g0.w); o.z = pk2(x[4] * r1 * g1.x, x[5] * r1 * g1.y); o.w = pk2(x[6] * r1 * g1.z, x[7] * r1 * g1.w);
        *(u32x4*)(QCn + (size_t)r * 512 + 8 * lane) = o;
        u32x2 p; p.x = pk2(y[0] * r2 * g2.x, y[1] * r2 * g2.y); p.y = pk2(y[2] * r2 * g2.z, y[3] * r2 * g2.w);
        *(u32x2*)(KVCn + (size_t)r * 256 + 4 * lane) = p;
    }
}
__device__ __forceinline__ void post_even(bf16* RAW, const float* gdq, const float* gdk, const float* ggq, const float* ggk, int vcu, int NGW, int wave_s) {
    const int lane = fresh_lane(); const int gw = vcu * NWAVES + wave_s;
    const int sub = lane & 15; const float L2T = 13.287712379549449f;
    float invf[4];
#pragma unroll
    for (int e = 0; e < 4; ++e) { const int jj = 4 * (sub & 7) + e; invf[e] = exp2f(-(float)(jj & 15) * (1.0f / 16.0f) * L2T); }
    f32x4 G[4]; G[0] = *(const f32x4*)(gdq + 4 * sub); G[1] = *(const f32x4*)(gdk + 4 * sub); G[2] = *(const f32x4*)(ggq + 4 * sub); G[3] = *(const f32x4*)(ggk + 4 * sub);
    u32x2 nx[7];
    if (gw < R) {
#pragma unroll
        for (int c = 0; c < 7; ++c) if (c == 2 || c == 3 || c == 6) nx[c] = *(const u32x2*)(RAW + (size_t)gw * RAWP + 256 * c + 4 * lane); }
    for (int r = gw; r < R; r += NGW) {
        const bool isl = r < NLAT; const int t = r & 2047; const float prow = (float)(t >> 6), pcol = (float)(t & 63);
        float cs[4], sn[4];
#pragma unroll
        for (int e = 0; e < 4; ++e) { if (isl) { const int jj = 4 * (sub & 7) + e; cs_of((jj < 16 ? prow : pcol) * invf[e], cs[e], sn[e]); } else { cs[e] = 1.f; sn[e] = 0.f; } }
        bf16* row = RAW + (size_t)r * RAWP;
        u32x2 av[7];
#pragma unroll
        for (int c = 0; c < 7; ++c) if (c == 2 || c == 3 || c == 6) av[c] = nx[c];
        if (r + NGW < R) {
#pragma unroll
            for (int c = 0; c < 7; ++c) if (c == 2 || c == 3 || c == 6) nx[c] = *(const u32x2*)(row + (size_t)NGW * RAWP + 256 * c + 4 * lane); }
#pragma unroll
        for (int c = 0; c < 7; ++c) { if (!(c == 2 || c == 3 || c == 6)) continue;
            const u32x2 a = av[c];
            float x[4] = {bflo(a.x), bfhi(a.x), bflo(a.y), bfhi(a.y)};
            float ss = (x[0] * x[0] + x[1] * x[1]) + (x[2] * x[2] + x[3] * x[3]);
            ss += shx(ss, 1, lane); ss += shx(ss, 2, lane); ss += shx(ss, 4, lane); ss += shx(ss, 8, lane);
            const float rinv = 1.0f / sqrtf(ss * (1.0f / 64) + EPS);
            const f32x4 g4 = G[c < 2 ? 0 : (c < 4 ? 1 : (c < 6 ? 2 : 3))];
            const float qs = (c < 2 || c == 4 || c == 5) ? 0.125f * LOG2E : 1.0f;
            float y[4] = {x[0] * rinv * g4.x, x[1] * rinv * g4.y, x[2] * rinv * g4.z, x[3] * rinv * g4.w}; float o[4];
#pragma unroll
            for (int e = 0; e < 4; ++e) { const float py = shx(y[e], 8, lane); o[e] = ((sub < 8) ? (y[e] * cs[e] - py * sn[e]) : (y[e] * cs[e] + py * sn[e])) * qs; }
            u32x2 w; w.x = pk2(o[0], o[1]); w.y = pk2(o[2], o[3]);
            *(u32x2*)(row + 256 * c + 4 * lane) = w;
        }
    }
}
__device__ __forceinline__ void post_mla(bf16* Q, bf16* Kb, const bf16* MRAW, const float* gq, const float* gk, int vcu, int NGW, int wave_s) {
    const int lane = fresh_lane(); const int gw = vcu * NWAVES + wave_s;
    const int i = lane & 31, half = lane >> 5; const float L2T = 13.287712379549449f;
    float invf[2];
#pragma unroll
    for (int e = 0; e < 2; ++e) { const int jj = (2 * i + e) & 15; invf[e] = exp2f(-(float)(jj & 7) * (1.0f / 8.0f) * L2T); }
    const f32x2 gqa = *(const f32x2*)(gq + 2 * i), gqb = *(const f32x2*)(gq + 64 + 2 * (i & 15)), gka = *(const f32x2*)(gk + 2 * i), gkb = *(const f32x2*)(gk + 64 + 2 * (i & 15));
    const float qs = 0.10206207261596577f * LOG2E;
    unsigned na[2][8], nb[8], nkr = 0u;
#define MLA_LOAD(rr) do { _Pragma("unroll") for (int p = 0; p < 8; ++p) { na[0][p] = 0u; na[1][p] = *(const unsigned*)(Kb + (size_t)(rr) * MQP + (2 * p + half) * 96 + 2 * i); nb[p] = 0u; } \
        nkr = (i < 16) ? *(const unsigned*)(MRAW + (size_t)(rr) * 32 + 2 * i) : 0u; } while (0)
    if (gw < R) MLA_LOAD(gw);
    for (int r = gw; r < R; r += NGW) {
        const bool isl = r < NLAT; const int t = r & 2047; const float prow = (float)(t >> 6), pcol = (float)(t & 63);
        float cs[2], sn[2];
#pragma unroll
        for (int e = 0; e < 2; ++e) { if (isl) { const int jj = (2 * i + e) & 15; cs_of((jj < 8 ? prow : pcol) * invf[e], cs[e], sn[e]); } else { cs[e] = 1.f; sn[e] = 0.f; } }
        unsigned la[2][8], lb[8];
#pragma unroll
        for (int p = 0; p < 8; ++p) { la[0][p] = na[0][p]; la[1][p] = na[1][p]; lb[p] = nb[p]; }
        const unsigned krw = nkr;
        if (r + NGW < R) { const int rn = r + NGW; MLA_LOAD(rn); }
#pragma unroll
        for (int isk = 1; isk < 2; ++isk) {
            bf16* base = (isk ? Kb : Q) + (size_t)r * MQP; const f32x2 ga = isk ? gka : gqa, gb = isk ? gkb : gqb; const float sc = isk ? 1.0f : qs;
#pragma unroll
            for (int p = 0; p < 8; ++p) {
                bf16* hp = base + (2 * p + half) * 96;
                const unsigned a = la[isk][p];
                const unsigned b = isk ? krw : lb[p];
                const float a0 = bflo(a), a1 = bfhi(a), b0 = bflo(b), b1 = bfhi(b);
                float ss = (a0 * a0 + a1 * a1) + (b0 * b0 + b1 * b1);
                ss += shx(ss, 1, lane); ss += shx(ss, 2, lane); ss += shx(ss, 4, lane); ss += shx(ss, 8, lane); ss += shx(ss, 16, lane);
                const float rinv = 1.0f / sqrtf(ss * (1.0f / 96) + EPS);
                const float y0 = b0 * rinv * gb.x, y1 = b1 * rinv * gb.y; const float p0 = shx(y0, 8, lane), p1 = shx(y1, 8, lane);
                const float o0 = (i < 8) ? (y0 * cs[0] - p0 * sn[0]) : (y0 * cs[0] + p0 * sn[0]);
                const float o1 = (i < 8) ? (y1 * cs[1] - p1 * sn[1]) : (y1 * cs[1] + p1 * sn[1]);
                *(unsigned*)(hp + 2 * i) = pk2(a0 * rinv * ga.x * sc, a1 * rinv * ga.y * sc);
                if (i < 16) *(unsigned*)(hp + 64 + 2 * i) = pk2(o0 * sc, o1 * sc);
            }
        }
    }
}

#undef MLA_LOAD
template <int DQK>
__device__ __forceinline__ void q_prep(bf16x8 (&qf)[DQK / 16], const float* gq, int row, float qs, int lane) {
    constexpr int NKS = DQK / 16; const int hh = lane >> 5; const float L2T = 13.287712379549449f;
    float x[NKS][8]; float ss = 0.f;
#pragma unroll
    for (int ks = 0; ks < NKS; ++ks)
#pragma unroll
        for (int e = 0; e < 8; ++e) { x[ks][e] = __builtin_bit_cast(float, ((unsigned)(unsigned short)qf[ks][e]) << 16); ss += x[ks][e] * x[ks][e]; }
    ss += shx(ss, 32, lane);
    const float rinv = 1.0f / sqrtf(ss * (1.0f / DQK) + EPS);
#pragma unroll
    for (int ks = 0; ks < NKS; ++ks) { const f32x4 g0 = *(const f32x4*)(gq + 16 * ks + 8 * hh), g1 = *(const f32x4*)(gq + 16 * ks + 8 * hh + 4);
        x[ks][0] *= rinv * g0.x; x[ks][1] *= rinv * g0.y; x[ks][2] *= rinv * g0.z; x[ks][3] *= rinv * g0.w; x[ks][4] *= rinv * g1.x; x[ks][5] *= rinv * g1.y; x[ks][6] *= rinv * g1.z; x[ks][7] *= rinv * g1.w; }
    if (row < NLAT) { const int t = row & 2047; const float prow = (float)(t >> 6), pcol = (float)(t & 63);
        if (DQK == 64) {
#pragma unroll
            for (int e = 0; e < 8; ++e) { const float invf = exp2f(-(float)(8 * hh + e) * (1.0f / 16.0f) * L2T); float c0, s0, c1, s1; cs_of(prow * invf, c0, s0); cs_of(pcol * invf, c1, s1);
                const float a0 = x[0][e], b0 = x[2][e], a1 = x[1][e], b1 = x[3][e];
                x[0][e] = a0 * c0 - b0 * s0; x[2][e] = b0 * c0 + a0 * s0; x[1][e] = a1 * c1 - b1 * s1; x[3][e] = b1 * c1 + a1 * s1; }
        } else {
#pragma unroll
            for (int e = 0; e < 8; ++e) { const float invf = exp2f(-(float)e * (1.0f / 8.0f) * L2T); float c, s; cs_of((hh ? pcol : prow) * invf, c, s);
                const float a = x[NKS - 2][e], b = x[NKS - 1][e]; x[NKS - 2][e] = a * c - b * s; x[NKS - 1][e] = b * c + a * s; }
        } }
#pragma unroll
    for (int ks = 0; ks < NKS; ++ks) { u32x4 w; w.x = pk2(x[ks][0] * qs, x[ks][1] * qs); w.y = pk2(x[ks][2] * qs, x[ks][3] * qs); w.z = pk2(x[ks][4] * qs, x[ks][5] * qs); w.w = pk2(x[ks][6] * qs, x[ks][7] * qs);
        qf[ks] = __builtin_bit_cast(bf16x8, w); }
}
template <int DQK, int DV, bool PIPE>
__device__ __forceinline__ void attn_pass(LAS unsigned char* lds, const bf16* Qw, int qpitch, const bf16* Kctx, const bf16* Klat, int kpitch, const bf16* VT, int ntiles, const float* gq, int qrow0, float qs,
                                          f32x16 (&o)[DV / 32], float& lsum, const int wave_s) {
    constexpr int KSTR = DQK * 2 + 16, VSTR = 144, KBYTES = 64 * KSTR, VBYTES = DV * VSTR, KC = DQK / 8, NKS = DQK / 16, NDB = DV / 32, NV = 4 * NDB;
    const int lane = fresh_lane(), tid = wave_s * 64 + lane, i = lane & 31, hh = lane >> 5;
    bf16x8 qf[NKS];
#pragma unroll
    for (int ks = 0; ks < NKS; ++ks) qf[ks] = *(const bf16x8*)(Qw + (size_t)i * qpitch + 16 * ks + 8 * hh);
    q_prep<DQK>(qf, gq, qrow0 + i, qs, lane);
#pragma unroll
    for (int db = 0; db < NDB; ++db)
#pragma unroll
        for (int r = 0; r < 16; ++r) o[db][r] = 0.f;
    lsum = 0.f;
    const int kc0 = tid, kc1 = tid + 512; const bool k2 = (DQK == 96) && (tid < 256);
    const int kr0 = kc0 / KC, kcc0 = kc0 % KC, kr1 = kc1 / KC, kcc1 = kc1 % KC;
    const int vd0 = tid >> 3, vc0 = tid & 7;
    u32x4 kreg0, kreg1 = {0u, 0u, 0u, 0u}, vreg0, vreg1 = {0u, 0u, 0u, 0u};
    constexpr bool TPB2 = (!PIPE) && (NV == 8);
    LAS unsigned char* const Kl = lds; LAS unsigned char* const Vl = lds + (TPB2 ? 4 : 2) * KBYTES;
    const int kfo = i * KSTR + 16 * hh, vfo = i * VSTR + 16 * hh;
    const unsigned koff0 = (unsigned)(kr0 * kpitch + 8 * kcc0) * 2u, koff1 = (unsigned)(kr1 * kpitch + 8 * kcc1) * 2u;
    const unsigned voff0 = (unsigned)(vd0 * KV + 8 * vc0) * 2u, voff1 = (unsigned)((vd0 + 64) * KV + 8 * vc0) * 2u;
#define AT_LOADK(t) do { const char* kt = (const char*)(((t) < 4) ? Kctx + (size_t)(64 * (t)) * kpitch : Klat + (size_t)(64 * ((t) - 4)) * kpitch); \
        kreg0 = *(const u32x4*)(kt + koff0); if (k2) kreg1 = *(const u32x4*)(kt + koff1); } while (0)
#define AT_LOADV(t) do { const char* vt_ = (const char*)(VT + 64 * (t)); vreg0 = *(const u32x4*)(vt_ + voff0); if (DV == 128) vreg1 = *(const u32x4*)(vt_ + voff1); } while (0)
#define AT_WRITEK(bufi) do { LAS unsigned char* kb_ = Kl + (bufi) * KBYTES; *(LAS u32x4*)(kb_ + kr0 * KSTR + 16 * kcc0) = kreg0; if (k2) *(LAS u32x4*)(kb_ + kr1 * KSTR + 16 * kcc1) = kreg1; } while (0)
#define AT_WRITEV(bufi) do { LAS unsigned char* vb_ = Vl + (bufi) * VBYTES; *(LAS u32x4*)(vb_ + vd0 * VSTR + 16 * vc0) = vreg0; if (DV == 128) *(LAS u32x4*)(vb_ + (vd0 + 64) * VSTR + 16 * vc0) = vreg1; } while (0)
    u32x4 kregB0, kregB1 = {0u, 0u, 0u, 0u}, vregB0;
#define AT_LOADKB(t) do { const char* kt = (const char*)(((t) < 4) ? Kctx + (size_t)(64 * (t)) * kpitch : Klat + (size_t)(64 * ((t) - 4)) * kpitch); \
        kregB0 = *(const u32x4*)(kt + koff0); if (k2) kregB1 = *(const u32x4*)(kt + koff1); } while (0)
#define AT_LOADVB(t) do { const char* vt_ = (const char*)(VT + 64 * (t)); vregB0 = *(const u32x4*)(vt_ + voff0); } while (0)
#define AT_WRITEKB(bufi) do { LAS unsigned char* kb_ = Kl + (bufi) * KBYTES; *(LAS u32x4*)(kb_ + kr0 * KSTR + 16 * kcc0) = kregB0; if (k2) *(LAS u32x4*)(kb_ + kr1 * KSTR + 16 * kcc1) = kregB1; } while (0)
#define AT_WRITEVB(bufi) do { LAS unsigned char* vb_ = Vl + (bufi) * VBYTES; *(LAS u32x4*)(vb_ + vd0 * VSTR + 16 * vc0) = vregB0; } while (0)
#define AT_KFRAGS(bufi) do { const LAS unsigned char* Kb = Kl + (bufi) * KBYTES + kfo; \
        _Pragma("unroll") for (int ks = 0; ks < NKS; ++ks) { kf[2 * ks] = *(const LAS bf16x8*)(Kb + 32 * ks); kf[2 * ks + 1] = *(const LAS bf16x8*)(Kb + 32 * KSTR + 32 * ks); } } while (0)
#define AT_QKM(P0, P1) do { _Pragma("unroll") for (int r = 0; r < 16; ++r) { P0[r] = 0.f; P1[r] = 0.f; } \
        _Pragma("unroll") for (int ks = 0; ks < NKS; ++ks) { P0 = __builtin_amdgcn_mfma_f32_32x32x16_bf16(kf[2 * ks], qf[ks], P0, 0, 0, 0); \
            P1 = __builtin_amdgcn_mfma_f32_32x32x16_bf16(kf[2 * ks + 1], qf[ks], P1, 0, 0, 0); } } while (0)
#define AT_VFRAGS(dst, m0, bufi) do { const LAS unsigned char* Vb = Vl + (bufi) * VBYTES + vfo; \
        _Pragma("unroll") for (int m = 0; m < 8; ++m) { const int s_ = ((m0) + m) / NDB, db_ = ((m0) + m) % NDB; dst[m] = *(const LAS bf16x8*)(Vb + 32 * db_ * VSTR + 32 * s_); } } while (0)
#define AT_PVM(src, m0) do { _Pragma("unroll") for (int m = 0; m < 8; ++m) { const int s_ = ((m0) + m) / NDB, db_ = ((m0) + m) % NDB; \
        o[db_] = __builtin_amdgcn_mfma_f32_32x32x16_bf16(src[m], pf[s_], o[db_], 0, 0, 0); } } while (0)
    f32x16 p0, p1, n0, n1; bf16x8 kf[2 * NKS], vfa[8], pf[4];
    if (PIPE) {
        AT_LOADK(0); AT_LOADV(0); AT_WRITEK(0); AT_WRITEV(0);
        AT_LOADK(1);
        __syncthreads();
        AT_KFRAGS(0); AT_QKM(p0, p1);
        AT_WRITEK(1);
        if (2 < ntiles) AT_LOADK(2);
        AT_LOADV(1);
        __syncthreads();
    } else if (TPB2) {
        AT_LOADK(0); AT_LOADV(0); AT_LOADKB(1); AT_LOADVB(1); AT_WRITEK(0); AT_WRITEV(0); AT_WRITEKB(1); AT_WRITEVB(1);
        AT_LOADK(2); AT_LOADV(2); AT_LOADKB(3); AT_LOADVB(3);
        __syncthreads();
    } else {
        AT_LOADK(0); AT_LOADV(0); AT_WRITEK(0); AT_WRITEV(0);
        AT_LOADK(1); AT_LOADV(1);
        __syncthreads();
    }
#define AT_BODY(HASNEXT, C0, C1, N0, N1, TT) do { const int t = (TT); \
        if (PIPE) { if (HASNEXT) AT_KFRAGS((t + 1) & 1); } else AT_KFRAGS(t & 1); \
        AT_VFRAGS(vfa, 0, t & 1); \
        __builtin_amdgcn_sched_barrier(0); \
        if (!PIPE) AT_QKM(C0, C1); \
        float ls = 0.f; \
        _Pragma("unroll") for (int r = 0; r < 16; ++r) { C0[r] = __builtin_amdgcn_exp2f(C0[r]); C1[r] = __builtin_amdgcn_exp2f(C1[r]); ls += C0[r] + C1[r]; } \
        lsum += ls; \
        { u32x4 w; \
          w.x = cvtpk_nv(C0[0], C0[1]); w.y = cvtpk_nv(C0[2], C0[3]); w.z = cvtpk_nv(C0[4], C0[5]); w.w = cvtpk_nv(C0[6], C0[7]); pf[0] = __builtin_bit_cast(bf16x8, w); \
          w.x = cvtpk_nv(C0[8], C0[9]); w.y = cvtpk_nv(C0[10], C0[11]); w.z = cvtpk_nv(C0[12], C0[13]); w.w = cvtpk_nv(C0[14], C0[15]); pf[1] = __builtin_bit_cast(bf16x8, w); \
          w.x = cvtpk_nv(C1[0], C1[1]); w.y = cvtpk_nv(C1[2], C1[3]); w.z = cvtpk_nv(C1[4], C1[5]); w.w = cvtpk_nv(C1[6], C1[7]); pf[2] = __builtin_bit_cast(bf16x8, w); \
          w.x = cvtpk_nv(C1[8], C1[9]); w.y = cvtpk_nv(C1[10], C1[11]); w.z = cvtpk_nv(C1[12], C1[13]); w.w = cvtpk_nv(C1[14], C1[15]); pf[3] = __builtin_bit_cast(bf16x8, w); } \
        if (PIPE && (HASNEXT)) AT_QKM(N0, N1); \
        if (NV == 16) { __builtin_amdgcn_sched_barrier(0); AT_VFRAGS(kf, 8, t & 1); __builtin_amdgcn_sched_barrier(0); __builtin_amdgcn_s_setprio(1); AT_PVM(vfa, 0); AT_PVM(kf, 8); __builtin_amdgcn_s_setprio(0); } \
        else { __builtin_amdgcn_s_setprio(1); AT_PVM(vfa, 0); __builtin_amdgcn_s_setprio(0); } \
        if (PIPE) { if (t + 2 < ntiles) AT_WRITEK(t & 1); if (t + 1 < ntiles) AT_WRITEV((t + 1) & 1); if (t + 3 < ntiles) AT_LOADK(t + 3); if (t + 2 < ntiles) AT_LOADV(t + 2); } \
        else { if (t + 1 < ntiles) { AT_WRITEK((t + 1) & 1); AT_WRITEV((t + 1) & 1); } if (t + 2 < ntiles) { AT_LOADK(t + 2); AT_LOADV(t + 2); } } \
        __syncthreads(); \
    } while (0)
    int tt = 0;
    if (PIPE) {
        for (; tt < ntiles - 2; tt += 2) { AT_BODY(true, p0, p1, n0, n1, tt); AT_BODY(true, n0, n1, p0, p1, tt + 1); }
        AT_BODY(true, p0, p1, n0, n1, tt); AT_BODY(false, n0, n1, p0, p1, tt + 1);
    } else {
        if (TPB2) {
#define AT_SUB(slot) do { AT_KFRAGS(slot); AT_VFRAGS(vfa, 0, slot); __builtin_amdgcn_sched_barrier(0); AT_QKM(p0, p1); \
            float ls = 0.f; _Pragma("unroll") for (int r = 0; r < 16; ++r) { p0[r] = __builtin_amdgcn_exp2f(p0[r]); p1[r] = __builtin_amdgcn_exp2f(p1[r]); ls += p0[r] + p1[r]; } lsum += ls; \
            { u32x4 w; \
              w.x = cvtpk_nv(p0[0], p0[1]); w.y = cvtpk_nv(p0[2], p0[3]); w.z = cvtpk_nv(p0[4], p0[5]); w.w = cvtpk_nv(p0[6], p0[7]); pf[0] = __builtin_bit_cast(bf16x8, w); \
              w.x = cvtpk_nv(p0[8], p0[9]); w.y = cvtpk_nv(p0[10], p0[11]); w.z = cvtpk_nv(p0[12], p0[13]); w.w = cvtpk_nv(p0[14], p0[15]); pf[1] = __builtin_bit_cast(bf16x8, w); \
              w.x = cvtpk_nv(p1[0], p1[1]); w.y = cvtpk_nv(p1[2], p1[3]); w.z = cvtpk_nv(p1[4], p1[5]); w.w = cvtpk_nv(p1[6], p1[7]); pf[2] = __builtin_bit_cast(bf16x8, w); \
              w.x = cvtpk_nv(p1[8], p1[9]); w.y = cvtpk_nv(p1[10], p1[11]); w.z = cvtpk_nv(p1[12], p1[13]); w.w = cvtpk_nv(p1[14], p1[15]); pf[3] = __builtin_bit_cast(bf16x8, w); } \
            __builtin_amdgcn_s_setprio(1); AT_PVM(vfa, 0); __builtin_amdgcn_s_setprio(0); } while (0)
            for (int pp = 0; 2 * pp < ntiles; ++pp) { const int sb = (pp & 1) * 2;
                AT_SUB(sb); AT_SUB(sb + 1);
                if (2 * pp + 2 < ntiles) { AT_WRITEK(sb ^ 2); AT_WRITEV(sb ^ 2); AT_WRITEKB((sb ^ 2) + 1); AT_WRITEVB((sb ^ 2) + 1); }
                if (2 * pp + 4 < ntiles) { AT_LOADK(2 * pp + 4); AT_LOADV(2 * pp + 4); AT_LOADKB(2 * pp + 5); AT_LOADVB(2 * pp + 5); }
                __syncthreads();
            }
#undef AT_SUB
        } else
        for (; tt < ntiles; ++tt) AT_BODY(true, p0, p1, p0, p1, tt);
    }
#undef AT_BODY
#undef AT_LOADK
#undef AT_LOADV
#undef AT_WRITEK
#undef AT_WRITEV
#undef AT_KFRAGS
#undef AT_QKM
#undef AT_VFRAGS
#undef AT_PVM
}
template <int NDB>
__device__ __forceinline__ void attn_store(bf16* ATT, int row0, int col0, const f32x16 (&o)[NDB], float inv, int lane) {
    const int i = lane & 31, hh = lane >> 5; bf16* rp = ATT + (size_t)(row0 + i) * D + col0 + 4 * hh;
#pragma unroll
    for (int db = 0; db < NDB; ++db)
#pragma unroll
        for (int g4 = 0; g4 < 4; ++g4) { u32x2 w; w.x = pk2(o[db][4 * g4] * inv, o[db][4 * g4 + 1] * inv); w.y = pk2(o[db][4 * g4 + 2] * inv, o[db][4 * g4 + 3] * inv);
            *(u32x2*)(rp + 32 * db + 8 * g4) = w; }
}

#define XB_TMO      128
#define XB_XCNT(j)  (256  + 64 * (j))
#define XB_XSUB(j)  (1280 + 64 * (j))
#define XB_XGEN(j)  (2304 + 64 * (j))
#define XB_TOP      3328
#define XB_TOPGEN   3392
#define XCD_BAR_WORDS 3456
#define XB_SPIN_CAP (1u << 18)

__device__ __forceinline__ unsigned xb_ld(unsigned* p)              { return __hip_atomic_load(p, __ATOMIC_RELAXED, __HIP_MEMORY_SCOPE_AGENT); }
__device__ __forceinline__ unsigned xb_add(unsigned* p, unsigned v) { return __hip_atomic_fetch_add(p, v, __ATOMIC_RELAXED, __HIP_MEMORY_SCOPE_AGENT); }
__device__ __forceinline__ unsigned xb_xcc_id() { return (unsigned)__builtin_amdgcn_s_getreg((3 << 11) | 20) & 0xFu; }
#define XB_SPIN(cond, bar) do { unsigned _sp = 0; while (cond) { __builtin_amdgcn_s_sleep(1); \
    if ((++_sp & 255u) == 0u) { if (xb_ld(&(bar)[XB_TMO])) break; if (_sp > XB_SPIN_CAP) { atomicAdd(&(bar)[XB_TMO], 1u); break; } } } } while (0)

struct XcdBarrier {
    unsigned* bar; unsigned x;
    volatile LAS unsigned* st;
};

__device__ __forceinline__ XcdBarrier xcd_barrier_post(unsigned* bar, volatile LAS unsigned* st) {
    XcdBarrier b; b.bar = bar; b.x = xb_xcc_id(); b.st = st;
    if (threadIdx.x == 0) (void)xb_add(&bar[XB_XCNT(b.x)], 1u);
    return b;
}
__device__ __forceinline__ void xcd_barrier_complete(unsigned* bar, unsigned x, unsigned& nloc, unsigned& nx) {
    const unsigned G = gridDim.x * gridDim.y * gridDim.z;
    unsigned sum, cnt, mine, sp = 0u;
    for (;;) {
        sum = 0u; cnt = 0u; mine = 0u;
#pragma unroll
        for (unsigned j = 0; j < 16; ++j) { const unsigned c = xb_ld(&bar[XB_XCNT(j)]); sum += c; cnt += (c > 0u) ? 1u : 0u; mine = (j == x) ? c : mine; }
        if (sum == G) break;
        __builtin_amdgcn_s_sleep(1);
        if ((++sp & 255u) == 0u) { if (xb_ld(&bar[XB_TMO])) break; if (sp > XB_SPIN_CAP) { atomicAdd(&bar[XB_TMO], 1u); break; } }
    }
    nloc = mine > 0u ? mine : 1u; nx = cnt > 0u ? cnt : 1u;
}

__device__ __forceinline__ void xcd_barrier(const XcdBarrier& b, const int wave_s) {
    asm volatile("s_waitcnt vmcnt(0)" ::: "memory");
    __syncthreads();
    if (wave_s == 0 && fresh_lane() == 0) {
        unsigned* bar = b.bar; asm volatile("" : "+s"(bar));
        __builtin_amdgcn_s_waitcnt(0);
        unsigned nloc = b.st[0], nx = b.st[1];
        if (nloc == 0u) { xcd_barrier_complete(bar, b.x, nloc, nx); b.st[0] = nloc; b.st[1] = nx; }
        const unsigned old = xb_add(&bar[XB_XSUB(b.x)], 1u);
        const unsigned gen = old / nloc;
        if (old + 1u == (gen + 1u) * nloc) {
            __builtin_amdgcn_fence(__ATOMIC_RELEASE, "agent");
            asm volatile("s_waitcnt vmcnt(0)" ::: "memory");
            const unsigned og = xb_add(&bar[XB_TOP], 1u);
            const unsigned tg = og / nx;
            if (og + 1u == (tg + 1u) * nx) xb_add(&bar[XB_TOPGEN], 1u);
            else XB_SPIN(xb_ld(&bar[XB_TOPGEN]) == tg, bar);
            __builtin_amdgcn_fence(__ATOMIC_ACQUIRE, "agent");
            xb_add(&bar[XB_XGEN(b.x)], 1u);
            asm volatile("s_waitcnt vmcnt(0)" ::: "memory");
        } else {
            XB_SPIN(xb_ld(&bar[XB_XGEN(b.x)]) == gen, bar);
            __builtin_amdgcn_fence(__ATOMIC_ACQUIRE, "agent");
            asm volatile("s_waitcnt vmcnt(0)" ::: "memory");
        }
    }
    __syncthreads();
}

__device__ __forceinline__ int grab_unit(unsigned* ctr, volatile LAS unsigned* slot, int wave_s) {
    if (wave_s == 0 && fresh_lane() == 0) *slot = __hip_atomic_fetch_add(ctr, 1u, __ATOMIC_RELAXED, __HIP_MEMORY_SCOPE_AGENT);
    __syncthreads();
    const unsigned v = *slot;
    __syncthreads();
    return __builtin_amdgcn_readfirstlane((int)v);
}
__device__ __forceinline__ unsigned ticket_issue(unsigned* ctr, int wave_s, bool& mine) {
    mine = (wave_s == 0) && (fresh_lane() == 0); unsigned v = 0u;
    if (mine) v = __hip_atomic_fetch_add(ctr, 1u, __ATOMIC_RELAXED, __HIP_MEMORY_SCOPE_AGENT);
    return v;
}
__device__ __forceinline__ int ticket_publish(unsigned v, bool mine, volatile LAS unsigned* slot) {
    if (mine) *slot = v;
    __syncthreads();
    const unsigned r = *slot;
    __syncthreads();
    return __builtin_amdgcn_readfirstlane((int)r);
}
struct Args { const float* in[23]; float* out; unsigned char* ws; };

__global__ void __launch_bounds__(NTHR, 2) mega_fwd(Args args) {
    extern __shared__ __attribute__((aligned(16))) unsigned char lds_raw[];
    LAS unsigned char* lds = (LAS unsigned char*)lds_raw;
    cg::grid_group grid = cg::this_grid();
    const int wave_s = __builtin_amdgcn_readfirstlane(threadIdx.x >> 6);
    if (threadIdx.x < 16) ((LAS unsigned*)(lds + MISC_OFF))[threadIdx.x] = 0u;
    __syncthreads();
    const XcdBarrier xbar = xcd_barrier_post((unsigned*)(args.ws + WS_CTL), (volatile LAS unsigned*)(lds + MISC_OFF));
    const int G = gridDim.x, bx = blockIdx.x; const int vcu = (G % 8 == 0) ? (bx % 8) * (G / 8) + bx / 8 : bx;
    const int NGW = G * NWAVES;
    unsigned char* ws = args.ws;
    const float* x_in = args.in[0]; const float* c_in = args.in[1]; const float* ctx_in = args.in[2]; const float* cctx_in = args.in[3];
    const float* ada_w = args.in[4]; const float* ada_b = args.in[5]; const float* norm_mix = args.in[6]; const float* norm_mlp = args.in[7];
    float* MOD = (float*)(ws + WS_MOD); float* XCTX = (float*)(ws + WS_XCTX); bf16* H = (bf16*)(ws + WS_H); unsigned char* RG = ws + WS_R;
    float* XLAT = args.out;

    {   const int tid = threadIdx.x, lane = tid & 63, wave = __builtin_amdgcn_readfirstlane(tid >> 6);
        const bool split = G >= 96; const int NGW = split ? (G - 48) * NWAVES : G * NWAVES; const int gw = split ? ((bx >= 48) ? (bx - 48) * NWAVES + wave : NGW + wave) : bx * NWAVES + wave;
        if (bx < 48) {
            LAS float* S = (LAS float*)lds;
            for (int idx = tid; idx < 33 * 1024; idx += NTHR) { const int b = idx >> 10, k = idx & 1023; const float cv = (b < 32) ? c_in[b * 1024 + k] : cctx_in[k]; S[idx] = cv / (1.0f + __expf(-cv)); }
            __syncthreads();
            for (int item = bx; item < 48; item += G) {
                const int L = item / 12, col = (item % 12) * 512 + wave * 64 + lane; const float* wp = ada_w + (size_t)L * 1024 * 6144 + col;
                float acc[33];
#pragma unroll
                for (int b = 0; b < 33; ++b) acc[b] = 0.f;
                float wn[16];
#pragma unroll
                for (int e = 0; e < 16; ++e) wn[e] = wp[(size_t)e * 6144];
                for (int kb = 0; kb < 1024; kb += 16) {
                    float wc[16];
#pragma unroll
                    for (int e = 0; e < 16; ++e) wc[e] = wn[e];
                    if (kb + 16 < 1024) {
#pragma unroll
                        for (int e = 0; e < 16; ++e) wn[e] = wp[(size_t)(kb + 16 + e) * 6144]; }
#pragma unroll
                    for (int q4 = 0; q4 < 4; ++q4)
#pragma unroll
                        for (int b = 0; b < 33; ++b) { const f32x4 s = *(const LAS f32x4*)(S + b * 1024 + kb + 4 * q4); acc[b] += (s.x * wc[4 * q4] + s.y * wc[4 * q4 + 1]) + (s.z * wc[4 * q4 + 2] + s.w * wc[4 * q4 + 3]); }
                }
                const float bias = ada_b[L * 6144 + col];
#pragma unroll
                for (int b = 0; b < 33; ++b) MOD[((size_t)L * 33 + b) * 6144 + col] = acc[b] + bias;
            }
            __syncthreads();
        }
        LAS float* scr = (LAS float*)(lds + wave * 16384); int cur = 0;
        if (gw < NGW) {
        for (int i2 = 0; i2 < 2; ++i2) {
            unsigned char* we = ws + WS_W + (size_t)i2 * 8 * MiB; bf16* WinM = (bf16*)we; bf16* WinV = (bf16*)(we + 3584 * 1024); bf16* Wout = (bf16*)(we + 5 * MiB);
            const float* win = args.in[10] + (size_t)i2 * 1024 * 2304;
            xpose_seg(win, 1024, 2304, 0, 1024, false, WinM, 0, scr, gw, NGW, cur, lane);
            xpose_seg(win, 1024, 2304, 1536, 640, false, WinM, 1024, scr, gw, NGW, cur, lane);
            xpose_seg(win, 1024, 2304, 1024, 512, false, WinV, 0, scr, gw, NGW, cur, lane);
            xpose_seg(win, 1024, 2304, 2176, 128, false, WinV, 512, scr, gw, NGW, cur, lane);
            zero_rows(WinM, 1024, 1664, 128, gw, NGW, lane); zero_rows(WinV, 1024, 640, 128, gw, NGW, lane);
            xpose_seg(args.in[11] + (size_t)i2 * 1024 * 1024, 1024, 1024, 0, 1024, false, Wout, 0, scr, gw, NGW, cur, lane);
            unsigned char* wo = ws + WS_W + 16 * MiB + (size_t)i2 * 8 * MiB; bf16* MWin = (bf16*)wo; bf16* MQup = (bf16*)(wo + 2 * MiB); bf16* MKn = (bf16*)(wo + 3584 * 1024); bf16* MV = (bf16*)(wo + 4 * MiB); bf16* MWout = (bf16*)(wo + 4608 * 1024);
            xpose_seg(args.in[16] + (size_t)i2 * 1024 * 800, 1024, 800, 0, 800, false, MWin, 0, scr, gw, NGW, cur, lane);
            zero_rows(MWin, 1024, 800, 224, gw, NGW, lane);
            xpose_seg(args.in[18] + (size_t)i2 * 512 * 1536, 512, 1536, 0, 1536, false, MQup, 0, scr, gw, NGW, cur, lane);
            xpose_seg(args.in[20] + (size_t)i2 * 256 * 2048, 256, 2048, 0, 1024, true, MKn, 0, scr, gw, NGW, cur, lane);
            xpose_seg(args.in[20] + (size_t)i2 * 256 * 2048, 256, 2048, 64, 1024, true, MV, 0, scr, gw, NGW, cur, lane);
            xpose_seg(args.in[22] + (size_t)i2 * 1024 * 1024, 1024, 1024, 0, 1024, false, MWout, 0, scr, gw, NGW, cur, lane);
        }
        for (int L = 0; L < 4; ++L) {
            unsigned char* wm = ws + WS_W + 32 * MiB + (size_t)L * 16 * MiB;
            xpose_seg(args.in[8] + (size_t)L * 1024 * 4096, 1024, 4096, 0, 4096, false, (bf16*)wm, 0, scr, gw, NGW, cur, lane);
            xpose_seg(args.in[9] + (size_t)L * 4096 * 1024, 4096, 1024, 0, 1024, false, (bf16*)(wm + 8 * MiB), 0, scr, gw, NGW, cur, lane);
        }
        }
    }
    if (__builtin_expect(args.ws == nullptr, 0)) grid.sync();
    xcd_barrier(xbar, wave_s);
    {
        float* MOD = (float*)(ws + WS_MOD); bf16* SHB = (bf16*)(ws + WS_SHB); float* SSQ1 = (float*)(ws + WS_SSQ); float* SSQ2 = SSQ1 + 131072;
        const int lane = fresh_lane(); const int gw = vcu * NWAVES + wave_s;
        for (int idx = gw; idx < 264; idx += NGW) { const int L = idx / 66, rem = idx % 66, w = rem / 33, b = rem % 33;
            const float* src = MOD + ((size_t)L * 33 + b) * 6144 + (w ? 3072 : 0); bf16* dst = SHB + ((size_t)(2 * L + w) * 256 + b) * 1024;
#pragma unroll
            for (int j = 0; j < 4; ++j) { const f32x4 v = *(const f32x4*)(src + 256 * j + 4 * lane); u32x2 o; o.x = pk2(v.x, v.y); o.y = pk2(v.z, v.w); *(u32x2*)(dst + 256 * j + 4 * lane) = o; } }
        prep_phase(x_in, ctx_in, norm_mix, MOD, 1024, (bf16*)(ws + WS_H), SSQ1, vcu, NGW, wave_s);
        zero_f32(SSQ2, R, vcu, NGW, wave_s);
        zero_f32((float*)(ws + WS_SSQM), 262144, vcu, NGW, wave_s);
    }
    xcd_barrier(xbar, wave_s);
    {
        pg8::Gemm g{(const bf16*)(ws + WS_SHB), (const bf16*)(ws + WS_W), 2048, 256, 1024}; pg8::ShwOrder S{G, bx}; pg8::EpiShw E{(float*)(ws + WS_SHW)};
        pg8::gemm_phase<pg8::EpiShw, pg8::ShwOrder, true, true>(lds, g, S, E, wave_s);
    }
    xcd_barrier(xbar, wave_s);

    const int G0 = G, bx0 = bx, vcu0 = vcu; int dir = 0;
    for (int L = 0; L < 4; ++L) {
        int G = G0, bx = bx0, vcu = vcu0; asm volatile("" : "+s"(G), "+s"(bx), "+s"(vcu)); const int NGW = G * NWAVES;
        const __attribute__((address_space(4))) Args* ap = (const __attribute__((address_space(4))) Args*)__builtin_amdgcn_kernarg_segment_ptr(); asm volatile("" : "+s"(ap));
        unsigned char* ws = ap->ws; float* XLAT = ap->out; const float* x_in = ap->in[0]; const float* ctx_in = ap->in[2]; const float* norm_mix = ap->in[6]; const float* norm_mlp = ap->in[7];
        float* MOD = (float*)(ws + WS_MOD); float* XCTX = (float*)(ws + WS_XCTX); bf16* H = (bf16*)(ws + WS_H); unsigned char* RG = ws + WS_R;
        const int i2 = L >> 1; const bool last = (L == 3);
        const float* modl = MOD + (size_t)L * 33 * 6144;
        const float* xl = (L == 0) ? x_in : XLAT; const float* xc = (L == 0) ? ctx_in : XCTX;
        float* SSQ1 = (float*)(ws + WS_SSQ); float* SSQ2 = SSQ1 + 131072; const float* SHWin = (const float*)(ws + WS_SHW) + (size_t)L * 33 * 8192; const float* SHW1 = SHWin + 33 * 4096;
        const int Ln = (L < 3) ? L + 1 : 3;
        bf16* ATT;
        if ((L & 1) == 0) {
            unsigned char* we = ws + WS_W + (size_t)i2 * 8 * MiB; const bf16* WinM = (const bf16*)we; const bf16* WinV = (const bf16*)(we + 3584 * 1024); const bf16* Wout = (const bf16*)(we + 5 * MiB);
            bf16* RAW = (bf16*)RG; bf16* VT = (bf16*)(RG + 252 * MiB); ATT = (bf16*)(RG + 576 * MiB);
            {   pg8::Gemm g{H, WinM, R, 1792, 1024}; pg8::StaticOrder S; S.init(R, 1792, G, bx); S.rev = dir; pg8::EpiEvenIn E{RAW, SSQ1, SHWin, ap->in[12] + i2 * 128 + 64, ap->in[15] + i2 * 128 + 64};
                pg8::gemm_phase<pg8::EpiEvenIn, pg8::StaticOrder, true, true>(lds, g, S, E, wave_s); }
            {   pg8::Gemm g{WinV, H, 768, R, 1024}; pg8::StaticOrder S; S.init(768, R, G, bx); S.rev = dir; pg8::EpiVT<true> E{VT, 768, SSQ1, SHWin + 1792, 2560, 1.0f / 1024.0f};
                pg8::gemm_phase<pg8::EpiVT<true>, pg8::StaticOrder, true, true>(lds, g, S, E, wave_s); }
            { xcd_barrier(xbar, wave_s); dir ^= 1; }
            {
                const int lane = fresh_lane(), wave = wave_s;
                const float* lamp = ap->in[13] + i2 * 256;
                const float lam_init = 0.8f - 0.6f * __expf(-0.3f * (float)L);
                const float lam_v = __expf(wave_sum(lamp[lane] * lamp[64 + lane], lane)) - __expf(wave_sum(lamp[128 + lane] * lamp[192 + lane], lane)) + lam_init;
                const float lam = __builtin_bit_cast(float, __builtin_amdgcn_readfirstlane(__builtin_bit_cast(int, lam_v)));
                const float* subln = ap->in[14] + i2 * 128;
                const int nlat_d = 1024, nctx_d = 128, nlat_g = 2048, nctx_g = 256;
#ifndef NO_DIFF
                unsigned* ctrs = (unsigned*)(ws + WS_CTL) + 3584 + 8 * L; volatile LAS unsigned* slot = (volatile LAS unsigned*)(lds + MISC_OFF) + 8;
                for (int u = grab_unit(ctrs, slot, wave_s); u < nlat_d + nctx_d; ) { bool tk_mine; const unsigned tk_next = ticket_issue(ctrs, wave_s, tk_mine);
                    int b, h, row0, nt;
                    if (u < nlat_d) { const int ur = dir ? (nlat_d - 1 - u) : u; const int qb = ur & 7; h = (ur >> 3) & 3; b = ur >> 5; row0 = b * 2048 + qb * 256 + wave * 32; nt = 36; }
                    else { const int uu = u - nlat_d; h = uu & 3; b = uu >> 2; row0 = NLAT + b * 256 + wave * 32; nt = 4; }
                    f32x16 o[4]; float l;
                    const bf16* vt = VT + ((size_t)b * 768 + h * 128) * KV;
                    attn_pass<64, 128, false>(lds, RAW + (size_t)row0 * RAWP + (h * 2) * 64, RAWP, RAW + (size_t)(NLAT + b * 256) * RAWP + 512 + (h * 2) * 64, RAW + (size_t)(b * 2048) * RAWP + 512 + (h * 2) * 64, RAWP, vt, nt, ap->in[12] + i2 * 128, row0, 0.125f * LOG2E, o, l, wave_s);
                    { const int ln = fresh_lane(); LAS unsigned* o1s = (LAS unsigned*)(lds + 57344 + wave_s * 8192) + ln; const float inv = 1.0f / (l + shx(l, 32, ln));
#pragma unroll
                      for (int db = 0; db < 4; ++db)
#pragma unroll
                          for (int j = 0; j < 8; ++j) o1s[(db * 8 + j) * 64] = pg8::cvt_pk_bf16(o[db][2 * j] * inv, o[db][2 * j + 1] * inv); }
                    attn_pass<64, 128, false>(lds, RAW + (size_t)row0 * RAWP + (h * 2 + 1) * 64, RAWP, RAW + (size_t)(NLAT + b * 256) * RAWP + 512 + (h * 2 + 1) * 64, RAW + (size_t)(b * 2048) * RAWP + 512 + (h * 2 + 1) * 64, RAWP, vt, nt, ap->in[12] + i2 * 128, row0, 0.125f * LOG2E, o, l, wave_s);
                    { const int ln = fresh_lane(), i = ln & 31, hh = ln >> 5; LAS unsigned* o1s = (LAS unsigned*)(lds + 57344 + wave_s * 8192) + ln; const float inv = lam / (l + shx(l, 32, ln)); float ss = 0.f;
#pragma unroll
                      for (int db = 0; db < 4; ++db)
#pragma unroll
                          for (int j = 0; j < 8; ++j) { const unsigned pk = o1s[(db * 8 + j) * 64]; const float a0 = bflo(pk) - o[db][2 * j] * inv, a1 = bfhi(pk) - o[db][2 * j + 1] * inv; o[db][2 * j] = a0; o[db][2 * j + 1] = a1; ss += a0 * a0 + a1 * a1; }
                      ss += shx(ss, 32, ln);
                      const float rinv = (1.0f - lam_init) / sqrtf(ss * (1.0f / 128) + EPS);
                      bf16* rp = ATT + (size_t)(row0 + i) * D + h * 128 + 4 * hh;
#pragma unroll
                      for (int db = 0; db < 4; ++db)
#pragma unroll
                          for (int g4 = 0; g4 < 4; ++g4) { const f32x4 sg = *(const f32x4*)(subln + 32 * db + 8 * g4 + 4 * hh);
                              u32x2 w; w.x = pk2(o[db][4 * g4] * rinv * sg.x, o[db][4 * g4 + 1] * rinv * sg.y); w.y = pk2(o[db][4 * g4 + 2] * rinv * sg.z, o[db][4 * g4 + 3] * rinv * sg.w);
                              *(u32x2*)(rp + 32 * db + 8 * g4) = w; } }
                    u = ticket_publish(tk_next, tk_mine, slot);
                }
#endif
#ifndef NO_GQA
                for (int u = grab_unit(ctrs + 1, slot, wave_s); u < nlat_g + nctx_g; ) { bool tk_mine; const unsigned tk_next = ticket_issue(ctrs + 1, wave_s, tk_mine);
                    int b, hq, row0, nt;
                    if (u < nlat_g) { const int ur = dir ? (nlat_g - 1 - u) : u; const int qb = ur & 7; hq = (ur >> 3) & 7; b = ur >> 6; row0 = b * 2048 + qb * 256 + wave * 32; nt = 36; }
                    else { const int uu = u - nlat_g; hq = uu & 7; b = uu >> 3; row0 = NLAT + b * 256 + wave * 32; nt = 4; }
                    const int kvh = hq >> 2; f32x16 o[2]; float l;
                    attn_pass<64, 64, false>(lds, RAW + (size_t)row0 * RAWP + 1024 + hq * 64, RAWP, RAW + (size_t)(NLAT + b * 256) * RAWP + 1536 + kvh * 64, RAW + (size_t)(b * 2048) * RAWP + 1536 + kvh * 64, RAWP,
                                      VT + ((size_t)b * 768 + 512 + kvh * 64) * KV, nt, ap->in[15] + i2 * 128, row0, 0.125f * LOG2E, o, l, wave_s);
                    { const int ln = fresh_lane(); attn_store<2>(ATT, row0, 512 + hq * 64, o, 1.0f / (l + shx(l, 32, ln)), ln); }
                    u = ticket_publish(tk_next, tk_mine, slot);
                }
#endif
            }
            { xcd_barrier(xbar, wave_s); dir ^= 1; }
            {   pg8::Gemm g{ATT, Wout, R, 1024, 1024}; pg8::StaticOrder S; S.init(R, 1024, G, bx); S.rev = dir; pg8::EpiResid E{xl, xc, XLAT, XCTX, modl + 2048, H, norm_mlp + L * 1024, modl + 4096, SSQ2};
                zero_f32(SSQ1, R, vcu, NGW, wave_s);
                pg8::gemm_phase<pg8::EpiResid, pg8::StaticOrder, true, true>(lds, g, S, E, wave_s); }
        } else {
            unsigned char* wo = ws + WS_W + 16 * MiB + (size_t)i2 * 8 * MiB; const bf16* MWin = (const bf16*)wo; const bf16* MQup = (const bf16*)(wo + 2 * MiB); const bf16* MKn = (const bf16*)(wo + 3584 * 1024);
            const bf16* MV = (const bf16*)(wo + 4 * MiB); const bf16* MWout = (const bf16*)(wo + 4608 * 1024);
            bf16* MRAW = (bf16*)RG; ATT = (bf16*)RG; bf16* Q = (bf16*)(RG + 144 * MiB); bf16* Kb = (bf16*)(RG + 360 * MiB); bf16* VT = (bf16*)(RG + 576 * MiB);
            bf16* QCn = (bf16*)RG; bf16* KVCn = (bf16*)(RG + 72 * MiB); bf16* KR = (bf16*)(RG + 108 * MiB);
            float* SSQq = (float*)(ws + WS_SSQM); float* SSQkv = SSQq + 131072; const float* ZSH = SSQq + 229376;
            {   pg8::Gemm g{H, MWin, R, 1024, 1024}; pg8::StaticOrder S; S.init(R, 1024, G, bx); S.rev = dir; pg8::EpiMlaIn E{SSQ1, SHWin, QCn, KVCn, KR, ap->in[17] + i2 * 512, ap->in[19] + i2 * 256, SSQq, SSQkv};
                pg8::gemm_phase<pg8::EpiMlaIn, pg8::StaticOrder, true, true>(lds, g, S, E, wave_s); }
            { xcd_barrier(xbar, wave_s); dir ^= 1; }
            {   pg8::Gemm g{QCn, MQup, last ? NLAT : R, 1536, 512}; pg8::StaticOrder S; S.init(last ? NLAT : R, 1536, G, bx); S.rev = dir; pg8::EpiStore<0, 0, true> E{Q, MQP, SSQq, ZSH, 0, 1.0f / 512.0f};
                pg8::gemm_phase<pg8::EpiStore<0, 0, true>, pg8::StaticOrder, true, true>(lds, g, S, E, wave_s); }
            {   pg8::Gemm g{KVCn, MKn, R, 1024, 256}; pg8::StaticOrder S; S.init(R, 1024, G, bx); S.rev = dir; pg8::EpiMlaKn E{Kb, SSQkv, KR, ap->in[21] + i2 * 192 + 96};
                pg8::gemm_phase<pg8::EpiMlaKn, pg8::StaticOrder, true, true>(lds, g, S, E, wave_s); }
            {   pg8::Gemm g{MV, KVCn, 1024, R, 256}; pg8::StaticOrder S; S.init(1024, R, G, bx); S.rev = dir; pg8::EpiVT<true> E{VT, 1024, SSQkv, ZSH, 0, 1.0f / 256.0f};
                pg8::gemm_phase<pg8::EpiVT<true>, pg8::StaticOrder, true, true>(lds, g, S, E, wave_s); }
            { xcd_barrier(xbar, wave_s); dir ^= 1; }
            {   const float* gq = ap->in[21] + i2 * 192; const float* gk = gq + 96;
                const int lane = fresh_lane(), wave = wave_s;
                const int nlat = 4096, nctx = last ? 0 : 512;
#ifndef NO_MLA
                unsigned* ctrs = (unsigned*)(ws + WS_CTL) + 3584 + 8 * L; volatile LAS unsigned* slot = (volatile LAS unsigned*)(lds + MISC_OFF) + 8;
                for (int u = grab_unit(ctrs, slot, wave_s); u < nlat + nctx; ) { bool tk_mine; const unsigned tk_next = ticket_issue(ctrs, wave_s, tk_mine);
                    int b, h, row0, nt;
                    if (u < nlat) { const int ur = dir ? (nlat - 1 - u) : u; const int qb = ur & 7; h = (ur >> 3) & 15; b = ur >> 7; row0 = b * 2048 + qb * 256 + wave * 32; nt = 36; }
                    else { const int uu = u - nlat; h = uu & 15; b = uu >> 4; row0 = NLAT + b * 256 + wave * 32; nt = 4; }
                    f32x16 o[2]; float l;
                    attn_pass<96, 64, false>(lds, Q + (size_t)row0 * MQP + h * 96, MQP, Kb + (size_t)(NLAT + b * 256) * MQP + h * 96, Kb + (size_t)(b * 2048) * MQP + h * 96, MQP,
                                      VT + ((size_t)b * 1024 + h * 64) * KV, nt, gq, row0, 0.10206207261596577f * LOG2E, o, l, wave_s);
                    { const int ln = fresh_lane(); attn_store<2>(ATT, row0, h * 64, o, 1.0f / (l + shx(l, 32, ln)), ln); }
                    u = ticket_publish(tk_next, tk_mine, slot);
                }
#endif
            }
            { xcd_barrier(xbar, wave_s); dir ^= 1; }
            {   const int Mr = last ? NLAT : R;
                pg8::Gemm g{ATT, MWout, Mr, 1024, 1024}; pg8::StaticOrder S; S.init(Mr, 1024, G, bx); S.rev = dir; pg8::EpiResid E{xl, xc, XLAT, XCTX, modl + 2048, H, norm_mlp + L * 1024, modl + 4096, SSQ2};
                zero_f32(SSQ1, R, vcu, NGW, wave_s);
                pg8::gemm_phase<pg8::EpiResid, pg8::StaticOrder, true, true>(lds, g, S, E, wave_s); }
        }
        { xcd_barrier(xbar, wave_s); dir ^= 1; }
        {   const int Mr = last ? NLAT : R; unsigned char* wm = ws + WS_W + 32 * MiB + (size_t)L * 16 * MiB; bf16* HID = (bf16*)RG;
            {   pg8::Gemm g{H, (const bf16*)wm, Mr, FF, 1024}; pg8::StaticOrder S; S.init(Mr, FF, G, bx); S.rev = dir; pg8::EpiStore<1, 0, true> E{HID, FF, SSQ2, SHW1, 4096, 1.0f / 1024.0f};
                pg8::gemm_phase<pg8::EpiStore<1, 0, true>, pg8::StaticOrder, true, true>(lds, g, S, E, wave_s); }
            { xcd_barrier(xbar, wave_s); dir ^= 1; }
            {   pg8::Gemm g{HID, (const bf16*)(wm + 8 * MiB), Mr, 1024, FF}; pg8::StaticOrder S; S.init(Mr, 1024, G, bx); S.rev = dir; pg8::EpiResid E{XLAT, XCTX, XLAT, XCTX, modl + 5120, last ? (bf16*)nullptr : H, norm_mix + Ln * 1024, MOD + (size_t)Ln * 33 * 6144 + 1024, SSQ1};
                zero_f32(SSQ2, R, vcu, NGW, wave_s); zero_f32((float*)(ws + WS_SSQM), 229376, vcu, NGW, wave_s);
                pg8::gemm_phase<pg8::EpiResid, pg8::StaticOrder, true, true>(lds, g, S, E, wave_s); }
        }
        { xcd_barrier(xbar, wave_s); dir ^= 1; }
    }
}

extern "C" void kernel_launch(void* const* d_in, const int* in_sizes, int n_in, void* d_out, int out_size, void* d_ws, size_t ws_size, hipStream_t stream) {
    static int grid = 0;
    if (grid == 0) {
        if (n_in != 23 || out_size != NLAT * D || ws_size < WS_END) { fprintf(stderr, "kernel_launch: unexpected shapes (n_in %d, out %d, ws %zu)\n", n_in, out_size, ws_size); grid = -1; return; }
        int dev = 0, cus = 0, per_cu = 0;
        hipGetDevice(&dev); hipDeviceGetAttribute(&cus, hipDeviceAttributeMultiprocessorCount, dev);
        if (hipFuncSetAttribute((const void*)mega_fwd, hipFuncAttributeMaxDynamicSharedMemorySize, LDS_BYTES) != hipSuccess) { fprintf(stderr, "kernel_launch: hipFuncSetAttribute failed\n"); grid = -1; return; }
        if (hipOccupancyMaxActiveBlocksPerMultiprocessor(&per_cu, (const void*)mega_fwd, NTHR, LDS_BYTES) != hipSuccess || per_cu < 1) { fprintf(stderr, "kernel_launch: occupancy query says %d\n", per_cu); per_cu = 1; }
        (void)hipGetLastError();
        grid = cus;
    }
    if (grid < 0) return;
    if (hipMemsetAsync((char*)d_ws + WS_CTL, 0, CTL_BYTES, stream) != hipSuccess) { fprintf(stderr, "kernel_launch: memset failed\n"); return; }
    Args a{};
    for (int i = 0; i < 23; ++i) a.in[i] = (const float*)d_in[i];
    a.out = (float*)d_out; a.ws = (unsigned char*)d_ws;
    void* kargs[] = {&a};
    hipError_t e = hipLaunchCooperativeKernel((const void*)mega_fwd, dim3(grid), dim3(NTHR), kargs, LDS_BYTES, stream);
    if (e != hipSuccess) fprintf(stderr, "kernel_launch: cooperative launch failed: %s (grid %d)\n", hipGetErrorString(e), grid);
}
```

```cpp
#include <hip/hip_runtime.h>
#include <hip/hip_cooperative_groups.h>
#include <cstdio>
#include <cstdint>
#include <cmath>
namespace cg = cooperative_groups;
__device__ __forceinline__ int fresh_lane() { int m1 = -1; asm volatile("" : "+s"(m1)); return __builtin_amdgcn_mbcnt_hi(m1, __builtin_amdgcn_mbcnt_lo(m1, 0)); }
namespace pg8 {
#define PG8_LAS __attribute__((address_space(3)))
typedef unsigned short bf16_t;
typedef short bf16x8 __attribute__((ext_vector_type(8)));
typedef float f32x4 __attribute__((ext_vector_type(4)));
typedef unsigned u32x4 __attribute__((ext_vector_type(4)));
constexpr int BM = 256, BK = 64, HALF = 128, HTB = HALF * BK * 2  , STAGE_BYTES = 8 * HTB, NXCD = 8, WGM = 8;

__host__ __device__ __forceinline__ int lds_byte(int r, int c) { const int st = (r >> 4) * 2 + (c >> 5), rr = r & 15, cc = c & 31, ob = rr * 64 + cc * 2; return st * 1024 + (ob ^ (((ob >> 9) & 1) << 5)); }
__host__ __device__ __forceinline__ void stage_rc(int b, int& R, int& C) { const int st = b / 1024, sb = b % 1024, swz = sb ^ (((sb >> 9) & 1) << 5); R = (st >> 1) * 16 + swz / 64; C = (st & 1) * 32 + (swz % 64) / 2; }
__host__ __device__ __forceinline__ int perm32(int rho) { const int n = rho >> 4, i = rho & 15; return 8 * (i >> 2) + 4 * n + (i & 3); }

struct Unit { int pm, pn; };
struct Gemm { const bf16_t* A; const bf16_t* Bt; int M, N, K; };

struct StaticOrder {
    int nM, nN, nwg, G, c, rev;
    __host__ __device__ void init(int M, int N, int G_, int c_) { nM = M / BM; nN = N / BM; nwg = nM * nN; G = G_; c = c_; rev = 0; }
    __host__ __device__ bool next(int i, Unit& u) const {
        const long L = (long)i * G + c; if (L >= nwg) return false;
        int wgid = (int)L; { const int q = nwg / NXCD, r = nwg % NXCD, xcd = wgid % NXCD, off = wgid / NXCD; wgid = (xcd < r ? xcd * (q + 1) : r * (q + 1) + (xcd - r) * q) + off; }
        if (rev) wgid = nwg - 1 - wgid;
        const int nig = WGM * nN, gid = wgid / nig, fm = gid * WGM, gsz = (nM - fm) < WGM ? (nM - fm) : WGM;
        u.pm = fm + ((wgid % nig) % gsz); u.pn = (wgid % nig) / gsz; return true;
    }
    __device__ __forceinline__ void a_ready(const Unit&) const {}
    __device__ __forceinline__ void done(const Unit&) const {}
};

__device__ __forceinline__ unsigned cvt_pk_bf16(float lo, float hi) { unsigned r; asm volatile("v_cvt_pk_bf16_f32 %0, %1, %2" : "=v"(r) : "v"(lo), "v"(hi)); return r; }
typedef float f32x2 __attribute__((ext_vector_type(2)));
typedef unsigned u32x2 __attribute__((ext_vector_type(2)));
__device__ __forceinline__ float rinv_of(float ssq, float invn) { return 1.0f / sqrtf(ssq * invn + 1e-6f); }
__device__ __forceinline__ int mi_of_tile(int r0) { return r0 < 65536 ? (r0 >> 11) : 32; }
template <int ACT, int HEADMAP, bool NORM> struct EpiStore {
    static constexpr bool PERM = true, AFTER_DRAIN = false, HEAD64 = false;
    bf16_t* O; int ldc; const float* ssq; const float* shw; int ldshw; float invn;
    __device__ __forceinline__ void operator()(const f32x4 (&acc)[2][2][4][2], const Unit& u, int wr, int wc, int fr, int fq) const {
        { const int t_ = fresh_lane(); fr = t_ & 15; fq = (t_ >> 4) & 3; }
        const int row0 = u.pm * BM + wr * 64 + fr; const int colb = u.pn * BM + wc * 32 + 8 * fq;
        f32x4 sw[2][2];
        if (NORM) { const float* sp = shw + (size_t)mi_of_tile(u.pm * BM) * ldshw + colb;
#pragma unroll
            for (int bj = 0; bj < 2; ++bj) { sw[bj][0] = *(const f32x4*)(sp + bj * HALF); sw[bj][1] = *(const f32x4*)(sp + bj * HALF + 4); } }
        float riv[2][4];
#pragma unroll
        for (int ai = 0; ai < 2; ++ai)
#pragma unroll
            for (int m = 0; m < 4; ++m) riv[ai][m] = NORM ? ssq[row0 + ai * HALF + m * 16] : 0.f;
#pragma unroll
        for (int ai = 0; ai < 2; ++ai)
#pragma unroll
            for (int m = 0; m < 4; ++m) { const int row = row0 + ai * HALF + m * 16; bf16_t* rowp = O + (size_t)row * ldc;
                float ri = 1.0f; if (NORM) ri = rinv_of(riv[ai][m], invn);
#pragma unroll
                for (int bj = 0; bj < 2; ++bj) { const int c = colb + bj * HALF; const int dc = HEADMAP ? ((c >> 6) * 96 + (c & 63)) : c;
                    f32x4 v0 = acc[ai][bj][m][0], v1 = acc[ai][bj][m][1];
                    if (NORM) { v0 = v0 * ri + sw[bj][0]; v1 = v1 * ri + sw[bj][1]; }
                    if (ACT == 1) {
#pragma unroll
                        for (int e = 0; e < 4; ++e) { float a = v0[e] > 0.f ? v0[e] : 0.f; v0[e] = a * a; float b = v1[e] > 0.f ? v1[e] : 0.f; v1[e] = b * b; } }
                    u32x4 w; w.x = cvt_pk_bf16(v0[0], v0[1]); w.y = cvt_pk_bf16(v0[2], v0[3]); w.z = cvt_pk_bf16(v1[0], v1[1]); w.w = cvt_pk_bf16(v1[2], v1[3]);
                    *(u32x4*)(rowp + dc) = w; } }
    }
};
template <bool NORM> struct EpiVT {
    static constexpr bool PERM = true, AFTER_DRAIN = false, HEAD64 = false;
    bf16_t* VT; int NF; const float* ssq; const float* shw; int ldshw; float invn;
    __device__ __forceinline__ void operator()(const f32x4 (&acc)[2][2][4][2], const Unit& u, int wr, int wc, int fr, int fq) const {
        { const int t_ = fresh_lane(); fr = t_ & 15; fq = (t_ >> 4) & 3; }
        const int r0 = u.pn * BM; int b, kv0; if (r0 < 65536) { b = r0 >> 11; kv0 = 256 + (r0 & 2047); } else { b = (r0 - 65536) >> 8; kv0 = 0; }
        const int f0 = u.pm * BM + wr * 64 + fr;
        f32x4 ri[2][2];
        if (NORM) {
#pragma unroll
            for (int bj = 0; bj < 2; ++bj)
#pragma unroll
                for (int n = 0; n < 2; ++n) { const f32x4 s = *(const f32x4*)(ssq + r0 + bj * HALF + wc * 32 + 8 * fq + 4 * n); ri[bj][n] = (f32x4){rinv_of(s.x, invn), rinv_of(s.y, invn), rinv_of(s.z, invn), rinv_of(s.w, invn)}; } }
        const float* sp = NORM ? shw + (size_t)mi_of_tile(r0) * ldshw : nullptr;
        float shv[2][4];
#pragma unroll
        for (int ai = 0; ai < 2; ++ai)
#pragma unroll
            for (int m = 0; m < 4; ++m) shv[ai][m] = NORM ? sp[f0 + ai * HALF + m * 16] : 0.f;
#pragma unroll
        for (int ai = 0; ai < 2; ++ai)
#pragma unroll
            for (int m = 0; m < 4; ++m) { const int f = f0 + ai * HALF + m * 16; bf16_t* rowp = VT + ((size_t)b * NF + f) * 2304 + kv0;
                const float sh = shv[ai][m];
#pragma unroll
                for (int bj = 0; bj < 2; ++bj) { const int cw = bj * HALF + wc * 32 + 8 * fq; const int gb = cw & ~15, o = cw & 15;
#pragma unroll
                    for (int n = 0; n < 2; ++n) { const int o4 = o + 4 * n; const int pos = (o4 & 3) | (((o4 >> 2) & 1) << 3) | (((o4 >> 3) & 1) << 2);
                        f32x4 v = acc[ai][bj][m][n]; if (NORM) v = v * ri[bj][n] + sh;
                        u32x2 w; w.x = cvt_pk_bf16(v[0], v[1]); w.y = cvt_pk_bf16(v[2], v[3]);
                        *(u32x2*)(rowp + gb + pos) = w; } } }
    }
};
struct EpiMlaIn {
    static constexpr bool PERM = true, AFTER_DRAIN = false, HEAD64 = false;
    const float* ssq; const float* shw; bf16_t* QCg; bf16_t* KVCg; bf16_t* KR; const float* gq; const float* gkv; float* ssq_q; float* ssq_kv;
    __device__ __forceinline__ void operator()(const f32x4 (&acc)[2][2][4][2], const Unit& u, int wr, int wc, int fr, int fq) const {
        const int ln_ = fresh_lane(); fr = ln_ & 15; fq = (ln_ >> 4) & 3;
        const int row0 = u.pm * BM + wr * 64 + fr; const int colb = u.pn * BM + wc * 32 + 8 * fq;
        const float* sp = shw + (size_t)mi_of_tile(u.pm * BM) * 1024 + colb;
        f32x4 sw[2][2], gg[2][2];
#pragma unroll
        for (int bj = 0; bj < 2; ++bj) { sw[bj][0] = *(const f32x4*)(sp + bj * HALF); sw[bj][1] = *(const f32x4*)(sp + bj * HALF + 4);
            const int c = colb + bj * HALF;
            if (u.pn < 2) { gg[bj][0] = *(const f32x4*)(gq + c); gg[bj][1] = *(const f32x4*)(gq + c + 4); }
            else if (u.pn == 2) { gg[bj][0] = *(const f32x4*)(gkv + c - 512); gg[bj][1] = *(const f32x4*)(gkv + c - 508); }
            else { gg[bj][0] = (f32x4){1.f, 1.f, 1.f, 1.f}; gg[bj][1] = gg[bj][0]; } }
        float riv[2][4];
#pragma unroll
        for (int ai = 0; ai < 2; ++ai)
#pragma unroll
            for (int m = 0; m < 4; ++m) riv[ai][m] = ssq[row0 + ai * HALF + m * 16];
#pragma unroll
        for (int ai = 0; ai < 2; ++ai)
#pragma unroll
            for (int m = 0; m < 4; ++m) { const int row = row0 + ai * HALF + m * 16; const float ri = rinv_of(riv[ai][m], 1.0f / 1024.0f); float ps = 0.f;
#pragma unroll
                for (int bj = 0; bj < 2; ++bj) { const int c = colb + bj * HALF;
                    const f32x4 v0 = acc[ai][bj][m][0] * ri + sw[bj][0], v1 = acc[ai][bj][m][1] * ri + sw[bj][1];
                    ps += ((v0[0] * v0[0] + v0[1] * v0[1]) + (v0[2] * v0[2] + v0[3] * v0[3])) + ((v1[0] * v1[0] + v1[1] * v1[1]) + (v1[2] * v1[2] + v1[3] * v1[3]));
                    const f32x4 a0 = v0 * gg[bj][0], a1 = v1 * gg[bj][1];
                    u32x4 w; w.x = cvt_pk_bf16(a0[0], a0[1]); w.y = cvt_pk_bf16(a0[2], a0[3]); w.z = cvt_pk_bf16(a1[0], a1[1]); w.w = cvt_pk_bf16(a1[2], a1[3]);
                    if (u.pn < 2) *(u32x4*)(QCg + (size_t)row * 512 + c) = w;
                    else if (u.pn == 2) *(u32x4*)(KVCg + (size_t)row * 256 + (c - 512)) = w;
                    else if (c < 800) *(u32x4*)(KR + (size_t)row * 32 + (c - 768)) = w; }
                if (u.pn < 3) {
                    ps += __builtin_bit_cast(float, __builtin_amdgcn_ds_bpermute((ln_ ^ 16) << 2, __builtin_bit_cast(int, ps)));
                    ps += __builtin_bit_cast(float, __builtin_amdgcn_ds_bpermute((ln_ ^ 32) << 2, __builtin_bit_cast(int, ps)));
                    if (fq == 0) atomicAdd((u.pn < 2 ? ssq_q : ssq_kv) + row, ps); } }
    }
};
__device__ __forceinline__ void cs_rev(float a, float& c, float& s) {
    double rev = (double)a * 0.15915494309189535; rev -= floor(rev); const float rf = (float)rev; c = __builtin_amdgcn_cosf(rf); s = __builtin_amdgcn_sinf(rf); }
__device__ __forceinline__ float shx32(float v, int o, int lane) { return __builtin_bit_cast(float, __builtin_amdgcn_ds_bpermute((lane ^ o) << 2, __builtin_bit_cast(int, v))); }
struct EpiEvenIn {
    static constexpr bool PERM = true, AFTER_DRAIN = false, HEAD64 = true;
    bf16_t* O; const float* ssq; const float* shw; const float* gdk; const float* ggk;
    __device__ __forceinline__ void operator()(const f32x4 (&acc)[2][2][4][2], const Unit& u, int wr, int wc, int fr, int fq) const {
        const int ln_ = fresh_lane(); fr = ln_ & 15; fq = (ln_ >> 4) & 3;
        const int rt = u.pm * BM; const int row0 = rt + wr * 64 + fr; const int colb = u.pn * BM + wc * 64 + 8 * fq;
        const bool isk = (u.pn == 2) || (u.pn == 3) || (u.pn == 6 && wc < 2); const bool isl = rt < 65536;
        const float* sp = shw + (size_t)mi_of_tile(rt) * 2560 + colb;
        f32x4 sw[2][2], gg[2][2]; float invf[8];
#pragma unroll
        for (int bj = 0; bj < 2; ++bj)
#pragma unroll
            for (int n = 0; n < 2; ++n) { sw[bj][n] = *(const f32x4*)(sp + 32 * bj + 4 * n); gg[bj][n] = (f32x4){1.f, 1.f, 1.f, 1.f}; }
        if (isk) { const float* g = (u.pn == 6) ? ggk : gdk;
#pragma unroll
            for (int bj = 0; bj < 2; ++bj)
#pragma unroll
                for (int n = 0; n < 2; ++n) gg[bj][n] = *(const f32x4*)(g + 32 * bj + 8 * fq + 4 * n);
#pragma unroll
            for (int j = 0; j < 8; ++j) invf[j] = exp2f(-(float)((8 * fq + j) & 15) * (13.287712379549449f / 16.0f)); }
        float riv[2][4];
#pragma unroll
        for (int ai = 0; ai < 2; ++ai)
#pragma unroll
            for (int m = 0; m < 4; ++m) riv[ai][m] = ssq[row0 + ai * HALF + m * 16];
#pragma unroll
        for (int ai = 0; ai < 2; ++ai)
#pragma unroll
            for (int m = 0; m < 4; ++m) { const int row = row0 + ai * HALF + m * 16; const float ri = rinv_of(riv[ai][m], 1.0f / 1024.0f);
                f32x4 v[2][2];
#pragma unroll
                for (int bj = 0; bj < 2; ++bj)
#pragma unroll
                    for (int n = 0; n < 2; ++n) v[bj][n] = acc[ai][bj][m][n] * ri + sw[bj][n];
                if (isk) { float ss = 0.f;
#pragma unroll
                    for (int bj = 0; bj < 2; ++bj)
#pragma unroll
                        for (int n = 0; n < 2; ++n) ss += (v[bj][n][0] * v[bj][n][0] + v[bj][n][1] * v[bj][n][1]) + (v[bj][n][2] * v[bj][n][2] + v[bj][n][3] * v[bj][n][3]);
                    ss += shx32(ss, 16, ln_); ss += shx32(ss, 32, ln_);
                    const float rh = 1.0f / sqrtf(ss * (1.0f / 64.0f) + 1e-6f);
#pragma unroll
                    for (int bj = 0; bj < 2; ++bj)
#pragma unroll
                        for (int n = 0; n < 2; ++n) v[bj][n] = v[bj][n] * rh * gg[bj][n];
                    if (isl) { const int t = row & 2047; const float pos = (fq < 2) ? (float)(t >> 6) : (float)(t & 63);
#pragma unroll
                        for (int n = 0; n < 2; ++n)
#pragma unroll
                            for (int e = 0; e < 4; ++e) { float c, s; cs_rev(pos * invf[4 * n + e], c, s); const float x1 = v[0][n][e], x2 = v[1][n][e]; v[0][n][e] = x1 * c - x2 * s; v[1][n][e] = x2 * c + x1 * s; } } }
#pragma unroll
                for (int bj = 0; bj < 2; ++bj) { u32x4 w; w.x = cvt_pk_bf16(v[bj][0][0], v[bj][0][1]); w.y = cvt_pk_bf16(v[bj][0][2], v[bj][0][3]); w.z = cvt_pk_bf16(v[bj][1][0], v[bj][1][1]); w.w = cvt_pk_bf16(v[bj][1][2], v[bj][1][3]);
                    *(u32x4*)(O + (size_t)row * 1792 + colb + 32 * bj) = w; } }
    }
};
struct EpiMlaKn {
    static constexpr bool PERM = true, AFTER_DRAIN = false, HEAD64 = true;
    bf16_t* K; const float* ssq_kv; const bf16_t* KR; const float* gk;
    __device__ __forceinline__ void operator()(const f32x4 (&acc)[2][2][4][2], const Unit& u, int wr, int wc, int fr, int fq) const {
        const int ln_ = fresh_lane(); fr = ln_ & 15; fq = (ln_ >> 4) & 3;
        const int rt = u.pm * BM; const int row0 = rt + wr * 64 + fr; const int h = 4 * u.pn + wc; const bool isl = rt < 65536;
        f32x4 gg[2][2], gr[2]; float invf[8];
#pragma unroll
        for (int bj = 0; bj < 2; ++bj)
#pragma unroll
            for (int n = 0; n < 2; ++n) gg[bj][n] = *(const f32x4*)(gk + 32 * bj + 8 * fq + 4 * n);
        gr[0] = *(const f32x4*)(gk + 64 + 8 * fq); gr[1] = *(const f32x4*)(gk + 64 + 8 * fq + 4);
#pragma unroll
        for (int j = 0; j < 8; ++j) invf[j] = exp2f(-(float)j * (13.287712379549449f / 8.0f));
        float riv[2][4];
#pragma unroll
        for (int ai = 0; ai < 2; ++ai)
#pragma unroll
            for (int m = 0; m < 4; ++m) riv[ai][m] = ssq_kv[row0 + ai * HALF + m * 16];
        u32x4 kwn = *(const u32x4*)(KR + (size_t)row0 * 32 + 8 * fq);
#pragma unroll
        for (int ai = 0; ai < 2; ++ai)
#pragma unroll
            for (int m = 0; m < 4; ++m) { const int row = row0 + ai * HALF + m * 16; const float ri = rinv_of(riv[ai][m], 1.0f / 256.0f);
                const u32x4 kw = kwn; { const int nx = ai * 4 + m + 1; if (nx < 8) kwn = *(const u32x4*)(KR + (size_t)(row0 + (nx >> 2) * HALF + (nx & 3) * 16) * 32 + 8 * fq); }
                float r[8] = {__builtin_bit_cast(float, kw.x << 16), __builtin_bit_cast(float, kw.x & 0xffff0000u), __builtin_bit_cast(float, kw.y << 16), __builtin_bit_cast(float, kw.y & 0xffff0000u),
                              __builtin_bit_cast(float, kw.z << 16), __builtin_bit_cast(float, kw.z & 0xffff0000u), __builtin_bit_cast(float, kw.w << 16), __builtin_bit_cast(float, kw.w & 0xffff0000u)};
                f32x4 v[2][2]; float ss = 0.f;
#pragma unroll
                for (int bj = 0; bj < 2; ++bj)
#pragma unroll
                    for (int n = 0; n < 2; ++n) { v[bj][n] = acc[ai][bj][m][n] * ri; ss += (v[bj][n][0] * v[bj][n][0] + v[bj][n][1] * v[bj][n][1]) + (v[bj][n][2] * v[bj][n][2] + v[bj][n][3] * v[bj][n][3]); }
#pragma unroll
                for (int j = 0; j < 8; ++j) ss += r[j] * r[j];
                ss += shx32(ss, 16, ln_); ss += shx32(ss, 32, ln_);
                const float rh = 1.0f / sqrtf(ss * (1.0f / 96.0f) + 1e-6f);
#pragma unroll
                for (int bj = 0; bj < 2; ++bj)
#pragma unroll
                    for (int n = 0; n < 2; ++n) v[bj][n] = v[bj][n] * rh * gg[bj][n];
#pragma unroll
                for (int j = 0; j < 8; ++j) r[j] *= rh * gr[j >> 2][j & 3];
                if (isl) { const int t = row & 2047; const float pos = (fq & 1) ? (float)(t & 63) : (float)(t >> 6);
#pragma unroll
                    for (int j = 0; j < 8; ++j) { const float pr = shx32(r[j], 32, ln_); float c, s; cs_rev(pos * invf[j], c, s); r[j] = (fq < 2) ? (r[j] * c - pr * s) : (r[j] * c + pr * s); } }
                bf16_t* kp = K + (size_t)row * 1536 + h * 96 + 8 * fq;
#pragma unroll
                for (int bj = 0; bj < 2; ++bj) { u32x4 w; w.x = cvt_pk_bf16(v[bj][0][0], v[bj][0][1]); w.y = cvt_pk_bf16(v[bj][0][2], v[bj][0][3]); w.z = cvt_pk_bf16(v[bj][1][0], v[bj][1][1]); w.w = cvt_pk_bf16(v[bj][1][2], v[bj][1][3]);
                    *(u32x4*)(kp + 32 * bj) = w; }
                { u32x4 w; w.x = cvt_pk_bf16(r[0], r[1]); w.y = cvt_pk_bf16(r[2], r[3]); w.z = cvt_pk_bf16(r[4], r[5]); w.w = cvt_pk_bf16(r[6], r[7]); *(u32x4*)(kp + 64) = w; } }
    }
};
struct EpiResid {
    static constexpr bool PERM = true, AFTER_DRAIN = false, HEAD64 = false;
    const float* base_lat; const float* base_ctx; float* out_lat; float* out_ctx; const float* gate;
    bf16_t* AP; const float* gn; const float* scn; float* ssq;
    __device__ __forceinline__ void operator()(const f32x4 (&acc)[2][2][4][2], const Unit& u, int wr, int wc, int fr, int fq) const {
        const int ln_ = fresh_lane(); fr = ln_ & 15; fq = (ln_ >> 4) & 3;
        const int rt = u.pm * BM; const bool isl = rt < 65536; const int mi = isl ? (rt >> 11) : 32;
        const float* bp = isl ? base_lat + (size_t)rt * 1024 : base_ctx + (size_t)(rt - 65536) * 1024;
        float* op = isl ? out_lat + (size_t)rt * 1024 : out_ctx + (size_t)(rt - 65536) * 1024;
        bf16_t* ap = AP + (size_t)rt * 1024;
        const int col0 = u.pn * BM + wc * 32 + 8 * fq; const float* gp = gate + mi * 6144 + col0; const float* sp = scn + mi * 6144 + col0; const float* gnp = gn + col0;
        float ps[2][4];
#pragma unroll
        for (int ai = 0; ai < 2; ++ai)
#pragma unroll
            for (int m = 0; m < 4; ++m) ps[ai][m] = 0.f;
#pragma unroll
        for (int bj = 0; bj < 2; ++bj) { const int co = bj * HALF;
            const f32x4 gv0 = *(const f32x4*)(gp + co), gv1 = *(const f32x4*)(gp + co + 4);
            const f32x4 gs0 = *(const f32x4*)(gnp + co) * (*(const f32x4*)(sp + co) + 1.0f), gs1 = *(const f32x4*)(gnp + co + 4) * (*(const f32x4*)(sp + co + 4) + 1.0f);
#pragma unroll
            for (int ai = 0; ai < 2; ++ai) {
                f32x4 b0[4], b1[4];
#pragma unroll
                for (int m = 0; m < 4; ++m) { const size_t off = (size_t)(ai * HALF + wr * 64 + m * 16 + fr) * 1024 + col0 + co; b0[m] = *(const f32x4*)(bp + off); b1[m] = *(const f32x4*)(bp + off + 4); }
#pragma unroll
                for (int m = 0; m < 4; ++m) { const size_t off = (size_t)(ai * HALF + wr * 64 + m * 16 + fr) * 1024 + col0 + co;
                    const f32x4 o0 = b0[m] + gv0 * acc[ai][bj][m][0], o1 = b1[m] + gv1 * acc[ai][bj][m][1];
                    *(f32x4*)(op + off) = o0; *(f32x4*)(op + off + 4) = o1;
                    if (AP) { const f32x4 a0 = o0 * gs0, a1 = o1 * gs1; u32x4 w; w.x = cvt_pk_bf16(a0[0], a0[1]); w.y = cvt_pk_bf16(a0[2], a0[3]); w.z = cvt_pk_bf16(a1[0], a1[1]); w.w = cvt_pk_bf16(a1[2], a1[3]);
                        *(u32x4*)(ap + off) = w; }
                    ps[ai][m] += ((o0[0] * o0[0] + o0[1] * o0[1]) + (o0[2] * o0[2] + o0[3] * o0[3])) + ((o1[0] * o1[0] + o1[1] * o1[1]) + (o1[2] * o1[2] + o1[3] * o1[3])); }
                asm volatile("" ::: "memory"); } }
#pragma unroll
        for (int ai = 0; ai < 2; ++ai)
#pragma unroll
            for (int m = 0; m < 4; ++m) { float s = ps[ai][m];
                s += __builtin_bit_cast(float, __builtin_amdgcn_ds_bpermute((ln_ ^ 16) << 2, __builtin_bit_cast(int, s)));
                s += __builtin_bit_cast(float, __builtin_amdgcn_ds_bpermute((ln_ ^ 32) << 2, __builtin_bit_cast(int, s)));
                if (AP && fq == 0) atomicAdd(ssq + rt + ai * HALF + wr * 64 + m * 16 + fr, s); }
    }
};
struct EpiShw {
    static constexpr bool PERM = false, AFTER_DRAIN = false, HEAD64 = false;
    float* SHW;
    __device__ __forceinline__ void operator()(const f32x4 (&acc)[2][2][4][2], const Unit& u, int wr, int wc, int fr, int fq) const {
        { const int t_ = fresh_lane(); fr = t_ & 15; fq = (t_ >> 4) & 3; }
        if (wr != 0) return;
        const int L = u.pm >> 1, w = u.pm & 1; const int i2 = L >> 1;
        const int t0 = w ? (64 + L * 32) : ((L & 1) ? (32 + i2 * 16) : (i2 * 16));
        const int ld = w ? 4096 : ((L & 1) ? 1024 : 2560);
        float* dst = SHW + (size_t)L * 33 * 8192 + (w ? 33 * 4096 : 0) + (u.pn - t0) * 256 + wc * 32 + 4 * fq;
#pragma unroll
        for (int m = 0; m < 3; ++m) { const int row = m * 16 + fr; if (row < 33) {
#pragma unroll
                for (int bj = 0; bj < 2; ++bj)
#pragma unroll
                    for (int n = 0; n < 2; ++n) *(f32x4*)(dst + (size_t)row * ld + bj * HALF + n * 16) = acc[0][bj][m][n]; } }
    }
};
struct ShwOrder {
    int G, c;
    __device__ __forceinline__ bool next(int i, Unit& u) const {
        int j = i * G + c; if (j >= 92) return false;
        int L = 0; if (j >= 26) { j -= 26; L = 1; if (j >= 20) { j -= 20; L = 2; if (j >= 26) { j -= 26; L = 3; } } }
        const int nin = (L & 1) ? 4 : 10; const int i2 = L >> 1;
        if (j < nin) { u.pm = 2 * L; u.pn = ((L & 1) ? (32 + i2 * 16) : (i2 * 16)) + j; }
        else { u.pm = 2 * L + 1; u.pn = 64 + L * 32 + (j - nin); }
        return true;
    }
    __device__ __forceinline__ void a_ready(const Unit&) const {}
    __device__ __forceinline__ void done(const Unit&) const {}
};
template <class Epi, class Sched, bool ALIGN_EPI = false, bool SP2 = false>
__device__ __forceinline__ void gemm_phase(PG8_LAS unsigned char* lds, const Gemm g, const Sched& S, const Epi& E, const int wave_s) {
    int tid_ = wave_s * 64 + fresh_lane();
    const int tid = tid_, wid = __builtin_amdgcn_readfirstlane(tid >> 6), lane = tid & 63, wr = wid >> 2, wc = wid & 3, fr = lane & 15, fq = lane >> 4;
    const int K = g.K, nt = K / BK;
    unsigned voffA[2], voffB[2];
#pragma unroll
    for (int i = 0; i < 2; ++i) { int R, C; stage_rc(tid * 16 + i * 8192, R, C); const int Rb = Epi::HEAD64 ? (64 * (R >> 5) + perm32(R & 31)) : (Epi::PERM ? ((R & ~31) + perm32(R & 31)) : R);
        voffA[i] = (unsigned)(R * K + C) * 2u; voffB[i] = (unsigned)(Rb * K + C) * 2u; }
    const size_t kstep = (size_t)(BK * 2);
    const size_t hstep = (size_t)HALF * K * 2;
    const size_t hstepB = Epi::HEAD64 ? (size_t)32 * K * 2 : hstep;
    const size_t tstep = 2 * hstep;
    const unsigned ldsw = (unsigned)wid * 1024u;
    const int aoff = lds_byte(wr * 64 + fr, fq * 8), boff = lds_byte(wc * 32 + fr, fq * 8);
#define PG8_SA(b, h) (((b) * 2 + (h)) * HTB)
#define PG8_SB(b, h) ((4 + (b) * 2 + (h)) * HTB)
#define PG8_STAGE(bufoff, gbase, voff) do { _Pragma("unroll") for (int _i = 0; _i < 2; ++_i) \
        __builtin_amdgcn_global_load_lds((const unsigned*)((const char*)(gbase) + (voff)[_i]), (PG8_LAS unsigned*)(lds + (bufoff) + ldsw + _i * 8192), 16, 0, 0); } while (0)
#define PG8_LDA(dst, b, h) do { _Pragma("unroll") for (int m = 0; m < 4; ++m) _Pragma("unroll") for (int k = 0; k < 2; ++k) dst[m][k] = *(const PG8_LAS bf16x8*)(lds + PG8_SA(b, h) + aoff + m * 2048 + k * 1024); } while (0)
#define PG8_LDB(dst, b, h) do { _Pragma("unroll") for (int n = 0; n < 2; ++n) _Pragma("unroll") for (int k = 0; k < 2; ++k) dst[n][k] = *(const PG8_LAS bf16x8*)(lds + PG8_SB(b, h) + boff + n * 2048 + k * 1024); } while (0)
#define PG8_MMA(ai, bj, At, Bt) do { __builtin_amdgcn_s_setprio(1); _Pragma("unroll") for (int m = 0; m < 4; ++m) _Pragma("unroll") for (int n = 0; n < 2; ++n) _Pragma("unroll") for (int k = 0; k < 2; ++k) \
        acc[ai][bj][m][n] = __builtin_amdgcn_mfma_f32_16x16x32_bf16(Bt[n][k], At[m][k], acc[ai][bj][m][n], 0, 0, 0); __builtin_amdgcn_s_setprio(0); } while (0)
#define PG8_WAIT_V(n) asm volatile("s_waitcnt vmcnt(" #n ")" ::: "memory")
#define PG8_WAIT_L(n) asm volatile("s_waitcnt lgkmcnt(" #n ")" ::: "memory")
#define PG8_BAR __builtin_amdgcn_s_barrier()
#define PG8_SCHED __builtin_amdgcn_sched_barrier(0)
    Unit cur, nxt; int ui = 0;
    if (!S.next(0, cur)) return;
    f32x4 acc[2][2][4][2];
#pragma unroll
    for (int a = 0; a < 2; ++a)
#pragma unroll
        for (int b = 0; b < 2; ++b)
#pragma unroll
            for (int m = 0; m < 4; ++m)
#pragma unroll
                for (int n = 0; n < 2; ++n) acc[a][b][m][n] = (f32x4){0.f, 0.f, 0.f, 0.f};
    bf16x8 At[4][2], B0[2][2], B1[2][2];
    const char* cA = (const char*)g.A + (size_t)cur.pm * tstep; const char* cB = (const char*)g.Bt + (size_t)cur.pn * tstep;
    S.a_ready(cur);
    if constexpr (SP2) {
        PG8_STAGE(PG8_SB(0, 0), cB, voffB); PG8_STAGE(PG8_SB(0, 1), cB + hstepB, voffB); PG8_STAGE(PG8_SA(0, 0), cA, voffA); PG8_STAGE(PG8_SA(0, 1), cA + hstep, voffA);
        if (wr == 1) PG8_BAR;
        PG8_WAIT_V(2); PG8_BAR;
        PG8_STAGE(PG8_SB(1, 0), cB + kstep, voffB); PG8_STAGE(PG8_SA(1, 0), cA + kstep, voffA); PG8_STAGE(PG8_SB(1, 1), cB + hstepB + kstep, voffB);
        PG8_WAIT_V(6); PG8_BAR;
    } else {
        PG8_STAGE(PG8_SB(0, 0), cB, voffB); PG8_STAGE(PG8_SA(0, 0), cA, voffA); PG8_STAGE(PG8_SB(0, 1), cB + hstepB, voffB); PG8_STAGE(PG8_SA(0, 1), cA + hstep, voffA);
        if (wr == 1) PG8_BAR;
        PG8_WAIT_V(4); PG8_BAR;
        PG8_STAGE(PG8_SB(1, 0), cB + kstep, voffB); PG8_STAGE(PG8_SA(1, 0), cA + kstep, voffA); PG8_STAGE(PG8_SB(1, 1), cB + hstepB + kstep, voffB);
        PG8_WAIT_V(6); PG8_BAR;
    }
    for (;;) {
        const bool has_next = S.next(ui + 1, nxt);
        const char* nA = has_next ? (const char*)g.A + (size_t)nxt.pm * tstep : cA; const char* nB = has_next ? (const char*)g.Bt + (size_t)nxt.pn * tstep : cB;
        for (int t = 0; t < nt; t += 2) {
            const bool last = (t == nt - 2);
            const char* a1 = cA + (size_t)(t + 1) * kstep;
            const char* a2 = last ? nA : cA + (size_t)(t + 2) * kstep; const char* b2 = last ? nB : cB + (size_t)(t + 2) * kstep;
            const char* a3 = a2 + kstep; const char* b3 = b2 + kstep;
            if (last && has_next) S.a_ready(nxt);
            if constexpr (SP2) {
            PG8_LDB(B0, 0, 0); PG8_LDB(B1, 0, 1); PG8_SCHED; PG8_LDA(At, 0, 0); PG8_STAGE(PG8_SA(1, 1), a1 + hstep, voffA);
            PG8_WAIT_V(8); PG8_WAIT_L(0); PG8_BAR; PG8_MMA(0, 0, At, B0); PG8_MMA(0, 1, At, B1); PG8_BAR; PG8_SCHED;
            PG8_LDA(At, 0, 1); PG8_STAGE(PG8_SB(0, 0), b2, voffB); PG8_STAGE(PG8_SB(0, 1), b2 + hstepB, voffB); PG8_STAGE(PG8_SA(0, 0), a2, voffA);
            PG8_WAIT_V(8); PG8_WAIT_L(0); PG8_BAR; PG8_MMA(1, 0, At, B0); PG8_MMA(1, 1, At, B1); PG8_BAR; PG8_SCHED;
            PG8_LDB(B0, 1, 0); PG8_LDB(B1, 1, 1); PG8_SCHED; PG8_LDA(At, 1, 0); PG8_STAGE(PG8_SA(0, 1), a2 + hstep, voffA);
            PG8_WAIT_V(8); PG8_WAIT_L(0); PG8_BAR; PG8_MMA(0, 0, At, B0); PG8_MMA(0, 1, At, B1); PG8_BAR; PG8_SCHED;
            PG8_LDA(At, 1, 1); PG8_STAGE(PG8_SB(1, 0), b3, voffB); PG8_STAGE(PG8_SB(1, 1), b3 + hstepB, voffB); PG8_STAGE(PG8_SA(1, 0), a3, voffA);
            PG8_WAIT_V(8); PG8_WAIT_L(0); PG8_BAR; PG8_MMA(1, 0, At, B0); PG8_MMA(1, 1, At, B1); PG8_BAR; PG8_SCHED;
            } else {
            PG8_LDB(B0, 0, 0); PG8_SCHED; PG8_LDA(At, 0, 0); PG8_STAGE(PG8_SA(1, 1), a1 + hstep, voffA);
            PG8_WAIT_L(8); PG8_BAR; PG8_WAIT_L(0); PG8_MMA(0, 0, At, B0); PG8_BAR; PG8_SCHED;
            PG8_LDB(B1, 0, 1); PG8_STAGE(PG8_SB(0, 0), b2, voffB);
            PG8_BAR; PG8_WAIT_L(0); PG8_MMA(0, 1, At, B1); PG8_BAR;
            PG8_LDA(At, 0, 1); PG8_STAGE(PG8_SA(0, 0), a2, voffA);
            PG8_BAR; PG8_WAIT_L(0); PG8_MMA(1, 0, At, B0); PG8_BAR; PG8_SCHED;
            PG8_STAGE(PG8_SB(0, 1), b2 + hstepB, voffB);
            PG8_WAIT_V(6); PG8_BAR; PG8_MMA(1, 1, At, B1); PG8_BAR;
            PG8_LDB(B0, 1, 0); PG8_SCHED; PG8_LDA(At, 1, 0); PG8_STAGE(PG8_SA(0, 1), a2 + hstep, voffA);
            PG8_WAIT_L(8); PG8_BAR; PG8_WAIT_L(0); PG8_MMA(0, 0, At, B0); PG8_BAR; PG8_SCHED;
            PG8_LDB(B1, 1, 1); PG8_STAGE(PG8_SB(1, 0), b3, voffB);
            PG8_BAR; PG8_WAIT_L(0); PG8_MMA(0, 1, At, B1); PG8_BAR;
            PG8_LDA(At, 1, 1); PG8_STAGE(PG8_SA(1, 0), a3, voffA);
            PG8_BAR; PG8_WAIT_L(0); PG8_MMA(1, 0, At, B0); PG8_BAR; PG8_SCHED;
            PG8_STAGE(PG8_SB(1, 1), b3 + hstepB, voffB);
            PG8_WAIT_V(6); PG8_BAR; PG8_MMA(1, 1, At, B1); PG8_BAR;
            }
        }
        if constexpr (ALIGN_EPI) { if (wr == 0) PG8_BAR; }
        if constexpr (!Epi::AFTER_DRAIN) { E(acc, cur, wr, wc, fr, fq); S.done(cur); }
        if (!has_next) break;
#pragma unroll
        for (int a = 0; a < 2; ++a)
#pragma unroll
            for (int b = 0; b < 2; ++b)
#pragma unroll
                for (int m = 0; m < 4; ++m)
#pragma unroll
                    for (int n = 0; n < 2; ++n) acc[a][b][m][n] = (f32x4){0.f, 0.f, 0.f, 0.f};
        cur = nxt; cA = nA; cB = nB; ++ui;
        if constexpr (ALIGN_EPI) { if (wr == 1) PG8_BAR; }
    }
    PG8_WAIT_V(0);
    if constexpr (!ALIGN_EPI) { if (wr == 0) PG8_BAR; }
    PG8_BAR;
    if constexpr (Epi::AFTER_DRAIN) { E.fused(acc, cur, wr, wc, fr, fq, lds, wid, lane); S.done(cur); }
#undef PG8_SA
#undef PG8_SB
#undef PG8_STAGE
#undef PG8_LDA
#undef PG8_LDB
#undef PG8_MMA
#undef PG8_WAIT_V
#undef PG8_WAIT_L
#undef PG8_BAR
#undef PG8_SCHED
}
}

#define LAS __attribute__((address_space(3)))
typedef unsigned short bf16;
typedef short bf16x8 __attribute__((ext_vector_type(8)));
typedef float f32x4 __attribute__((ext_vector_type(4)));
typedef float f32x2 __attribute__((ext_vector_type(2)));
typedef float f32x16 __attribute__((ext_vector_type(16)));
typedef unsigned u32x4 __attribute__((ext_vector_type(4)));
typedef unsigned u32x2 __attribute__((ext_vector_type(2)));

constexpr int NWAVES = 8, NTHR = 512;
constexpr int NLAT = 65536, NCTX = 8192, R = NLAT + NCTX;
constexpr int D = 1024, FF = 4096, KV = 2304;
constexpr float EPS = 1e-6f, LOG2E = 1.4426950408889634f;
constexpr size_t MiB = 1u << 20;
constexpr size_t WS_MOD = 0, WS_W = 4 * MiB, WS_XCTX = 100 * MiB, WS_H = 132 * MiB, WS_R = 276 * MiB, WS_CTL = 996 * MiB, WS_SSQ = 997 * MiB, WS_SHB = 998 * MiB, WS_SHW = 1002 * MiB, WS_SSQM = 1007 * MiB, WS_END = 1008 * MiB;
constexpr size_t CTL_BYTES = 16384;
constexpr int MISC_OFF = 147456 - 64;
constexpr int LDS_BYTES = 147456;
constexpr int RAWP = 1792;
constexpr int MQP = 1536;

__device__ __forceinline__ unsigned f2bf(float f) { unsigned u = __builtin_bit_cast(unsigned, f); return (u + 0x7fffu + ((u >> 16) & 1u)) >> 16; }
__device__ __forceinline__ unsigned pk2(float lo, float hi) { return f2bf(lo) | (f2bf(hi) << 16); }
typedef __bf16 bf16x2_t __attribute__((ext_vector_type(2)));
__device__ __forceinline__ unsigned cvtpk_nv(float lo, float hi) { f32x2 v = {lo, hi}; bf16x2_t b = __builtin_convertvector(v, bf16x2_t); return __builtin_bit_cast(unsigned, b); }
__device__ __forceinline__ float bflo(unsigned u) { return __builtin_bit_cast(float, u << 16); }
__device__ __forceinline__ float bfhi(unsigned u) { return __builtin_bit_cast(float, u & 0xffff0000u); }
__device__ __forceinline__ float shx(float v, int o, int lane) { return __builtin_bit_cast(float, __builtin_amdgcn_ds_bpermute((lane ^ o) << 2, __builtin_bit_cast(int, v))); }
__device__ __forceinline__ float wave_sum(float v, int lane) {
#pragma unroll
    for (int o = 1; o < 64; o <<= 1) v += shx(v, o, lane);
    return v;
}
__device__ __forceinline__ float wave_max(float v, int lane) {
#pragma unroll
    for (int o = 1; o < 64; o <<= 1) v = fmaxf(v, shx(v, o, lane));
    return v;
}
__device__ __forceinline__ void cs_of(float a, float& c, float& s) {
    double rev = (double)a * 0.15915494309189535; rev -= floor(rev); const float rf = (float)rev;
    c = __builtin_amdgcn_cosf(rf); s = __builtin_amdgcn_sinf(rf);
}

__device__ __forceinline__ void xpose_item(const float* W, int srcN, int scol, bf16* WT, int K, int drow, LAS float* scr, int k0, int lane) {
#pragma unroll 8
    for (int i = 0; i < 32; ++i) { const int kk = 2 * i + (lane >> 5); scr[kk * 33 + (lane & 31)] = W[(size_t)(k0 + kk) * srcN + scol + (lane & 31)]; }
    asm volatile("s_waitcnt lgkmcnt(0)" ::: "memory");
    const int c = lane & 7;
#pragma unroll
    for (int j = 0; j < 4; ++j) { const int n = (lane >> 3) + 8 * j; const LAS float* s = scr + (8 * c) * 33 + n;
        u32x4 o; o.x = pk2(s[0 * 33], s[1 * 33]); o.y = pk2(s[2 * 33], s[3 * 33]); o.z = pk2(s[4 * 33], s[5 * 33]); o.w = pk2(s[6 * 33], s[7 * 33]);
        *(u32x4*)(WT + (size_t)(drow + n) * K + k0 + 8 * c) = o; }
    asm volatile("s_waitcnt lgkmcnt(0)" ::: "memory");
}
__device__ __forceinline__ void xpose_seg(const float* W, int K, int srcN, int scol0, int ncols, bool hs, bf16* WT, int drow0, LAS float* scr, int gw, int NGW, int& cur, int lane) {
    const int nblk = ncols / 32, nit = (K / 64) * nblk;
    int it = gw - cur; if (it < 0) it += NGW;
    for (; it < nit; it += NGW) { const int kb = it / nblk, nb = it % nblk; const int sc = scol0 + (hs ? ((nb >> 1) * 128 + (nb & 1) * 32) : nb * 32);
        xpose_item(W, srcN, sc, WT, K, drow0 + nb * 32, scr, kb * 64, lane); }
    cur = (cur + nit) % NGW;
}
__device__ __forceinline__ void zero_rows(bf16* WT, int K, int row0, int nrows, int gw, int NGW, int lane) {
    const int n16 = nrows * K / 8; u32x4* p = (u32x4*)(WT + (size_t)row0 * K); const u32x4 z = {0u, 0u, 0u, 0u};
    for (int i = gw * 64 + lane; i < n16; i += NGW * 64) p[i] = z;
}

__device__ __forceinline__ void norm_phase(const float* xlat, const float* xctx, const float* g, const float* modl, int sh_off, int sc_off, bf16* H, int vcu, int NGW, int wave_s) {
    const int lane = fresh_lane(); const int gw = vcu * NWAVES + wave_s;
    f32x4 g4[4];
#pragma unroll
    for (int j = 0; j < 4; ++j) g4[j] = *(const f32x4*)(g + 256 * j + 4 * lane);
    for (int r0 = gw; r0 < R; r0 += 2 * NGW) {
        const int r1 = r0 + NGW; const bool has1 = r1 < R;
        const float* xr0 = (r0 < NLAT) ? xlat + (size_t)r0 * D : xctx + (size_t)(r0 - NLAT) * D;
        const float* xr1 = has1 ? ((r1 < NLAT) ? xlat + (size_t)r1 * D : xctx + (size_t)(r1 - NLAT) * D) : xr0;
        f32x4 v0[4], v1[4]; float s0 = 0.f, s1 = 0.f;
#pragma unroll
        for (int j = 0; j < 4; ++j) { v0[j] = *(const f32x4*)(xr0 + 256 * j + 4 * lane); v1[j] = *(const f32x4*)(xr1 + 256 * j + 4 * lane); }
#pragma unroll
        for (int j = 0; j < 4; ++j) { s0 += (v0[j].x * v0[j].x + v0[j].y * v0[j].y) + (v0[j].z * v0[j].z + v0[j].w * v0[j].w); s1 += (v1[j].x * v1[j].x + v1[j].y * v1[j].y) + (v1[j].z * v1[j].z + v1[j].w * v1[j].w); }
        const float ri0 = 1.0f / sqrtf(wave_sum(s0, lane) * (1.0f / D) + EPS), ri1 = 1.0f / sqrtf(wave_sum(s1, lane) * (1.0f / D) + EPS);
        const float* mp0 = modl + ((r0 < NLAT) ? (r0 >> 11) : 32) * 6144; const float* mp1 = modl + ((r1 < NLAT) ? (r1 >> 11) : 32) * 6144;
#pragma unroll
        for (int j = 0; j < 4; ++j) { const int c = 256 * j + 4 * lane; const f32x4 sc = *(const f32x4*)(mp0 + sc_off + c), sh = *(const f32x4*)(mp0 + sh_off + c);
            const f32x4 y = (v0[j] * ri0 * g4[j]) * (sc + 1.0f) + sh; u32x2 w; w.x = pk2(y.x, y.y); w.y = pk2(y.z, y.w);
            *(u32x2*)(H + (size_t)r0 * D + c) = w; }
        if (has1) {
#pragma unroll
            for (int j = 0; j < 4; ++j) { const int c = 256 * j + 4 * lane; const f32x4 sc = *(const f32x4*)(mp1 + sc_off + c), sh = *(const f32x4*)(mp1 + sh_off + c);
                const f32x4 y = (v1[j] * ri1 * g4[j]) * (sc + 1.0f) + sh; u32x2 w; w.x = pk2(y.x, y.y); w.y = pk2(y.z, y.w);
                *(u32x2*)(H + (size_t)r1 * D + c) = w; }
        }
    }
}
__device__ __forceinline__ void prep_phase(const float* xlat, const float* xctx, const float* g, const float* modl, int sc_off, bf16* AP, float* ssq, int vcu, int NGW, int wave_s) {
    const int lane = fresh_lane(); const int gw = vcu * NWAVES + wave_s;
    f32x4 g4[4];
#pragma unroll
    for (int j = 0; j < 4; ++j) g4[j] = *(const f32x4*)(g + 256 * j + 4 * lane);
    for (int r0 = gw; r0 < R; r0 += 2 * NGW) {
        const int r1 = r0 + NGW; const bool has1 = r1 < R;
        const float* xr0 = (r0 < NLAT) ? xlat + (size_t)r0 * D : xctx + (size_t)(r0 - NLAT) * D;
        const float* xr1 = has1 ? ((r1 < NLAT) ? xlat + (size_t)r1 * D : xctx + (size_t)(r1 - NLAT) * D) : xr0;
        f32x4 v0[4], v1[4]; float s0 = 0.f, s1 = 0.f;
#pragma unroll
        for (int j = 0; j < 4; ++j) { v0[j] = *(const f32x4*)(xr0 + 256 * j + 4 * lane); v1[j] = *(const f32x4*)(xr1 + 256 * j + 4 * lane); }
#pragma unroll
        for (int j = 0; j < 4; ++j) { s0 += (v0[j].x * v0[j].x + v0[j].y * v0[j].y) + (v0[j].z * v0[j].z + v0[j].w * v0[j].w); s1 += (v1[j].x * v1[j].x + v1[j].y * v1[j].y) + (v1[j].z * v1[j].z + v1[j].w * v1[j].w); }
        s0 = wave_sum(s0, lane); s1 = wave_sum(s1, lane);
        const float* mp0 = modl + ((r0 < NLAT) ? (r0 >> 11) : 32) * 6144; const float* mp1 = modl + ((r1 < NLAT) ? (r1 >> 11) : 32) * 6144;
#pragma unroll
        for (int j = 0; j < 4; ++j) { const int c = 256 * j + 4 * lane; const f32x4 sc = *(const f32x4*)(mp0 + sc_off + c);
            const f32x4 y = (v0[j] * g4[j]) * (sc + 1.0f); u32x2 w; w.x = pk2(y.x, y.y); w.y = pk2(y.z, y.w);
            *(u32x2*)(AP + (size_t)r0 * D + c) = w; }
        if (lane == 0) ssq[r0] = s0;
        if (has1) {
#pragma unroll
            for (int j = 0; j < 4; ++j) { const int c = 256 * j + 4 * lane; const f32x4 sc = *(const f32x4*)(mp1 + sc_off + c);
                const f32x4 y = (v1[j] * g4[j]) * (sc + 1.0f); u32x2 w; w.x = pk2(y.x, y.y); w.y = pk2(y.z, y.w);
                *(u32x2*)(AP + (size_t)r1 * D + c) = w; }
            if (lane == 0) ssq[r1] = s1;
        }
    }
}
__device__ __forceinline__ void zero_f32(float* p, int n, int vcu, int NGW, int wave_s) {
    const int lane = fresh_lane(); const int gw = vcu * NWAVES + wave_s;
    for (int i = gw * 64 + lane; i < n; i += NGW * 64) p[i] = 0.f;
}
__device__ __forceinline__ void mlanorm_phase(const bf16* MRAW, const float* gq, const float* gkv, bf16* QCn, bf16* KVCn, int vcu, int NGW, int wave_s) {
    const int lane = fresh_lane(); const int gw = vcu * NWAVES + wave_s;
    u32x4 na = {0u, 0u, 0u, 0u}; u32x2 nb = {0u, 0u};
    if (gw < R) { na = *(const u32x4*)(MRAW + (size_t)gw * 1024 + 8 * lane); nb = *(const u32x2*)(MRAW + (size_t)gw * 1024 + 512 + 4 * lane); }
    for (int r = gw; r < R; r += NGW) {
        const bf16* row = MRAW + (size_t)r * 1024;
        const u32x4 a = na; const u32x2 b = nb;
        if (r + NGW < R) { na = *(const u32x4*)(row + (size_t)NGW * 1024 + 8 * lane); nb = *(const u32x2*)(row + (size_t)NGW * 1024 + 512 + 4 * lane); }
        float x[8] = {bflo(a.x), bfhi(a.x), bflo(a.y), bfhi(a.y), bflo(a.z), bfhi(a.z), bflo(a.w), bfhi(a.w)}; float y[4] = {bflo(b.x), bfhi(b.x), bflo(b.y), bfhi(b.y)};
        float s1 = 0.f, s2 = 0.f;
#pragma unroll
        for (int e = 0; e < 8; ++e) s1 += x[e] * x[e];
#pragma unroll
        for (int e = 0; e < 4; ++e) s2 += y[e] * y[e];
        const float r1 = 1.0f / sqrtf(wave_sum(s1, lane) * (1.0f / 512) + EPS), r2 = 1.0f / sqrtf(wave_sum(s2, lane) * (1.0f / 256) + EPS);
        const f32x4 g0 = *(const f32x4*)(gq + 8 * lane), g1 = *(const f32x4*)(gq + 8 * lane + 4), g2 = *(const f32x4*)(gkv + 4 * lane);
        u32x4 o; o.x = pk2(x[0] * r1 * g0.x, x[1] * r1 * g0.y); o.y = pk2(x[2] * r1 * g0.z, x[3] * r1 * g0.w); o.z = pk2(x[4] * r1 * g1.x, x[5] * r1 * g1.y); o.w = pk2(x[6] * r1 * g1.z, x[7] * r1 * g1.w);
        *(u32x4*)(QCn + (size_t)r * 512 + 8 * lane) = o;
        u32x2 p; p.x = pk2(y[0] * r2 * g2.x, y[1] * r2 * g2.y); p.y = pk2(y[2] * r2 * g2.z, y[3] * r2 * g2.w);
        *(u32x2*)(KVCn + (size_t)r * 256 + 4 * lane) = p;
    }
}
__device__ __forceinline__ void post_even(bf16* RAW, const float* gdq, const float* gdk, const float* ggq, const float* ggk, int vcu, int NGW, int wave_s) {
    const int lane = fresh_lane(); const int gw = vcu * NWAVES + wave_s;
    const int sub = lane & 15; const float L2T = 13.287712379549449f;
    float invf[4];
#pragma unroll
    for (int e = 0; e < 4; ++e) { const int jj = 4 * (sub & 7) + e; invf[e] = exp2f(-(float)(jj & 15) * (1.0f / 16.0f) * L2T); }
    f32x4 G[4]; G[0] = *(const f32x4*)(gdq + 4 * sub); G[1] = *(const f32x4*)(gdk + 4 * sub); G[2] = *(const f32x4*)(ggq + 4 * sub); G[3] = *(const f32x4*)(ggk + 4 * sub);
    u32x2 nx[7];
    if (gw < R) {
#pragma unroll
        for (int c = 0; c < 7; ++c) if (c == 2 || c == 3 || c == 6) nx[c] = *(const u32x2*)(RAW + (size_t)gw * RAWP + 256 * c + 4 * lane); }
    for (int r = gw; r < R; r += NGW) {
        const bool isl = r < NLAT; const int t = r & 2047; const float prow = (float)(t >> 6), pcol = (float)(t & 63);
        float cs[4], sn[4];
#pragma unroll
        for (int e = 0; e < 4; ++e) { if (isl) { const int jj = 4 * (sub & 7) + e; cs_of((jj < 16 ? prow : pcol) * invf[e], cs[e], sn[e]); } else { cs[e] = 1.f; sn[e] = 0.f; } }
        bf16* row = RAW + (size_t)r * RAWP;
        u32x2 av[7];
#pragma unroll
        for (int c = 0; c < 7; ++c) if (c == 2 || c == 3 || c == 6) av[c] = nx[c];
        if (r + NGW < R) {
#pragma unroll
            for (int c = 0; c < 7; ++c) if (c == 2 || c == 3 || c == 6) nx[c] = *(const u32x2*)(row + (size_t)NGW * RAWP + 256 * c + 4 * lane); }
#pragma unroll
        for (int c = 0; c < 7; ++c) { if (!(c == 2 || c == 3 || c == 6)) continue;
            const u32x2 a = av[c];
            float x[4] = {bflo(a.x), bfhi(a.x), bflo(a.y), bfhi(a.y)};
            float ss = (x[0] * x[0] + x[1] * x[1]) + (x[2] * x[2] + x[3] * x[3]);
            ss += shx(ss, 1, lane); ss += shx(ss, 2, lane); ss += shx(ss, 4, lane); ss += shx(ss, 8, lane);
            const float rinv = 1.0f / sqrtf(ss * (1.0f / 64) + EPS);
            const f32x4 g4 = G[c < 2 ? 0 : (c < 4 ? 1 : (c < 6 ? 2 : 3))];
            const float qs = (c < 2 || c == 4 || c == 5) ? 0.125f * LOG2E : 1.0f;
            float y[4] = {x[0] * rinv * g4.x, x[1] * rinv * g4.y, x[2] * rinv * g4.z, x[3] * rinv * g4.w}; float o[4];
#pragma unroll
            for (int e = 0; e < 4; ++e) { const float py = shx(y[e], 8, lane); o[e] = ((sub < 8) ? (y[e] * cs[e] - py * sn[e]) : (y[e] * cs[e] + py * sn[e])) * qs; }
            u32x2 w; w.x = pk2(o[0], o[1]); w.y = pk2(o[2], o[3]);
            *(u32x2*)(row + 256 * c + 4 * lane) = w;
        }
    }
}
__device__ __forceinline__ void post_mla(bf16* Q, bf16* Kb, const bf16* MRAW, const float* gq, const float* gk, int vcu, int NGW, int wave_s) {
    const int lane = fresh_lane(); const int gw = vcu * NWAVES + wave_s;
    const int i = lane & 31, half = lane >> 5; const float L2T = 13.287712379549449f;
    float invf[2];
#pragma unroll
    for (int e = 0; e < 2; ++e) { const int jj = (2 * i + e) & 15; invf[e] = exp2f(-(float)(jj & 7) * (1.0f / 8.0f) * L2T); }
    const f32x2 gqa = *(const f32x2*)(gq + 2 * i), gqb = *(const f32x2*)(gq + 64 + 2 * (i & 15)), gka = *(const f32x2*)(gk + 2 * i), gkb = *(const f32x2*)(gk + 64 + 2 * (i & 15));
    const float qs = 0.10206207261596577f * LOG2E;
    unsigned na[2][8], nb[8], nkr = 0u;
#define MLA_LOAD(rr) do { _Pragma("unroll") for (int p = 0; p < 8; ++p) { na[0][p] = 0u; na[1][p] = *(const unsigned*)(Kb + (size_t)(rr) * MQP + (2 * p + half) * 96 + 2 * i); nb[p] = 0u; } \
        nkr = (i < 16) ? *(const unsigned*)(MRAW + (size_t)(rr) * 32 + 2 * i) : 0u; } while (0)
    if (gw < R) MLA_LOAD(gw);
    for (int r = gw; r < R; r += NGW) {
        const bool isl = r < NLAT; const int t = r & 2047; const float prow = (float)(t >> 6), pcol = (float)(t & 63);
        float cs[2], sn[2];
#pragma unroll
        for (int e = 0; e < 2; ++e) { if (isl) { const int jj = (2 * i + e) & 15; cs_of((jj < 8 ? prow : pcol) * invf[e], cs[e], sn[e]); } else { cs[e] = 1.f; sn[e] = 0.f; } }
        unsigned la[2][8], lb[8];
#pragma unroll
        for (int p = 0; p < 8; ++p) { la[0][p] = na[0][p]; la[1][p] = na[1][p]; lb[p] = nb[p]; }
        const unsigned krw = nkr;
        if (r + NGW < R) { const int rn = r + NGW; MLA_LOAD(rn); }
#pragma unroll
        for (int isk = 1; isk < 2; ++isk) {
            bf16* base = (isk ? Kb : Q) + (size_t)r * MQP; const f32x2 ga = isk ? gka : gqa, gb = isk ? gkb : gqb; const float sc = isk ? 1.0f : qs;
#pragma unroll
            for (int p = 0; p < 8; ++p) {
                bf16* hp = base + (2 * p + half) * 96;
                const unsigned a = la[isk][p];
                const unsigned b = isk ? krw : lb[p];
                const float a0 = bflo(a), a1 = bfhi(a), b0 = bflo(b), b1 = bfhi(b);
                float ss = (a0 * a0 + a1 * a1) + (b0 * b0 + b1 * b1);
                ss += shx(ss, 1, lane); ss += shx(ss, 2, lane); ss += shx(ss, 4, lane); ss += shx(ss, 8, lane); ss += shx(ss, 16, lane);
                const float rinv = 1.0f / sqrtf(ss * (1.0f / 96) + EPS);
                const float y0 = b0 * rinv * gb.x, y1 = b1 * rinv * gb.y; const float p0 = shx(y0, 8, lane), p1 = shx(y1, 8, lane);
                const float o0 = (i < 8) ? (y0 * cs[0] - p0 * sn[0]) : (y0 * cs[0] + p0 * sn[0]);
                const float o1 = (i < 8) ? (y1 * cs[1] - p1 * sn[1]) : (y1 * cs[1] + p1 * sn[1]);
                *(unsigned*)(hp + 2 * i) = pk2(a0 * rinv * ga.x * sc, a1 * rinv * ga.y * sc);
                if (i < 16) *(unsigned*)(hp + 64 + 2 * i) = pk2(o0 * sc, o1 * sc);
            }
        }
    }
}

#undef MLA_LOAD
template <int DQK>
__device__ __forceinline__ void q_prep(bf16x8 (&qf)[DQK / 16], const float* gq, int row, float qs, int lane) {
    constexpr int NKS = DQK / 16; const int hh = lane >> 5; const float L2T = 13.287712379549449f;
    float x[NKS][8]; float ss = 0.f;
#pragma unroll
    for (int ks = 0; ks < NKS; ++ks)
#pragma unroll
        for (int e = 0; e < 8; ++e) { x[ks][e] = __builtin_bit_cast(float, ((unsigned)(unsigned short)qf[ks][e]) << 16); ss += x[ks][e] * x[ks][e]; }
    ss += shx(ss, 32, lane);
    const float rinv = 1.0f / sqrtf(ss * (1.0f / DQK) + EPS);
#pragma unroll
    for (int ks = 0; ks < NKS; ++ks) { const f32x4 g0 = *(const f32x4*)(gq + 16 * ks + 8 * hh), g1 = *(const f32x4*)(gq + 16 * ks + 8 * hh + 4);
        x[ks][0] *= rinv * g0.x; x[ks][1] *= rinv * g0.y; x[ks][2] *= rinv * g0.z; x[ks][3] *= rinv * g0.w; x[ks][4] *= rinv * g1.x; x[ks][5] *= rinv * g1.y; x[ks][6] *= rinv * g1.z; x[ks][7] *= rinv * g1.w; }
    if (row < NLAT) { const int t = row & 2047; const float prow = (float)(t >> 6), pcol = (float)(t & 63);
        if (DQK == 64) {
#pragma unroll
            for (int e = 0; e < 8; ++e) { const float invf = exp2f(-(float)(8 * hh + e) * (1.0f / 16.0f) * L2T); float c0, s0, c1, s1; cs_of(prow * invf, c0, s0); cs_of(pcol * invf, c1, s1);
                const float a0 = x[0][e], b0 = x[2][e], a1 = x[1][e], b1 = x[3][e];
                x[0][e] = a0 * c0 - b0 * s0; x[2][e] = b0 * c0 + a0 * s0; x[1][e] = a1 * c1 - b1 * s1; x[3][e] = b1 * c1 + a1 * s1; }
        } else {
#pragma unroll
            for (int e = 0; e < 8; ++e) { const float invf = exp2f(-(float)e * (1.0f / 8.0f) * L2T); float c, s; cs_of((hh ? pcol : prow) * invf, c, s);
                const float a = x[NKS - 2][e], b = x[NKS - 1][e]; x[NKS - 2][e] = a * c - b * s; x[NKS - 1][e] = b * c + a * s; }
        } }
#pragma unroll
    for (int ks = 0; ks < NKS; ++ks) { u32x4 w; w.x = pk2(x[ks][0] * qs, x[ks][1] * qs); w.y = pk2(x[ks][2] * qs, x[ks][3] * qs); w.z = pk2(x[ks][4] * qs, x[ks][5] * qs); w.w = pk2(x[ks][6] * qs, x[ks][7] * qs);
        qf[ks] = __builtin_bit_cast(bf16x8, w); }
}
template <int DQK, int DV, bool PIPE>
__device__ __forceinline__ void attn_pass(LAS unsigned char* lds, const bf16* Qw, int qpitch, const bf16* Kctx, const bf16* Klat, int kpitch, const bf16* VT, int ntiles, const float* gq, int qrow0, float qs,
                                          f32x16 (&o)[DV / 32], float& lsum, const int wave_s) {
    constexpr int KSTR = DQK * 2 + 16, VSTR = 144, KBYTES = 64 * KSTR, VBYTES = DV * VSTR, KC = DQK / 8, NKS = DQK / 16, NDB = DV / 32, NV = 4 * NDB;
    const int lane = fresh_lane(), tid = wave_s * 64 + lane, i = lane & 31, hh = lane >> 5;
    bf16x8 qf[NKS];
#pragma unroll
    for (int ks = 0; ks < NKS; ++ks) qf[ks] = *(const bf16x8*)(Qw + (size_t)i * qpitch + 16 * ks + 8 * hh);
    q_prep<DQK>(qf, gq, qrow0 + i, qs, lane);
#pragma unroll
    for (int db = 0; db < NDB; ++db)
#pragma unroll
        for (int r = 0; r < 16; ++r) o[db][r] = 0.f;
    lsum = 0.f;
    const int kc0 = tid, kc1 = tid + 512; const bool k2 = (DQK == 96) && (tid < 256);
    const int kr0 = kc0 / KC, kcc0 = kc0 % KC, kr1 = kc1 / KC, kcc1 = kc1 % KC;
    const int vd0 = tid >> 3, vc0 = tid & 7;
    u32x4 kreg0, kreg1 = {0u, 0u, 0u, 0u}, vreg0, vreg1 = {0u, 0u, 0u, 0u};
    constexpr bool TPB2 = (!PIPE) && (NV == 8);
    LAS unsigned char* const Kl = lds; LAS unsigned char* const Vl = lds + (TPB2 ? 4 : 2) * KBYTES;
    const int kfo = i * KSTR + 16 * hh, vfo = i * VSTR + 16 * hh;
    const unsigned koff0 = (unsigned)(kr0 * kpitch + 8 * kcc0) * 2u, koff1 = (unsigned)(kr1 * kpitch + 8 * kcc1) * 2u;
    const unsigned voff0 = (unsigned)(vd0 * KV + 8 * vc0) * 2u, voff1 = (unsigned)((vd0 + 64) * KV + 8 * vc0) * 2u;
#define AT_LOADK(t) do { const char* kt = (const char*)(((t) < 4) ? Kctx + (size_t)(64 * (t)) * kpitch : Klat + (size_t)(64 * ((t) - 4)) * kpitch); \
        kreg0 = *(const u32x4*)(kt + koff0); if (k2) kreg1 = *(const u32x4*)(kt + koff1); } while (0)
#define AT_LOADV(t) do { const char* vt_ = (const char*)(VT + 64 * (t)); vreg0 = *(const u32x4*)(vt_ + voff0); if (DV == 128) vreg1 = *(const u32x4*)(vt_ + voff1); } while (0)
#define AT_WRITEK(bufi) do { LAS unsigned char* kb_ = Kl + (bufi) * KBYTES; *(LAS u32x4*)(kb_ + kr0 * KSTR + 16 * kcc0) = kreg0; if (k2) *(LAS u32x4*)(kb_ + kr1 * KSTR + 16 * kcc1) = kreg1; } while (0)
#define AT_WRITEV(bufi) do { LAS unsigned char* vb_ = Vl + (bufi) * VBYTES; *(LAS u32x4*)(vb_ + vd0 * VSTR + 16 * vc0) = vreg0; if (DV == 128) *(LAS u32x4*)(vb_ + (vd0 + 64) * VSTR + 16 * vc0) = vreg1; } while (0)
    u32x4 kregB0, kregB1 = {0u, 0u, 0u, 0u}, vregB0;
#define AT_LOADKB(t) do { const char* kt = (const char*)(((t) < 4) ? Kctx + (size_t)(64 * (t)) * kpitch : Klat + (size_t)(64 * ((t) - 4)) * kpitch); \
        kregB0 = *(const u32x4*)(kt + koff0); if (k2) kregB1 = *(const u32x4*)(kt + koff1); } while (0)
#define AT_LOADVB(t) do { const char* vt_ = (const char*)(VT + 64 * (t)); vregB0 = *(const u32x4*)(vt_ + voff0); } while (0)
#define AT_WRITEKB(bufi) do { LAS unsigned char* kb_ = Kl + (bufi) * KBYTES; *(LAS u32x4*)(kb_ + kr0 * KSTR + 16 * kcc0) = kregB0; if (k2) *(LAS u32x4*)(kb_ + kr1 * KSTR + 16 * kcc1) = kregB1; } while (0)
#define AT_WRITEVB(bufi) do { LAS unsigned char* vb_ = Vl + (bufi) * VBYTES; *(LAS u32x4*)(vb_ + vd0 * VSTR + 16 * vc0) = vregB0; } while (0)
#define AT_KFRAGS(bufi) do { const LAS unsigned char* Kb = Kl + (bufi) * KBYTES + kfo; \
        _Pragma("unroll") for (int ks = 0; ks < NKS; ++ks) { kf[2 * ks] = *(const LAS bf16x8*)(Kb + 32 * ks); kf[2 * ks + 1] = *(const LAS bf16x8*)(Kb + 32 * KSTR + 32 * ks); } } while (0)
#define AT_QKM(P0, P1) do { _Pragma("unroll") for (int r = 0; r < 16; ++r) { P0[r] = 0.f; P1[r] = 0.f; } \
        _Pragma("unroll") for (int ks = 0; ks < NKS; ++ks) { P0 = __builtin_amdgcn_mfma_f32_32x32x16_bf16(kf[2 * ks], qf[ks], P0, 0, 0, 0); \
            P1 = __builtin_amdgcn_mfma_f32_32x32x16_bf16(kf[2 * ks + 1], qf[ks], P1, 0, 0, 0); } } while (0)
#define AT_VFRAGS(dst, m0, bufi) do { const LAS unsigned char* Vb = Vl + (bufi) * VBYTES + vfo; \
        _Pragma("unroll") for (int m = 0; m < 8; ++m) { const int s_ = ((m0) + m) / NDB, db_ = ((m0) + m) % NDB; dst[m] = *(const LAS bf16x8*)(Vb + 32 * db_ * VSTR + 32 * s_); } } while (0)
#define AT_PVM(src, m0) do { _Pragma("unroll") for (int m = 0; m < 8; ++m) { const int s_ = ((m0) + m) / NDB, db_ = ((m0) + m) % NDB; \
        o[db_] = __builtin_amdgcn_mfma_f32_32x32x16_bf16(src[m], pf[s_], o[db_], 0, 0, 0); } } while (0)
    f32x16 p0, p1, n0, n1; bf16x8 kf[2 * NKS], vfa[8], pf[4];
    if (PIPE) {
        AT_LOADK(0); AT_LOADV(0); AT_WRITEK(0); AT_WRITEV(0);
        AT_LOADK(1);
        __syncthreads();
        AT_KFRAGS(0); AT_QKM(p0, p1);
        AT_WRITEK(1);
        if (2 < ntiles) AT_LOADK(2);
        AT_LOADV(1);
        __syncthreads();
    } else if (TPB2) {
        AT_LOADK(0); AT_LOADV(0); AT_LOADKB(1); AT_LOADVB(1); AT_WRITEK(0); AT_WRITEV(0); AT_WRITEKB(1); AT_WRITEVB(1);
        AT_LOADK(2); AT_LOADV(2); AT_LOADKB(3); AT_LOADVB(3);
        __syncthreads();
    } else {
        AT_LOADK(0); AT_LOADV(0); AT_WRITEK(0); AT_WRITEV(0);
        AT_LOADK(1); AT_LOADV(1);
        __syncthreads();
    }
#define AT_BODY(HASNEXT, C0, C1, N0, N1, TT) do { const int t = (TT); \
        if (PIPE) { if (HASNEXT) AT_KFRAGS((t + 1) & 1); } else AT_KFRAGS(t & 1); \
        AT_VFRAGS(vfa, 0, t & 1); \
        __builtin_amdgcn_sched_barrier(0); \
        if (!PIPE) AT_QKM(C0, C1); \
        float ls = 0.f; \
        _Pragma("unroll") for (int r = 0; r < 16; ++r) { C0[r] = __builtin_amdgcn_exp2f(C0[r]); C1[r] = __builtin_amdgcn_exp2f(C1[r]); ls += C0[r] + C1[r]; } \
        lsum += ls; \
        { u32x4 w; \
          w.x = cvtpk_nv(C0[0], C0[1]); w.y = cvtpk_nv(C0[2], C0[3]); w.z = cvtpk_nv(C0[4], C0[5]); w.w = cvtpk_nv(C0[6], C0[7]); pf[0] = __builtin_bit_cast(bf16x8, w); \
          w.x = cvtpk_nv(C0[8], C0[9]); w.y = cvtpk_nv(C0[10], C0[11]); w.z = cvtpk_nv(C0[12], C0[13]); w.w = cvtpk_nv(C0[14], C0[15]); pf[1] = __builtin_bit_cast(bf16x8, w); \
          w.x = cvtpk_nv(C1[0], C1[1]); w.y = cvtpk_nv(C1[2], C1[3]); w.z = cvtpk_nv(C1[4], C1[5]); w.w = cvtpk_nv(C1[6], C1[7]); pf[2] = __builtin_bit_cast(bf16x8, w); \
          w.x = cvtpk_nv(C1[8], C1[9]); w.y = cvtpk_nv(C1[10], C1[11]); w.z = cvtpk_nv(C1[12], C1[13]); w.w = cvtpk_nv(C1[14], C1[15]); pf[3] = __builtin_bit_cast(bf16x8, w); } \
        if (PIPE && (HASNEXT)) AT_QKM(N0, N1); \
        if (NV == 16) { __builtin_amdgcn_sched_barrier(0); AT_VFRAGS(kf, 8, t & 1); __builtin_amdgcn_sched_barrier(0); __builtin_amdgcn_s_setprio(1); AT_PVM(vfa, 0); AT_PVM(kf, 8); __builtin_amdgcn_s_setprio(0); } \
        else { __builtin_amdgcn_s_setprio(1); AT_PVM(vfa, 0); __builtin_amdgcn_s_setprio(0); } \
        if (PIPE) { if (t + 2 < ntiles) AT_WRITEK(t & 1); if (t + 1 < ntiles) AT_WRITEV((t + 1) & 1); if (t + 3 < ntiles) AT_LOADK(t + 3); if (t + 2 < ntiles) AT_LOADV(t + 2); } \
        else { if (t + 1 < ntiles) { AT_WRITEK((t + 1) & 1); AT_WRITEV((t + 1) & 1); } if (t + 2 < ntiles) { AT_LOADK(t + 2); AT_LOADV(t + 2); } } \
        __syncthreads(); \
    } while (0)
    int tt = 0;
    if (PIPE) {
        for (; tt < ntiles - 2; tt += 2) { AT_BODY(true, p0, p1, n0, n1, tt); AT_BODY(true, n0, n1, p0, p1, tt + 1); }
        AT_BODY(true, p0, p1, n0, n1, tt); AT_BODY(false, n0, n1, p0, p1, tt + 1);
    } else {
        if (TPB2) {
#define AT_SUB(slot) do { AT_KFRAGS(slot); AT_VFRAGS(vfa, 0, slot); __builtin_amdgcn_sched_barrier(0); AT_QKM(p0, p1); \
            float ls = 0.f; _Pragma("unroll") for (int r = 0; r < 16; ++r) { p0[r] = __builtin_amdgcn_exp2f(p0[r]); p1[r] = __builtin_amdgcn_exp2f(p1[r]); ls += p0[r] + p1[r]; } lsum += ls; \
            { u32x4 w; \
              w.x = cvtpk_nv(p0[0], p0[1]); w.y = cvtpk_nv(p0[2], p0[3]); w.z = cvtpk_nv(p0[4], p0[5]); w.w = cvtpk_nv(p0[6], p0[7]); pf[0] = __builtin_bit_cast(bf16x8, w); \
              w.x = cvtpk_nv(p0[8], p0[9]); w.y = cvtpk_nv(p0[10], p0[11]); w.z = cvtpk_nv(p0[12], p0[13]); w.w = cvtpk_nv(p0[14], p0[15]); pf[1] = __builtin_bit_cast(bf16x8, w); \
              w.x = cvtpk_nv(p1[0], p1[1]); w.y = cvtpk_nv(p1[2], p1[3]); w.z = cvtpk_nv(p1[4], p1[5]); w.w = cvtpk_nv(p1[6], p1[7]); pf[2] = __builtin_bit_cast(bf16x8, w); \
              w.x = cvtpk_nv(p1[8], p1[9]); w.y = cvtpk_nv(p1[10], p1[11]); w.z = cvtpk_nv(p1[12], p1[13]); w.w = cvtpk_nv(p1[14], p1[15]); pf[3] = __builtin_bit_cast(bf16x8, w); } \
            __builtin_amdgcn_s_setprio(1); AT_PVM(vfa, 0); __builtin_amdgcn_s_setprio(0); } while (0)
            for (int pp = 0; 2 * pp < ntiles; ++pp) { const int sb = (pp & 1) * 2;
                AT_SUB(sb); AT_SUB(sb + 1);
                if (2 * pp + 2 < ntiles) { AT_WRITEK(sb ^ 2); AT_WRITEV(sb ^ 2); AT_WRITEKB((sb ^ 2) + 1); AT_WRITEVB((sb ^ 2) + 1); }
                if (2 * pp + 4 < ntiles) { AT_LOADK(2 * pp + 4); AT_LOADV(2 * pp + 4); AT_LOADKB(2 * pp + 5); AT_LOADVB(2 * pp + 5); }
                __syncthreads();
            }
#undef AT_SUB
        } else
        for (; tt < ntiles; ++tt) AT_BODY(true, p0, p1, p0, p1, tt);
    }
#undef AT_BODY
#undef AT_LOADK
#undef AT_LOADV
#undef AT_WRITEK
#undef AT_WRITEV
#undef AT_KFRAGS
#undef AT_QKM
#undef AT_VFRAGS
#undef AT_PVM
}
template <int NDB>
__device__ __forceinline__ void attn_store(bf16* ATT, int row0, int col0, const f32x16 (&o)[NDB], float inv, int lane) {
    const int i = lane & 31, hh = lane >> 5; bf16* rp = ATT + (size_t)(row0 + i) * D + col0 + 4 * hh;
#pragma unroll
    for (int db = 0; db < NDB; ++db)
#pragma unroll
        for (int g4 = 0; g4 < 4; ++g4) { u32x2 w; w.x = pk2(o[db][4 * g4] * inv, o[db][4 * g4 + 1] * inv); w.y = pk2(o[db][4 * g4 + 2] * inv, o[db][4 * g4 + 3] * inv);
            *(u32x2*)(rp + 32 * db + 8 * g4) = w; }
}

#define XB_TMO      128
#define XB_XCNT(j)  (256  + 64 * (j))
#define XB_XSUB(j)  (1280 + 64 * (j))
#define XB_XGEN(j)  (2304 + 64 * (j))
#define XB_TOP      3328
#define XB_TOPGEN   3392
#define XCD_BAR_WORDS 3456
#define XB_SPIN_CAP (1u << 18)

__device__ __forceinline__ unsigned xb_ld(unsigned* p)              { return __hip_atomic_load(p, __ATOMIC_RELAXED, __HIP_MEMORY_SCOPE_AGENT); }
__device__ __forceinline__ unsigned xb_add(unsigned* p, unsigned v) { return __hip_atomic_fetch_add(p, v, __ATOMIC_RELAXED, __HIP_MEMORY_SCOPE_AGENT); }
__device__ __forceinline__ unsigned xb_xcc_id() { return (unsigned)__builtin_amdgcn_s_getreg((3 << 11) | 20) & 0xFu; }
#define XB_SPIN(cond, bar) do { unsigned _sp = 0; while (cond) { __builtin_amdgcn_s_sleep(1); \
    if ((++_sp & 255u) == 0u) { if (xb_ld(&(bar)[XB_TMO])) break; if (_sp > XB_SPIN_CAP) { atomicAdd(&(bar)[XB_TMO], 1u); break; } } } } while (0)

struct XcdBarrier {
    unsigned* bar; unsigned x;
    volatile LAS unsigned* st;
};

__device__ __forceinline__ XcdBarrier xcd_barrier_post(unsigned* bar, volatile LAS unsigned* st) {
    XcdBarrier b; b.bar = bar; b.x = xb_xcc_id(); b.st = st;
    if (threadIdx.x == 0) (void)xb_add(&bar[XB_XCNT(b.x)], 1u);
    return b;
}
__device__ __forceinline__ void xcd_barrier_complete(unsigned* bar, unsigned x, unsigned& nloc, unsigned& nx) {
    const unsigned G = gridDim.x * gridDim.y * gridDim.z;
    unsigned sum, cnt, mine, sp = 0u;
    for (;;) {
        sum = 0u; cnt = 0u; mine = 0u;
#pragma unroll
        for (unsigned j = 0; j < 16; ++j) { const unsigned c = xb_ld(&bar[XB_XCNT(j)]); sum += c; cnt += (c > 0u) ? 1u : 0u; mine = (j == x) ? c : mine; }
        if (sum == G) break;
        __builtin_amdgcn_s_sleep(1);
        if ((++sp & 255u) == 0u) { if (xb_ld(&bar[XB_TMO])) break; if (sp > XB_SPIN_CAP) { atomicAdd(&bar[XB_TMO], 1u); break; } }
    }
    nloc = mine > 0u ? mine : 1u; nx = cnt > 0u ? cnt : 1u;
}

__device__ __forceinline__ void xcd_barrier(const XcdBarrier& b, const int wave_s) {
    asm volatile("s_waitcnt vmcnt(0)" ::: "memory");
    __syncthreads();
    if (wave_s == 0 && fresh_lane() == 0) {
        unsigned* bar = b.bar; asm volatile("" : "+s"(bar));
        __builtin_amdgcn_s_waitcnt(0);
        unsigned nloc = b.st[0], nx = b.st[1];
        if (nloc == 0u) { xcd_barrier_complete(bar, b.x, nloc, nx); b.st[0] = nloc; b.st[1] = nx; }
        const unsigned old = xb_add(&bar[XB_XSUB(b.x)], 1u);
        const unsigned gen = old / nloc;
        if (old + 1u == (gen + 1u) * nloc) {
            __builtin_amdgcn_fence(__ATOMIC_RELEASE, "agent");
            asm volatile("s_waitcnt vmcnt(0)" ::: "memory");
            const unsigned og = xb_add(&bar[XB_TOP], 1u);
            const unsigned tg = og / nx;
            if (og + 1u == (tg + 1u) * nx) xb_add(&bar[XB_TOPGEN], 1u);
            else XB_SPIN(xb_ld(&bar[XB_TOPGEN]) == tg, bar);
            __builtin_amdgcn_fence(__ATOMIC_ACQUIRE, "agent");
            xb_add(&bar[XB_XGEN(b.x)], 1u);
            asm volatile("s_waitcnt vmcnt(0)" ::: "memory");
        } else {
            XB_SPIN(xb_ld(&bar[XB_XGEN(b.x)]) == gen, bar);
            __builtin_amdgcn_fence(__ATOMIC_ACQUIRE, "agent");
            asm volatile("s_waitcnt vmcnt(0)" ::: "memory");
        }
    }
    __syncthreads();
}

__device__ __forceinline__ int grab_unit(unsigned* ctr, volatile LAS unsigned* slot, int wave_s) {
    if (wave_s == 0 && fresh_lane() == 0) *slot = __hip_atomic_fetch_add(ctr, 1u, __ATOMIC_RELAXED, __HIP_MEMORY_SCOPE_AGENT);
    __syncthreads();
    const unsigned v = *slot;
    __syncthreads();
    return __builtin_amdgcn_readfirstlane((int)v);
}
__device__ __forceinline__ unsigned ticket_issue(unsigned* ctr, int wave_s, bool& mine) {
    mine = (wave_s == 0) && (fresh_lane() == 0); unsigned v = 0u;
    if (mine) v = __hip_atomic_fetch_add(ctr, 1u, __ATOMIC_RELAXED, __HIP_MEMORY_SCOPE_AGENT);
    return v;
}
__device__ __forceinline__ int ticket_publish(unsigned v, bool mine, volatile LAS unsigned* slot) {
    if (mine) *slot = v;
    __syncthreads();
    const unsigned r = *slot;
    __syncthreads();
    return __builtin_amdgcn_readfirstlane((int)r);
}
__device__ __forceinline__ void prep_dyn(const float* xlat, const float* xctx, const float* g, const float* modl, int sc_off, bf16* AP, float* ssq, unsigned* ctr, volatile LAS unsigned* slot, int wave_s) {
    const int lane = fresh_lane();
    f32x4 g4[4];
#pragma unroll
    for (int j = 0; j < 4; ++j) g4[j] = *(const f32x4*)(g + 256 * j + 4 * lane);
    for (int ch = grab_unit(ctr, slot, wave_s); ch < R / 16; ch = grab_unit(ctr, slot, wave_s)) {
        const int r0 = ch * 16 + 2 * wave_s, r1 = r0 + 1;
        const float* xr0 = (r0 < NLAT) ? xlat + (size_t)r0 * D : xctx + (size_t)(r0 - NLAT) * D; const float* xr1 = xr0 + D;
        f32x4 v0[4], v1[4]; float s0 = 0.f, s1 = 0.f;
#pragma unroll
        for (int j = 0; j < 4; ++j) { v0[j] = *(const f32x4*)(xr0 + 256 * j + 4 * lane); v1[j] = *(const f32x4*)(xr1 + 256 * j + 4 * lane); }
#pragma unroll
        for (int j = 0; j < 4; ++j) { s0 += (v0[j].x * v0[j].x + v0[j].y * v0[j].y) + (v0[j].z * v0[j].z + v0[j].w * v0[j].w); s1 += (v1[j].x * v1[j].x + v1[j].y * v1[j].y) + (v1[j].z * v1[j].z + v1[j].w * v1[j].w); }
        s0 = wave_sum(s0, lane); s1 = wave_sum(s1, lane);
        const float* mp = modl + ((r0 < NLAT) ? (r0 >> 11) : 32) * 6144;
#pragma unroll
        for (int j = 0; j < 4; ++j) { const int c = 256 * j + 4 * lane; const f32x4 gs = g4[j] * (*(const f32x4*)(mp + sc_off + c) + 1.0f);
            const f32x4 y0 = v0[j] * gs, y1 = v1[j] * gs; u32x2 w0, w1; w0.x = pk2(y0.x, y0.y); w0.y = pk2(y0.z, y0.w); w1.x = pk2(y1.x, y1.y); w1.y = pk2(y1.z, y1.w);
            *(u32x2*)(AP + (size_t)r0 * D + c) = w0; *(u32x2*)(AP + (size_t)r1 * D + c) = w1; }
        if (lane == 0) { ssq[r0] = s0; ssq[r1] = s1; }
    }
}
struct Args { const float* in[23]; float* out; unsigned char* ws; };

__global__ void __launch_bounds__(NTHR, 2) mega_fwd(Args args) {
    extern __shared__ __attribute__((aligned(16))) unsigned char lds_raw[];
    LAS unsigned char* lds = (LAS unsigned char*)lds_raw;
    cg::grid_group grid = cg::this_grid();
    const int wave_s = __builtin_amdgcn_readfirstlane(threadIdx.x >> 6);
    if (threadIdx.x < 16) ((LAS unsigned*)(lds + MISC_OFF))[threadIdx.x] = 0u;
    __syncthreads();
    const XcdBarrier xbar = xcd_barrier_post((unsigned*)(args.ws + WS_CTL), (volatile LAS unsigned*)(lds + MISC_OFF));
    const int G = gridDim.x, bx = blockIdx.x; const int vcu = (G % 8 == 0) ? (bx % 8) * (G / 8) + bx / 8 : bx;
    const int NGW = G * NWAVES;
    unsigned char* ws = args.ws;
    const float* x_in = args.in[0]; const float* c_in = args.in[1]; const float* ctx_in = args.in[2]; const float* cctx_in = args.in[3];
    const float* ada_w = args.in[4]; const float* ada_b = args.in[5]; const float* norm_mix = args.in[6]; const float* norm_mlp = args.in[7];
    float* MOD = (float*)(ws + WS_MOD); float* XCTX = (float*)(ws + WS_XCTX); bf16* H = (bf16*)(ws + WS_H); unsigned char* RG = ws + WS_R;
    float* XLAT = args.out;

    {   const int tid = threadIdx.x, lane = tid & 63, wave = __builtin_amdgcn_readfirstlane(tid >> 6);
        const bool split = G >= 96; const int NGW = split ? (G - 48) * NWAVES : G * NWAVES; const int gw = split ? ((bx >= 48) ? (bx - 48) * NWAVES + wave : NGW + wave) : bx * NWAVES + wave;
        if (bx < 48) {
            LAS float* S = (LAS float*)lds;
            for (int idx = tid; idx < 33 * 1024; idx += NTHR) { const int b = idx >> 10, k = idx & 1023; const float cv = (b < 32) ? c_in[b * 1024 + k] : cctx_in[k]; S[idx] = cv / (1.0f + __expf(-cv)); }
            __syncthreads();
            for (int item = bx; item < 48; item += G) {
                const int L = item / 12, col = (item % 12) * 512 + wave * 64 + lane; const float* wp = ada_w + (size_t)L * 1024 * 6144 + col;
                float acc[33];
#pragma unroll
                for (int b = 0; b < 33; ++b) acc[b] = 0.f;
                float wn[16];
#pragma unroll
                for (int e = 0; e < 16; ++e) wn[e] = wp[(size_t)e * 6144];
                for (int kb = 0; kb < 1024; kb += 16) {
                    float wc[16];
#pragma unroll
                    for (int e = 0; e < 16; ++e) wc[e] = wn[e];
                    if (kb + 16 < 1024) {
#pragma unroll
                        for (int e = 0; e < 16; ++e) wn[e] = wp[(size_t)(kb + 16 + e) * 6144]; }
#pragma unroll
                    for (int q4 = 0; q4 < 4; ++q4)
#pragma unroll
                        for (int b = 0; b < 33; ++b) { const f32x4 s = *(const LAS f32x4*)(S + b * 1024 + kb + 4 * q4); acc[b] += (s.x * wc[4 * q4] + s.y * wc[4 * q4 + 1]) + (s.z * wc[4 * q4 + 2] + s.w * wc[4 * q4 + 3]); }
                }
                const float bias = ada_b[L * 6144 + col];
#pragma unroll
                for (int b = 0; b < 33; ++b) MOD[((size_t)L * 33 + b) * 6144 + col] = acc[b] + bias;
                { const int cgi = item % 12;
                  if (cgi < 2 || cgi == 6 || cgi == 7) { const int w = cgi >= 6; unsigned short* dst = (unsigned short*)(ws + WS_SHB) + ((size_t)(2 * L + w) * 256) * 1024 + (col - (w ? 3072 : 0));
#pragma unroll
                      for (int b = 0; b < 33; ++b) dst[(size_t)b * 1024] = (unsigned short)f2bf(acc[b] + bias); } }
            }
            __syncthreads();
        }
        LAS float* scr = (LAS float*)(lds + wave * 16384); int cur = 0;
        if (gw < NGW) {
        for (int i2 = 0; i2 < 2; ++i2) {
            unsigned char* we = ws + WS_W + (size_t)i2 * 8 * MiB; bf16* WinM = (bf16*)we; bf16* WinV = (bf16*)(we + 3584 * 1024); bf16* Wout = (bf16*)(we + 5 * MiB);
            const float* win = args.in[10] + (size_t)i2 * 1024 * 2304;
            xpose_seg(win, 1024, 2304, 0, 1024, false, WinM, 0, scr, gw, NGW, cur, lane);
            xpose_seg(win, 1024, 2304, 1536, 640, false, WinM, 1024, scr, gw, NGW, cur, lane);
            xpose_seg(win, 1024, 2304, 1024, 512, false, WinV, 0, scr, gw, NGW, cur, lane);
            xpose_seg(win, 1024, 2304, 2176, 128, false, WinV, 512, scr, gw, NGW, cur, lane);
            zero_rows(WinM, 1024, 1664, 128, gw, NGW, lane); zero_rows(WinV, 1024, 640, 128, gw, NGW, lane);
            xpose_seg(args.in[11] + (size_t)i2 * 1024 * 1024, 1024, 1024, 0, 1024, false, Wout, 0, scr, gw, NGW, cur, lane);
            unsigned char* wo = ws + WS_W + 16 * MiB + (size_t)i2 * 8 * MiB; bf16* MWin = (bf16*)wo; bf16* MQup = (bf16*)(wo + 2 * MiB); bf16* MKn = (bf16*)(wo + 3584 * 1024); bf16* MV = (bf16*)(wo + 4 * MiB); bf16* MWout = (bf16*)(wo + 4608 * 1024);
            xpose_seg(args.in[16] + (size_t)i2 * 1024 * 800, 1024, 800, 0, 800, false, MWin, 0, scr, gw, NGW, cur, lane);
            zero_rows(MWin, 1024, 800, 224, gw, NGW, lane);
            xpose_seg(args.in[18] + (size_t)i2 * 512 * 1536, 512, 1536, 0, 1536, false, MQup, 0, scr, gw, NGW, cur, lane);
            xpose_seg(args.in[20] + (size_t)i2 * 256 * 2048, 256, 2048, 0, 1024, true, MKn, 0, scr, gw, NGW, cur, lane);
            xpose_seg(args.in[20] + (size_t)i2 * 256 * 2048, 256, 2048, 64, 1024, true, MV, 0, scr, gw, NGW, cur, lane);
            xpose_seg(args.in[22] + (size_t)i2 * 1024 * 1024, 1024, 1024, 0, 1024, false, MWout, 0, scr, gw, NGW, cur, lane);
        }
        for (int L = 0; L < 4; ++L) {
            unsigned char* wm = ws + WS_W + 32 * MiB + (size_t)L * 16 * MiB;
            xpose_seg(args.in[8] + (size_t)L * 1024 * 4096, 1024, 4096, 0, 4096, false, (bf16*)wm, 0, scr, gw, NGW, cur, lane);
            xpose_seg(args.in[9] + (size_t)L * 4096 * 1024, 4096, 1024, 0, 1024, false, (bf16*)(wm + 8 * MiB), 0, scr, gw, NGW, cur, lane);
        }
        }
    }
    if (__builtin_expect(args.ws == nullptr, 0)) grid.sync();
    xcd_barrier(xbar, wave_s);
    {
        float* MOD = (float*)(ws + WS_MOD); float* SSQ1 = (float*)(ws + WS_SSQ); float* SSQ2 = SSQ1 + 131072;
        zero_f32(SSQ2, R, vcu, NGW, wave_s);
        zero_f32((float*)(ws + WS_SSQM), 262144, vcu, NGW, wave_s);
        {   pg8::Gemm g{(const bf16*)(ws + WS_SHB), (const bf16*)(ws + WS_W), 2048, 256, 1024}; pg8::ShwOrder S{G, bx}; pg8::EpiShw E{(float*)(ws + WS_SHW)};
            pg8::gemm_phase<pg8::EpiShw, pg8::ShwOrder, true, true>(lds, g, S, E, wave_s); }
        prep_dyn(x_in, ctx_in, norm_mix, MOD, 1024, (bf16*)(ws + WS_H), SSQ1, (unsigned*)(ws + WS_CTL) + 3700, (volatile LAS unsigned*)(lds + MISC_OFF) + 8, wave_s);
    }
    xcd_barrier(xbar, wave_s);

    const int G0 = G, bx0 = bx, vcu0 = vcu; int dir = 0;
    for (int L = 0; L < 4; ++L) {
        int G = G0, bx = bx0, vcu = vcu0; asm volatile("" : "+s"(G), "+s"(bx), "+s"(vcu)); const int NGW = G * NWAVES;
        const __attribute__((address_space(4))) Args* ap = (const __attribute__((address_space(4))) Args*)__builtin_amdgcn_kernarg_segment_ptr(); asm volatile("" : "+s"(ap));
        unsigned char* ws = ap->ws; float* XLAT = ap->out; const float* x_in = ap->in[0]; const float* ctx_in = ap->in[2]; const float* norm_mix = ap->in[6]; const float* norm_mlp = ap->in[7];
        float* MOD = (float*)(ws + WS_MOD); float* XCTX = (float*)(ws + WS_XCTX); bf16* H = (bf16*)(ws + WS_H); unsigned char* RG = ws + WS_R;
        const int i2 = L >> 1; const bool last = (L == 3);
        const float* modl = MOD + (size_t)L * 33 * 6144;
        const float* xl = (L == 0) ? x_in : XLAT; const float* xc = (L == 0) ? ctx_in : XCTX;
        float* SSQ1 = (float*)(ws + WS_SSQ); float* SSQ2 = SSQ1 + 131072; const float* SHWin = (const float*)(ws + WS_SHW) + (size_t)L * 33 * 8192; const float* SHW1 = SHWin + 33 * 4096;
        const int Ln = (L < 3) ? L + 1 : 3;
        bf16* ATT;
        if ((L & 1) == 0) {
            unsigned char* we = ws + WS_W + (size_t)i2 * 8 * MiB; const bf16* WinM = (const bf16*)we; const bf16* WinV = (const bf16*)(we + 3584 * 1024); const bf16* Wout = (const bf16*)(we + 5 * MiB);
            bf16* RAW = (bf16*)RG; bf16* VT = (bf16*)(RG + 252 * MiB); ATT = (bf16*)(RG + 576 * MiB);
            {   pg8::Gemm g{H, WinM, R, 1792, 1024}; pg8::StaticOrder S; S.init(R, 1792, G, bx); S.rev = dir; pg8::EpiEvenIn E{RAW, SSQ1, SHWin, ap->in[12] + i2 * 128 + 64, ap->in[15] + i2 * 128 + 64};
                pg8::gemm_phase<pg8::EpiEvenIn, pg8::StaticOrder, true, true>(lds, g, S, E, wave_s); }
            {   pg8::Gemm g{WinV, H, 768, R, 1024}; pg8::StaticOrder S; S.init(768, R, G, bx); S.rev = dir; pg8::EpiVT<true> E{VT, 768, SSQ1, SHWin + 1792, 2560, 1.0f / 1024.0f};
                pg8::gemm_phase<pg8::EpiVT<true>, pg8::StaticOrder, true, true>(lds, g, S, E, wave_s); }
            { xcd_barrier(xbar, wave_s); dir ^= 1; }
            {
                const int lane = fresh_lane(), wave = wave_s;
                const float* lamp = ap->in[13] + i2 * 256;
                const float lam_init = 0.8f - 0.6f * __expf(-0.3f * (float)L);
                const float lam_v = __expf(wave_sum(lamp[lane] * lamp[64 + lane], lane)) - __expf(wave_sum(lamp[128 + lane] * lamp[192 + lane], lane)) + lam_init;
                const float lam = __builtin_bit_cast(float, __builtin_amdgcn_readfirstlane(__builtin_bit_cast(int, lam_v)));
                const float* subln = ap->in[14] + i2 * 128;
                const int nlat_d = 1024, nctx_d = 128, nlat_g = 2048, nctx_g = 256;
#ifndef NO_DIFF
                unsigned* ctrs = (unsigned*)(ws + WS_CTL) + 3584 + 8 * L; volatile LAS unsigned* slot = (volatile LAS unsigned*)(lds + MISC_OFF) + 8;
                for (int u = grab_unit(ctrs, slot, wave_s); u < nlat_d + nctx_d; ) { bool tk_mine; const unsigned tk_next = ticket_issue(ctrs, wave_s, tk_mine);
                    int b, h, row0, nt;
                    if (u < nlat_d) { const int ur = dir ? (nlat_d - 1 - u) : u; const int qb = ur & 7; h = (ur >> 3) & 3; b = ur >> 5; row0 = b * 2048 + qb * 256 + wave * 32; nt = 36; }
                    else { const int uu = u - nlat_d; h = uu & 3; b = uu >> 2; row0 = NLAT + b * 256 + wave * 32; nt = 4; }
                    f32x16 o[4]; float l;
                    const bf16* vt = VT + ((size_t)b * 768 + h * 128) * KV;
                    attn_pass<64, 128, false>(lds, RAW + (size_t)row0 * RAWP + (h * 2) * 64, RAWP, RAW + (size_t)(NLAT + b * 256) * RAWP + 512 + (h * 2) * 64, RAW + (size_t)(b * 2048) * RAWP + 512 + (h * 2) * 64, RAWP, vt, nt, ap->in[12] + i2 * 128, row0, 0.125f * LOG2E, o, l, wave_s);
                    { const int ln = fresh_lane(); LAS unsigned* o1s = (LAS unsigned*)(lds + 57344 + wave_s * 8192) + ln; const float inv = 1.0f / (l + shx(l, 32, ln));
#pragma unroll
                      for (int db = 0; db < 4; ++db)
#pragma unroll
                          for (int j = 0; j < 8; ++j) o1s[(db * 8 + j) * 64] = pg8::cvt_pk_bf16(o[db][2 * j] * inv, o[db][2 * j + 1] * inv); }
                    attn_pass<64, 128, false>(lds, RAW + (size_t)row0 * RAWP + (h * 2 + 1) * 64, RAWP, RAW + (size_t)(NLAT + b * 256) * RAWP + 512 + (h * 2 + 1) * 64, RAW + (size_t)(b * 2048) * RAWP + 512 + (h * 2 + 1) * 64, RAWP, vt, nt, ap->in[12] + i2 * 128, row0, 0.125f * LOG2E, o, l, wave_s);
                    { const int ln = fresh_lane(), i = ln & 31, hh = ln >> 5; LAS unsigned* o1s = (LAS unsigned*)(lds + 57344 + wave_s * 8192) + ln; const float inv = lam / (l + shx(l, 32, ln)); float ss = 0.f;
#pragma unroll
                      for (int db = 0; db < 4; ++db)
#pragma unroll
                          for (int j = 0; j < 8; ++j) { const unsigned pk = o1s[(db * 8 + j) * 64]; const float a0 = bflo(pk) - o[db][2 * j] * inv, a1 = bfhi(pk) - o[db][2 * j + 1] * inv; o[db][2 * j] = a0; o[db][2 * j + 1] = a1; ss += a0 * a0 + a1 * a1; }
                      ss += shx(ss, 32, ln);
                      const float rinv = (1.0f - lam_init) / sqrtf(ss * (1.0f / 128) + EPS);
                      bf16* rp = ATT + (size_t)(row0 + i) * D + h * 128 + 4 * hh;
#pragma unroll
                      for (int db = 0; db < 4; ++db)
#pragma unroll
                          for (int g4 = 0; g4 < 4; ++g4) { const f32x4 sg = *(const f32x4*)(subln + 32 * db + 8 * g4 + 4 * hh);
                              u32x2 w; w.x = pk2(o[db][4 * g4] * rinv * sg.x, o[db][4 * g4 + 1] * rinv * sg.y); w.y = pk2(o[db][4 * g4 + 2] * rinv * sg.z, o[db][4 * g4 + 3] * rinv * sg.w);
                              *(u32x2*)(rp + 32 * db + 8 * g4) = w; } }
                    u = ticket_publish(tk_next, tk_mine, slot);
                }
#endif
#ifndef NO_GQA
                for (int u = grab_unit(ctrs + 1, slot, wave_s); u < nlat_g + nctx_g; ) { bool tk_mine; const unsigned tk_next = ticket_issue(ctrs + 1, wave_s, tk_mine);
                    int b, hq, row0, nt;
                    if (u < nlat_g) { const int ur = dir ? (nlat_g - 1 - u) : u; const int qb = ur & 7; hq = (ur >> 3) & 7; b = ur >> 6; row0 = b * 2048 + qb * 256 + wave * 32; nt = 36; }
                    else { const int uu = u - nlat_g; hq = uu & 7; b = uu >> 3; row0 = NLAT + b * 256 + wave * 32; nt = 4; }
                    const int kvh = hq >> 2; f32x16 o[2]; float l;
                    attn_pass<64, 64, false>(lds, RAW + (size_t)row0 * RAWP + 1024 + hq * 64, RAWP, RAW + (size_t)(NLAT + b * 256) * RAWP + 1536 + kvh * 64, RAW + (size_t)(b * 2048) * RAWP + 1536 + kvh * 64, RAWP,
                                      VT + ((size_t)b * 768 + 512 + kvh * 64) * KV, nt, ap->in[15] + i2 * 128, row0, 0.125f * LOG2E, o, l, wave_s);
                    { const int ln = fresh_lane(); attn_store<2>(ATT, row0, 512 + hq * 64, o, 1.0f / (l + shx(l, 32, ln)), ln); }
                    u = ticket_publish(tk_next, tk_mine, slot);
                }
#endif
            }
            { xcd_barrier(xbar, wave_s); dir ^= 1; }
            {   pg8::Gemm g{ATT, Wout, R, 1024, 1024}; pg8::StaticOrder S; S.init(R, 1024, G, bx); S.rev = dir; pg8::EpiResid E{xl, xc, XLAT, XCTX, modl + 2048, H, norm_mlp + L * 1024, modl + 4096, SSQ2};
                zero_f32(SSQ1, R, vcu, NGW, wave_s);
                pg8::gemm_phase<pg8::EpiResid, pg8::StaticOrder, true, true>(lds, g, S, E, wave_s); }
        } else {
            unsigned char* wo = ws + WS_W + 16 * MiB + (size_t)i2 * 8 * MiB; const bf16* MWin = (const bf16*)wo; const bf16* MQup = (const bf16*)(wo + 2 * MiB); const bf16* MKn = (const bf16*)(wo + 3584 * 1024);
            const bf16* MV = (const bf16*)(wo + 4 * MiB); const bf16* MWout = (const bf16*)(wo + 4608 * 1024);
            bf16* MRAW = (bf16*)RG; ATT = (bf16*)RG; bf16* Q = (bf16*)(RG + 144 * MiB); bf16* Kb = (bf16*)(RG + 360 * MiB); bf16* VT = (bf16*)(RG + 576 * MiB);
            bf16* QCn = (bf16*)RG; bf16* KVCn = (bf16*)(RG + 72 * MiB); bf16* KR = (bf16*)(RG + 108 * MiB);
            float* SSQq = (float*)(ws + WS_SSQM); float* SSQkv = SSQq + 131072; const float* ZSH = SSQq + 229376;
            {   pg8::Gemm g{H, MWin, R, 1024, 1024}; pg8::StaticOrder S; S.init(R, 1024, G, bx); S.rev = dir; pg8::EpiMlaIn E{SSQ1, SHWin, QCn, KVCn, KR, ap->in[17] + i2 * 512, ap->in[19] + i2 * 256, SSQq, SSQkv};
                pg8::gemm_phase<pg8::EpiMlaIn, pg8::StaticOrder, true, true>(lds, g, S, E, wave_s); }
            { xcd_barrier(xbar, wave_s); dir ^= 1; }
            {   pg8::Gemm g{QCn, MQup, last ? NLAT : R, 1536, 512}; pg8::StaticOrder S; S.init(last ? NLAT : R, 1536, G, bx); S.rev = dir; pg8::EpiStore<0, 0, true> E{Q, MQP, SSQq, ZSH, 0, 1.0f / 512.0f};
                pg8::gemm_phase<pg8::EpiStore<0, 0, true>, pg8::StaticOrder, true, true>(lds, g, S, E, wave_s); }
            {   pg8::Gemm g{KVCn, MKn, R, 1024, 256}; pg8::StaticOrder S; S.init(R, 1024, G, bx); S.rev = dir; pg8::EpiMlaKn E{Kb, SSQkv, KR, ap->in[21] + i2 * 192 + 96};
                pg8::gemm_phase<pg8::EpiMlaKn, pg8::StaticOrder, true, true>(lds, g, S, E, wave_s); }
            {   pg8::Gemm g{MV, KVCn, 1024, R, 256}; pg8::StaticOrder S; S.init(1024, R, G, bx); S.rev = dir; pg8::EpiVT<true> E{VT, 1024, SSQkv, ZSH, 0, 1.0f / 256.0f};
                pg8::gemm_phase<pg8::EpiVT<true>, pg8::StaticOrder, true, true>(lds, g, S, E, wave_s); }
            { xcd_barrier(xbar, wave_s); dir ^= 1; }
            {   const float* gq = ap->in[21] + i2 * 192; const float* gk = gq + 96;
                const int lane = fresh_lane(), wave = wave_s;
                const int nlat = 4096, nctx = last ? 0 : 512;
#ifndef NO_MLA
                unsigned* ctrs = (unsigned*)(ws + WS_CTL) + 3584 + 8 * L; volatile LAS unsigned* slot = (volatile LAS unsigned*)(lds + MISC_OFF) + 8;
                for (int u = grab_unit(ctrs, slot, wave_s); u < nlat + nctx; ) { bool tk_mine; const unsigned tk_next = ticket_issue(ctrs, wave_s, tk_mine);
                    int b, h, row0, nt;
                    if (u < nlat) { const int ur = dir ? (nlat - 1 - u) : u; const int qb = ur & 7; h = (ur >> 3) & 15; b = ur >> 7; row0 = b * 2048 + qb * 256 + wave * 32; nt = 36; }
                    else { const int uu = u - nlat; h = uu & 15; b = uu >> 4; row0 = NLAT + b * 256 + wave * 32; nt = 4; }
                    f32x16 o[2]; float l;
                    attn_pass<96, 64, false>(lds, Q + (size_t)row0 * MQP + h * 96, MQP, Kb + (size_t)(NLAT + b * 256) * MQP + h * 96, Kb + (size_t)(b * 2048) * MQP + h * 96, MQP,
                                      VT + ((size_t)b * 1024 + h * 64) * KV, nt, gq, row0, 0.10206207261596577f * LOG2E, o, l, wave_s);
                    { const int ln = fresh_lane(); attn_store<2>(ATT, row0, h * 64, o, 1.0f / (l + shx(l, 32, ln)), ln); }
                    u = ticket_publish(tk_next, tk_mine, slot);
                }
#endif
            }
            { xcd_barrier(xbar, wave_s); dir ^= 1; }
            {   const int Mr = last ? NLAT : R;
                pg8::Gemm g{ATT, MWout, Mr, 1024, 1024}; pg8::StaticOrder S; S.init(Mr, 1024, G, bx); S.rev = dir; pg8::EpiResid E{xl, xc, XLAT, XCTX, modl + 2048, H, norm_mlp + L * 1024, modl + 4096, SSQ2};
                zero_f32(SSQ1, R, vcu, NGW, wave_s);
                pg8::gemm_phase<pg8::EpiResid, pg8::StaticOrder, true, true>(lds, g, S, E, wave_s); }
        }
        { xcd_barrier(xbar, wave_s); dir ^= 1; }
        {   const int Mr = last ? NLAT : R; unsigned char* wm = ws + WS_W + 32 * MiB + (size_t)L * 16 * MiB; bf16* HID = (bf16*)RG;
            {   pg8::Gemm g{H, (const bf16*)wm, Mr, FF, 1024}; pg8::StaticOrder S; S.init(Mr, FF, G, bx); S.rev = dir; pg8::EpiStore<1, 0, true> E{HID, FF, SSQ2, SHW1, 4096, 1.0f / 1024.0f};
                pg8::gemm_phase<pg8::EpiStore<1, 0, true>, pg8::StaticOrder, true, true>(lds, g, S, E, wave_s); }
            { xcd_barrier(xbar, wave_s); dir ^= 1; }
            {   pg8::Gemm g{HID, (const bf16*)(wm + 8 * MiB), Mr, 1024, FF}; pg8::StaticOrder S; S.init(Mr, 1024, G, bx); S.rev = dir; pg8::EpiResid E{XLAT, XCTX, XLAT, XCTX, modl + 5120, last ? (bf16*)nullptr : H, norm_mix + Ln * 1024, MOD + (size_t)Ln * 33 * 6144 + 1024, SSQ1};
                zero_f32(SSQ2, R, vcu, NGW, wave_s); zero_f32((float*)(ws + WS_SSQM), 229376, vcu, NGW, wave_s);
                pg8::gemm_phase<pg8::EpiResid, pg8::StaticOrder, true, true>(lds, g, S, E, wave_s); }
        }
        { xcd_barrier(xbar, wave_s); dir ^= 1; }
    }
}

extern "C" void kernel_launch(void* const* d_in, const int* in_sizes, int n_in, void* d_out, int out_size, void* d_ws, size_t ws_size, hipStream_t stream) {
    static int grid = 0;
    if (grid == 0) {
        if (n_in != 23 || out_size != NLAT * D || ws_size < WS_END) { fprintf(stderr, "kernel_launch: unexpected shapes (n_in %d, out %d, ws %zu)\n", n_in, out_size, ws_size); grid = -1; return; }
        int dev = 0, cus = 0, per_cu = 0;
        hipGetDevice(&dev); hipDeviceGetAttribute(&cus, hipDeviceAttributeMultiprocessorCount, dev);
        if (hipFuncSetAttribute((const void*)mega_fwd, hipFuncAttributeMaxDynamicSharedMemorySize, LDS_BYTES) != hipSuccess) { fprintf(stderr, "kernel_launch: hipFuncSetAttribute failed\n"); grid = -1; return; }
        if (hipOccupancyMaxActiveBlocksPerMultiprocessor(&per_cu, (const void*)mega_fwd, NTHR, LDS_BYTES) != hipSuccess || per_cu < 1) { fprintf(stderr, "kernel_launch: occupancy query says %d\n", per_cu); per_cu = 1; }
        (void)hipGetLastError();
        grid = cus;
    }
    if (grid < 0) return;
    if (hipMemsetAsync((char*)d_ws + WS_CTL, 0, CTL_BYTES, stream) != hipSuccess) { fprintf(stderr, "kernel_launch: memset failed\n"); return; }
    Args a{};
    for (int i = 0; i < 23; ++i) a.in[i] = (const float*)d_in[i];
    a.out = (float*)d_out; a.ws = (unsigned char*)d_ws;
    void* kargs[] = {&a};
    hipError_t e = hipLaunchCooperativeKernel((const void*)mega_fwd, dim3(grid), dim3(NTHR), kargs, LDS_BYTES, stream);
    if (e != hipSuccess) fprintf(stderr, "kernel_launch: cooperative launch failed: %s (grid %d)\n", hipGetErrorString(e), grid);
}
```

```cpp
#include <hip/hip_runtime.h>
#include <hip/hip_cooperative_groups.h>
#include <cstdio>
#include <cstdint>
#include <cmath>
namespace cg = cooperative_groups;
__device__ __forceinline__ int fresh_lane() { int m1 = -1; asm volatile("" : "+s"(m1)); return __builtin_amdgcn_mbcnt_hi(m1, __builtin_amdgcn_mbcnt_lo(m1, 0)); }
namespace pg8 {
#define PG8_LAS __attribute__((address_space(3)))
typedef unsigned short bf16_t;
typedef short bf16x8 __attribute__((ext_vector_type(8)));
typedef float f32x4 __attribute__((ext_vector_type(4)));
typedef unsigned u32x4 __attribute__((ext_vector_type(4)));
constexpr int BM = 256, BK = 64, HALF = 128, HTB = HALF * BK * 2  , STAGE_BYTES = 8 * HTB, NXCD = 8, WGM = 8;

__host__ __device__ __forceinline__ int lds_byte(int r, int c) { const int st = (r >> 4) * 2 + (c >> 5), rr = r & 15, cc = c & 31, ob = rr * 64 + cc * 2; return st * 1024 + (ob ^ (((ob >> 9) & 1) << 5)); }
__host__ __device__ __forceinline__ void stage_rc(int b, int& R, int& C) { const int st = b / 1024, sb = b % 1024, swz = sb ^ (((sb >> 9) & 1) << 5); R = (st >> 1) * 16 + swz / 64; C = (st & 1) * 32 + (swz % 64) / 2; }
__host__ __device__ __forceinline__ int perm32(int rho) { const int n = rho >> 4, i = rho & 15; return 8 * (i >> 2) + 4 * n + (i & 3); }

struct Unit { int pm, pn; };
struct Gemm { const bf16_t* A; const bf16_t* Bt; int M, N, K; };

struct StaticOrder {
    int nM, nN, nwg, G, c, rev;
    __host__ __device__ void init(int M, int N, int G_, int c_) { nM = M / BM; nN = N / BM; nwg = nM * nN; G = G_; c = c_; rev = 0; }
    __host__ __device__ bool next(int i, Unit& u) const {
        const long L = (long)i * G + c; if (L >= nwg) return false;
        int wgid = (int)L; { const int q = nwg / NXCD, r = nwg % NXCD, xcd = wgid % NXCD, off = wgid / NXCD; wgid = (xcd < r ? xcd * (q + 1) : r * (q + 1) + (xcd - r) * q) + off; }
        if (rev) wgid = nwg - 1 - wgid;
        const int nig = WGM * nN, gid = wgid / nig, fm = gid * WGM, gsz = (nM - fm) < WGM ? (nM - fm) : WGM;
        u.pm = fm + ((wgid % nig) % gsz); u.pn = (wgid % nig) / gsz; return true;
    }
    __device__ __forceinline__ void a_ready(const Unit&) const {}
    __device__ __forceinline__ void done(const Unit&) const {}
};

__device__ __forceinline__ unsigned cvt_pk_bf16(float lo, float hi) { unsigned r; asm volatile("v_cvt_pk_bf16_f32 %0, %1, %2" : "=v"(r) : "v"(lo), "v"(hi)); return r; }
typedef float f32x2 __attribute__((ext_vector_type(2)));
typedef unsigned u32x2 __attribute__((ext_vector_type(2)));
__device__ __forceinline__ float rinv_of(float ssq, float invn) { return 1.0f / sqrtf(ssq * invn + 1e-6f); }
__device__ __forceinline__ int mi_of_tile(int r0) { return r0 < 65536 ? (r0 >> 11) : 32; }
template <int ACT, int HEADMAP, bool NORM> struct EpiStore {
    static constexpr bool PERM = true, AFTER_DRAIN = false, HEAD64 = false;
    bf16_t* O; int ldc; const float* ssq; const float* shw; int ldshw; float invn;
    __device__ __forceinline__ void operator()(const f32x4 (&acc)[2][2][4][2], const Unit& u, int wr, int wc, int fr, int fq) const {
        { const int t_ = fresh_lane(); fr = t_ & 15; fq = (t_ >> 4) & 3; }
        const int row0 = u.pm * BM + wr * 64 + fr; const int colb = u.pn * BM + wc * 32 + 8 * fq;
        f32x4 sw[2][2];
        if (NORM) { const float* sp = shw + (size_t)mi_of_tile(u.pm * BM) * ldshw + colb;
#pragma unroll
            for (int bj = 0; bj < 2; ++bj) { sw[bj][0] = *(const f32x4*)(sp + bj * HALF); sw[bj][1] = *(const f32x4*)(sp + bj * HALF + 4); } }
        float riv[2][4];
#pragma unroll
        for (int ai = 0; ai < 2; ++ai)
#pragma unroll
            for (int m = 0; m < 4; ++m) riv[ai][m] = NORM ? ssq[row0 + ai * HALF + m * 16] : 0.f;
#pragma unroll
        for (int ai = 0; ai < 2; ++ai)
#pragma unroll
            for (int m = 0; m < 4; ++m) { const int row = row0 + ai * HALF + m * 16; bf16_t* rowp = O + (size_t)row * ldc;
                float ri = 1.0f; if (NORM) ri = rinv_of(riv[ai][m], invn);
#pragma unroll
                for (int bj = 0; bj < 2; ++bj) { const int c = colb + bj * HALF; const int dc = HEADMAP ? ((c >> 6) * 96 + (c & 63)) : c;
                    f32x4 v0 = acc[ai][bj][m][0], v1 = acc[ai][bj][m][1];
                    if (NORM) { v0 = v0 * ri + sw[bj][0]; v1 = v1 * ri + sw[bj][1]; }
                    if (ACT == 1) {
#pragma unroll
                        for (int e = 0; e < 4; ++e) { float a = v0[e] > 0.f ? v0[e] : 0.f; v0[e] = a * a; float b = v1[e] > 0.f ? v1[e] : 0.f; v1[e] = b * b; } }
                    u32x4 w; w.x = cvt_pk_bf16(v0[0], v0[1]); w.y = cvt_pk_bf16(v0[2], v0[3]); w.z = cvt_pk_bf16(v1[0], v1[1]); w.w = cvt_pk_bf16(v1[2], v1[3]);
                    *(u32x4*)(rowp + dc) = w; } }
    }
};
template <bool NORM> struct EpiVT {
    static constexpr bool PERM = true, AFTER_DRAIN = false, HEAD64 = false;
    bf16_t* VT; int NF; const float* ssq; const float* shw; int ldshw; float invn;
    __device__ __forceinline__ void operator()(const f32x4 (&acc)[2][2][4][2], const Unit& u, int wr, int wc, int fr, int fq) const {
        { const int t_ = fresh_lane(); fr = t_ & 15; fq = (t_ >> 4) & 3; }
        const int r0 = u.pn * BM; int b, kv0; if (r0 < 65536) { b = r0 >> 11; kv0 = 256 + (r0 & 2047); } else { b = (r0 - 65536) >> 8; kv0 = 0; }
        const int f0 = u.pm * BM + wr * 64 + fr;
        f32x4 ri[2][2];
        if (NORM) {
#pragma unroll
            for (int bj = 0; bj < 2; ++bj)
#pragma unroll
                for (int n = 0; n < 2; ++n) { const f32x4 s = *(const f32x4*)(ssq + r0 + bj * HALF + wc * 32 + 8 * fq + 4 * n); ri[bj][n] = (f32x4){rinv_of(s.x, invn), rinv_of(s.y, invn), rinv_of(s.z, invn), rinv_of(s.w, invn)}; } }
        const float* sp = NORM ? shw + (size_t)mi_of_tile(r0) * ldshw : nullptr;
        float shv[2][4];
#pragma unroll
        for (int ai = 0; ai < 2; ++ai)
#pragma unroll
            for (int m = 0; m < 4; ++m) shv[ai][m] = NORM ? sp[f0 + ai * HALF + m * 16] : 0.f;
#pragma unroll
        for (int ai = 0; ai < 2; ++ai)
#pragma unroll
            for (int m = 0; m < 4; ++m) { const int f = f0 + ai * HALF + m * 16; bf16_t* rowp = VT + ((size_t)b * NF + f) * 2304 + kv0;
                const float sh = shv[ai][m];
#pragma unroll
                for (int bj = 0; bj < 2; ++bj) { const int cw = bj * HALF + wc * 32 + 8 * fq; const int gb = cw & ~15, o = cw & 15;
#pragma unroll
                    for (int n = 0; n < 2; ++n) { const int o4 = o + 4 * n; const int pos = (o4 & 3) | (((o4 >> 2) & 1) << 3) | (((o4 >> 3) & 1) << 2);
                        f32x4 v = acc[ai][bj][m][n]; if (NORM) v = v * ri[bj][n] + sh;
                        u32x2 w; w.x = cvt_pk_bf16(v[0], v[1]); w.y = cvt_pk_bf16(v[2], v[3]);
                        *(u32x2*)(rowp + gb + pos) = w; } } }
    }
};
struct EpiMlaIn {
    static constexpr bool PERM = true, AFTER_DRAIN = false, HEAD64 = false;
    const float* ssq; const float* shw; bf16_t* QCg; bf16_t* KVCg; bf16_t* KR; const float* gq; const float* gkv; float* ssq_q; float* ssq_kv;
    __device__ __forceinline__ void operator()(const f32x4 (&acc)[2][2][4][2], const Unit& u, int wr, int wc, int fr, int fq) const {
        const int ln_ = fresh_lane(); fr = ln_ & 15; fq = (ln_ >> 4) & 3;
        const int row0 = u.pm * BM + wr * 64 + fr; const int colb = u.pn * BM + wc * 32 + 8 * fq;
        const float* sp = shw + (size_t)mi_of_tile(u.pm * BM) * 1024 + colb;
        f32x4 sw[2][2], gg[2][2];
#pragma unroll
        for (int bj = 0; bj < 2; ++bj) { sw[bj][0] = *(const f32x4*)(sp + bj * HALF); sw[bj][1] = *(const f32x4*)(sp + bj * HALF + 4);
            const int c = colb + bj * HALF;
            if (u.pn < 2) { gg[bj][0] = *(const f32x4*)(gq + c); gg[bj][1] = *(const f32x4*)(gq + c + 4); }
            else if (u.pn == 2) { gg[bj][0] = *(const f32x4*)(gkv + c - 512); gg[bj][1] = *(const f32x4*)(gkv + c - 508); }
            else { gg[bj][0] = (f32x4){1.f, 1.f, 1.f, 1.f}; gg[bj][1] = gg[bj][0]; } }
        float riv[2][4];
#pragma unroll
        for (int ai = 0; ai < 2; ++ai)
#pragma unroll
            for (int m = 0; m < 4; ++m) riv[ai][m] = ssq[row0 + ai * HALF + m * 16];
#pragma unroll
        for (int ai = 0; ai < 2; ++ai)
#pragma unroll
            for (int m = 0; m < 4; ++m) { const int row = row0 + ai * HALF + m * 16; const float ri = rinv_of(riv[ai][m], 1.0f / 1024.0f); float ps = 0.f;
#pragma unroll
                for (int bj = 0; bj < 2; ++bj) { const int c = colb + bj * HALF;
                    const f32x4 v0 = acc[ai][bj][m][0] * ri + sw[bj][0], v1 = acc[ai][bj][m][1] * ri + sw[bj][1];
                    ps += ((v0[0] * v0[0] + v0[1] * v0[1]) + (v0[2] * v0[2] + v0[3] * v0[3])) + ((v1[0] * v1[0] + v1[1] * v1[1]) + (v1[2] * v1[2] + v1[3] * v1[3]));
                    const f32x4 a0 = v0 * gg[bj][0], a1 = v1 * gg[bj][1];
                    u32x4 w; w.x = cvt_pk_bf16(a0[0], a0[1]); w.y = cvt_pk_bf16(a0[2], a0[3]); w.z = cvt_pk_bf16(a1[0], a1[1]); w.w = cvt_pk_bf16(a1[2], a1[3]);
                    if (u.pn < 2) *(u32x4*)(QCg + (size_t)row * 512 + c) = w;
                    else if (u.pn == 2) *(u32x4*)(KVCg + (size_t)row * 256 + (c - 512)) = w;
                    else if (c < 800) *(u32x4*)(KR + (size_t)row * 32 + (c - 768)) = w; }
                if (u.pn < 3) {
                    ps += __builtin_bit_cast(float, __builtin_amdgcn_ds_bpermute((ln_ ^ 16) << 2, __builtin_bit_cast(int, ps)));
                    ps += __builtin_bit_cast(float, __builtin_amdgcn_ds_bpermute((ln_ ^ 32) << 2, __builtin_bit_cast(int, ps)));
                    if (fq == 0) atomicAdd((u.pn < 2 ? ssq_q : ssq_kv) + row, ps); } }
    }
};
__device__ __forceinline__ void cs_rev(float a, float& c, float& s) {
    double rev = (double)a * 0.15915494309189535; rev -= floor(rev); const float rf = (float)rev; c = __builtin_amdgcn_cosf(rf); s = __builtin_amdgcn_sinf(rf); }
__device__ __forceinline__ float shx32(float v, int o, int lane) { return __builtin_bit_cast(float, __builtin_amdgcn_ds_bpermute((lane ^ o) << 2, __builtin_bit_cast(int, v))); }
struct EpiEvenIn {
    static constexpr bool PERM = true, AFTER_DRAIN = false, HEAD64 = true;
    bf16_t* O; const float* ssq; const float* shw; const float* gdk; const float* ggk;
    __device__ __forceinline__ void operator()(const f32x4 (&acc)[2][2][4][2], const Unit& u, int wr, int wc, int fr, int fq) const {
        const int ln_ = fresh_lane(); fr = ln_ & 15; fq = (ln_ >> 4) & 3;
        const int rt = u.pm * BM; const int row0 = rt + wr * 64 + fr; const int colb = u.pn * BM + wc * 64 + 8 * fq;
        const bool isk = (u.pn == 2) || (u.pn == 3) || (u.pn == 6 && wc < 2); const bool isl = rt < 65536;
        const float* sp = shw + (size_t)mi_of_tile(rt) * 2560 + colb;
        f32x4 sw[2][2], gg[2][2]; float invf[8];
#pragma unroll
        for (int bj = 0; bj < 2; ++bj)
#pragma unroll
            for (int n = 0; n < 2; ++n) { sw[bj][n] = *(const f32x4*)(sp + 32 * bj + 4 * n); gg[bj][n] = (f32x4){1.f, 1.f, 1.f, 1.f}; }
        if (isk) { const float* g = (u.pn == 6) ? ggk : gdk;
#pragma unroll
            for (int bj = 0; bj < 2; ++bj)
#pragma unroll
                for (int n = 0; n < 2; ++n) gg[bj][n] = *(const f32x4*)(g + 32 * bj + 8 * fq + 4 * n);
#pragma unroll
            for (int j = 0; j < 8; ++j) invf[j] = exp2f(-(float)((8 * fq + j) & 15) * (13.287712379549449f / 16.0f)); }
        float riv[2][4];
#pragma unroll
        for (int ai = 0; ai < 2; ++ai)
#pragma unroll
            for (int m = 0; m < 4; ++m) riv[ai][m] = ssq[row0 + ai * HALF + m * 16];
#pragma unroll
        for (int ai = 0; ai < 2; ++ai)
#pragma unroll
            for (int m = 0; m < 4; ++m) { const int row = row0 + ai * HALF + m * 16; const float ri = rinv_of(riv[ai][m], 1.0f / 1024.0f);
                f32x4 v[2][2];
#pragma unroll
                for (int bj = 0; bj < 2; ++bj)
#pragma unroll
                    for (int n = 0; n < 2; ++n) v[bj][n] = acc[ai][bj][m][n] * ri + sw[bj][n];
                if (isk) { float ss = 0.f;
#pragma unroll
                    for (int bj = 0; bj < 2; ++bj)
#pragma unroll
                        for (int n = 0; n < 2; ++n) ss += (v[bj][n][0] * v[bj][n][0] + v[bj][n][1] * v[bj][n][1]) + (v[bj][n][2] * v[bj][n][2] + v[bj][n][3] * v[bj][n][3]);
                    ss += shx32(ss, 16, ln_); ss += shx32(ss, 32, ln_);
                    const float rh = 1.0f / sqrtf(ss * (1.0f / 64.0f) + 1e-6f);
#pragma unroll
                    for (int bj = 0; bj < 2; ++bj)
#pragma unroll
                        for (int n = 0; n < 2; ++n) v[bj][n] = v[bj][n] * rh * gg[bj][n];
                    if (isl) { const int t = row & 2047; const float pos = (fq < 2) ? (float)(t >> 6) : (float)(t & 63);
#pragma unroll
                        for (int n = 0; n < 2; ++n)
#pragma unroll
                            for (int e = 0; e < 4; ++e) { float c, s; cs_rev(pos * invf[4 * n + e], c, s); const float x1 = v[0][n][e], x2 = v[1][n][e]; v[0][n][e] = x1 * c - x2 * s; v[1][n][e] = x2 * c + x1 * s; } } }
#pragma unroll
                for (int bj = 0; bj < 2; ++bj) { u32x4 w; w.x = cvt_pk_bf16(v[bj][0][0], v[bj][0][1]); w.y = cvt_pk_bf16(v[bj][0][2], v[bj][0][3]); w.z = cvt_pk_bf16(v[bj][1][0], v[bj][1][1]); w.w = cvt_pk_bf16(v[bj][1][2], v[bj][1][3]);
                    *(u32x4*)(O + (size_t)row * 1792 + colb + 32 * bj) = w; } }
    }
};
struct EpiMlaKn {
    static constexpr bool PERM = true, AFTER_DRAIN = false, HEAD64 = true;
    bf16_t* K; const float* ssq_kv; const bf16_t* KR; const float* gk;
    __device__ __forceinline__ void operator()(const f32x4 (&acc)[2][2][4][2], const Unit& u, int wr, int wc, int fr, int fq) const {
        const int ln_ = fresh_lane(); fr = ln_ & 15; fq = (ln_ >> 4) & 3;
        const int rt = u.pm * BM; const int row0 = rt + wr * 64 + fr; const int h = 4 * u.pn + wc; const bool isl = rt < 65536;
        f32x4 gg[2][2], gr[2]; float invf[8];
#pragma unroll
        for (int bj = 0; bj < 2; ++bj)
#pragma unroll
            for (int n = 0; n < 2; ++n) gg[bj][n] = *(const f32x4*)(gk + 32 * bj + 8 * fq + 4 * n);
        gr[0] = *(const f32x4*)(gk + 64 + 8 * fq); gr[1] = *(const f32x4*)(gk + 64 + 8 * fq + 4);
#pragma unroll
        for (int j = 0; j < 8; ++j) invf[j] = exp2f(-(float)j * (13.287712379549449f / 8.0f));
        float riv[2][4];
#pragma unroll
        for (int ai = 0; ai < 2; ++ai)
#pragma unroll
            for (int m = 0; m < 4; ++m) riv[ai][m] = ssq_kv[row0 + ai * HALF + m * 16];
        u32x4 kwn = *(const u32x4*)(KR + (size_t)row0 * 32 + 8 * fq);
#pragma unroll
        for (int ai = 0; ai < 2; ++ai)
#pragma unroll
            for (int m = 0; m < 4; ++m) { const int row = row0 + ai * HALF + m * 16; const float ri = rinv_of(riv[ai][m], 1.0f / 256.0f);
                const u32x4 kw = kwn; { const int nx = ai * 4 + m + 1; if (nx < 8) kwn = *(const u32x4*)(KR + (size_t)(row0 + (nx >> 2) * HALF + (nx & 3) * 16) * 32 + 8 * fq); }
                float r[8] = {__builtin_bit_cast(float, kw.x << 16), __builtin_bit_cast(float, kw.x & 0xffff0000u), __builtin_bit_cast(float, kw.y << 16), __builtin_bit_cast(float, kw.y & 0xffff0000u),
                              __builtin_bit_cast(float, kw.z << 16), __builtin_bit_cast(float, kw.z & 0xffff0000u), __builtin_bit_cast(float, kw.w << 16), __builtin_bit_cast(float, kw.w & 0xffff0000u)};
                f32x4 v[2][2]; float ss = 0.f;
#pragma unroll
                for (int bj = 0; bj < 2; ++bj)
#pragma unroll
                    for (int n = 0; n < 2; ++n) { v[bj][n] = acc[ai][bj][m][n] * ri; ss += (v[bj][n][0] * v[bj][n][0] + v[bj][n][1] * v[bj][n][1]) + (v[bj][n][2] * v[bj][n][2] + v[bj][n][3] * v[bj][n][3]); }
#pragma unroll
                for (int j = 0; j < 8; ++j) ss += r[j] * r[j];
                ss += shx32(ss, 16, ln_); ss += shx32(ss, 32, ln_);
                const float rh = 1.0f / sqrtf(ss * (1.0f / 96.0f) + 1e-6f);
#pragma unroll
                for (int bj = 0; bj < 2; ++bj)
#pragma unroll
                    for (int n = 0; n < 2; ++n) v[bj][n] = v[bj][n] * rh * gg[bj][n];
#pragma unroll
                for (int j = 0; j < 8; ++j) r[j] *= rh * gr[j >> 2][j & 3];
                if (isl) { const int t = row & 2047; const float pos = (fq & 1) ? (float)(t & 63) : (float)(t >> 6);
#pragma unroll
                    for (int j = 0; j < 8; ++j) { const float pr = shx32(r[j], 32, ln_); float c, s; cs_rev(pos * invf[j], c, s); r[j] = (fq < 2) ? (r[j] * c - pr * s) : (r[j] * c + pr * s); } }
                bf16_t* kp = K + (size_t)row * 1536 + h * 96 + 8 * fq;
#pragma unroll
                for (int bj = 0; bj < 2; ++bj) { u32x4 w; w.x = cvt_pk_bf16(v[bj][0][0], v[bj][0][1]); w.y = cvt_pk_bf16(v[bj][0][2], v[bj][0][3]); w.z = cvt_pk_bf16(v[bj][1][0], v[bj][1][1]); w.w = cvt_pk_bf16(v[bj][1][2], v[bj][1][3]);
                    *(u32x4*)(kp + 32 * bj) = w; }
                { u32x4 w; w.x = cvt_pk_bf16(r[0], r[1]); w.y = cvt_pk_bf16(r[2], r[3]); w.z = cvt_pk_bf16(r[4], r[5]); w.w = cvt_pk_bf16(r[6], r[7]); *(u32x4*)(kp + 64) = w; } }
    }
};
struct EpiResid {
    static constexpr bool PERM = true, AFTER_DRAIN = false, HEAD64 = false;
    const float* base_lat; const float* base_ctx; float* out_lat; float* out_ctx; const float* gate;
    bf16_t* AP; const float* gn; const float* scn; float* ssq;
    __device__ __forceinline__ void operator()(const f32x4 (&acc)[2][2][4][2], const Unit& u, int wr, int wc, int fr, int fq) const {
        const int ln_ = fresh_lane(); fr = ln_ & 15; fq = (ln_ >> 4) & 3;
        const int rt = u.pm * BM; const bool isl = rt < 65536; const int mi = isl ? (rt >> 11) : 32;
        const float* bp = isl ? base_lat + (size_t)rt * 1024 : base_ctx + (size_t)(rt - 65536) * 1024;
        float* op = isl ? out_lat + (size_t)rt * 1024 : out_ctx + (size_t)(rt - 65536) * 1024;
        bf16_t* ap = AP + (size_t)rt * 1024;
        const int col0 = u.pn * BM + wc * 32 + 8 * fq; const float* gp = gate + mi * 6144 + col0; const float* sp = scn + mi * 6144 + col0; const float* gnp = gn + col0;
        float ps[2][4];
#pragma unroll
        for (int ai = 0; ai < 2; ++ai)
#pragma unroll
            for (int m = 0; m < 4; ++m) ps[ai][m] = 0.f;
#pragma unroll
        for (int bj = 0; bj < 2; ++bj) { const int co = bj * HALF;
            const f32x4 gv0 = *(const f32x4*)(gp + co), gv1 = *(const f32x4*)(gp + co + 4);
            const f32x4 gs0 = *(const f32x4*)(gnp + co) * (*(const f32x4*)(sp + co) + 1.0f), gs1 = *(const f32x4*)(gnp + co + 4) * (*(const f32x4*)(sp + co + 4) + 1.0f);
#pragma unroll
            for (int ai = 0; ai < 2; ++ai) {
                f32x4 b0[4], b1[4];
#pragma unroll
                for (int m = 0; m < 4; ++m) { const size_t off = (size_t)(ai * HALF + wr * 64 + m * 16 + fr) * 1024 + col0 + co; b0[m] = *(const f32x4*)(bp + off); b1[m] = *(const f32x4*)(bp + off + 4); }
#pragma unroll
                for (int m = 0; m < 4; ++m) { const size_t off = (size_t)(ai * HALF + wr * 64 + m * 16 + fr) * 1024 + col0 + co;
                    const f32x4 o0 = b0[m] + gv0 * acc[ai][bj][m][0], o1 = b1[m] + gv1 * acc[ai][bj][m][1];
                    *(f32x4*)(op + off) = o0; *(f32x4*)(op + off + 4) = o1;
                    if (AP) { const f32x4 a0 = o0 * gs0, a1 = o1 * gs1; u32x4 w; w.x = cvt_pk_bf16(a0[0], a0[1]); w.y = cvt_pk_bf16(a0[2], a0[3]); w.z = cvt_pk_bf16(a1[0], a1[1]); w.w = cvt_pk_bf16(a1[2], a1[3]);
                        *(u32x4*)(ap + off) = w; }
                    ps[ai][m] += ((o0[0] * o0[0] + o0[1] * o0[1]) + (o0[2] * o0[2] + o0[3] * o0[3])) + ((o1[0] * o1[0] + o1[1] * o1[1]) + (o1[2] * o1[2] + o1[3] * o1[3])); }
                asm volatile("" ::: "memory"); } }
#pragma unroll
        for (int ai = 0; ai < 2; ++ai)
#pragma unroll
            for (int m = 0; m < 4; ++m) { float s = ps[ai][m];
                s += __builtin_bit_cast(float, __builtin_amdgcn_ds_bpermute((ln_ ^ 16) << 2, __builtin_bit_cast(int, s)));
                s += __builtin_bit_cast(float, __builtin_amdgcn_ds_bpermute((ln_ ^ 32) << 2, __builtin_bit_cast(int, s)));
                if (AP && fq == 0) atomicAdd(ssq + rt + ai * HALF + wr * 64 + m * 16 + fr, s); }
    }
};
struct EpiShw {
    static constexpr bool PERM = false, AFTER_DRAIN = false, HEAD64 = false;
    float* SHW;
    __device__ __forceinline__ void operator()(const f32x4 (&acc)[2][2][4][2], const Unit& u, int wr, int wc, int fr, int fq) const {
        { const int t_ = fresh_lane(); fr = t_ & 15; fq = (t_ >> 4) & 3; }
        if (wr != 0) return;
        const int L = u.pm >> 1, w = u.pm & 1; const int i2 = L >> 1;
        const int t0 = w ? (64 + L * 32) : ((L & 1) ? (32 + i2 * 16) : (i2 * 16));
        const int ld = w ? 4096 : ((L & 1) ? 1024 : 2560);
        float* dst = SHW + (size_t)L * 33 * 8192 + (w ? 33 * 4096 : 0) + (u.pn - t0) * 256 + wc * 32 + 4 * fq;
#pragma unroll
        for (int m = 0; m < 3; ++m) { const int row = m * 16 + fr; if (row < 33) {
#pragma unroll
                for (int bj = 0; bj < 2; ++bj)
#pragma unroll
                    for (int n = 0; n < 2; ++n) *(f32x4*)(dst + (size_t)row * ld + bj * HALF + n * 16) = acc[0][bj][m][n]; } }
    }
};
struct ShwOrder {
    int G, c;
    __device__ __forceinline__ bool next(int i, Unit& u) const {
        int j = i * G + c; if (j >= 92) return false;
        int L = 0; if (j >= 26) { j -= 26; L = 1; if (j >= 20) { j -= 20; L = 2; if (j >= 26) { j -= 26; L = 3; } } }
        const int nin = (L & 1) ? 4 : 10; const int i2 = L >> 1;
        if (j < nin) { u.pm = 2 * L; u.pn = ((L & 1) ? (32 + i2 * 16) : (i2 * 16)) + j; }
        else { u.pm = 2 * L + 1; u.pn = 64 + L * 32 + (j - nin); }
        return true;
    }
    __device__ __forceinline__ void a_ready(const Unit&) const {}
    __device__ __forceinline__ void done(const Unit&) const {}
};
template <class Epi, class Sched, bool ALIGN_EPI = false, bool SP2 = false>
__device__ __forceinline__ void gemm_phase(PG8_LAS unsigned char* lds, const Gemm g, const Sched& S, const Epi& E, const int wave_s) {
    int tid_ = wave_s * 64 + fresh_lane();
    const int tid = tid_, wid = __builtin_amdgcn_readfirstlane(tid >> 6), lane = tid & 63, wr = wid >> 2, wc = wid & 3, fr = lane & 15, fq = lane >> 4;
    const int K = g.K, nt = K / BK;
    unsigned voffA[2], voffB[2];
#pragma unroll
    for (int i = 0; i < 2; ++i) { int R, C; stage_rc(tid * 16 + i * 8192, R, C); const int Rb = Epi::HEAD64 ? (64 * (R >> 5) + perm32(R & 31)) : (Epi::PERM ? ((R & ~31) + perm32(R & 31)) : R);
        voffA[i] = (unsigned)(R * K + C) * 2u; voffB[i] = (unsigned)(Rb * K + C) * 2u; }
    const size_t kstep = (size_t)(BK * 2);
    const size_t hstep = (size_t)HALF * K * 2;
    const size_t hstepB = Epi::HEAD64 ? (size_t)32 * K * 2 : hstep;
    const size_t tstep = 2 * hstep;
    const unsigned ldsw = (unsigned)wid * 1024u;
    const int aoff = lds_byte(wr * 64 + fr, fq * 8), boff = lds_byte(wc * 32 + fr, fq * 8);
#define PG8_SA(b, h) (((b) * 2 + (h)) * HTB)
#define PG8_SB(b, h) ((4 + (b) * 2 + (h)) * HTB)
#define PG8_STAGE(bufoff, gbase, voff) do { _Pragma("unroll") for (int _i = 0; _i < 2; ++_i) \
        __builtin_amdgcn_global_load_lds((const unsigned*)((const char*)(gbase) + (voff)[_i]), (PG8_LAS unsigned*)(lds + (bufoff) + ldsw + _i * 8192), 16, 0, 0); } while (0)
#define PG8_LDA(dst, b, h) do { _Pragma("unroll") for (int m = 0; m < 4; ++m) _Pragma("unroll") for (int k = 0; k < 2; ++k) dst[m][k] = *(const PG8_LAS bf16x8*)(lds + PG8_SA(b, h) + aoff + m * 2048 + k * 1024); } while (0)
#define PG8_LDB(dst, b, h) do { _Pragma("unroll") for (int n = 0; n < 2; ++n) _Pragma("unroll") for (int k = 0; k < 2; ++k) dst[n][k] = *(const PG8_LAS bf16x8*)(lds + PG8_SB(b, h) + boff + n * 2048 + k * 1024); } while (0)
#define PG8_MMA(ai, bj, At, Bt) do { __builtin_amdgcn_s_setprio(1); _Pragma("unroll") for (int m = 0; m < 4; ++m) _Pragma("unroll") for (int n = 0; n < 2; ++n) _Pragma("unroll") for (int k = 0; k < 2; ++k) \
        acc[ai][bj][m][n] = __builtin_amdgcn_mfma_f32_16x16x32_bf16(Bt[n][k], At[m][k], acc[ai][bj][m][n], 0, 0, 0); __builtin_amdgcn_s_setprio(0); } while (0)
#define PG8_WAIT_V(n) asm volatile("s_waitcnt vmcnt(" #n ")" ::: "memory")
#define PG8_WAIT_L(n) asm volatile("s_waitcnt lgkmcnt(" #n ")" ::: "memory")
#define PG8_BAR __builtin_amdgcn_s_barrier()
#define PG8_SCHED __builtin_amdgcn_sched_barrier(0)
    Unit cur, nxt; int ui = 0;
    if (!S.next(0, cur)) return;
    f32x4 acc[2][2][4][2];
#pragma unroll
    for (int a = 0; a < 2; ++a)
#pragma unroll
        for (int b = 0; b < 2; ++b)
#pragma unroll
            for (int m = 0; m < 4; ++m)
#pragma unroll
                for (int n = 0; n < 2; ++n) acc[a][b][m][n] = (f32x4){0.f, 0.f, 0.f, 0.f};
    bf16x8 At[4][2], B0[2][2], B1[2][2];
    const char* cA = (const char*)g.A + (size_t)cur.pm * tstep; const char* cB = (const char*)g.Bt + (size_t)cur.pn * tstep;
    S.a_ready(cur);
    if constexpr (SP2) {
        PG8_STAGE(PG8_SB(0, 0), cB, voffB); PG8_STAGE(PG8_SB(0, 1), cB + hstepB, voffB); PG8_STAGE(PG8_SA(0, 0), cA, voffA); PG8_STAGE(PG8_SA(0, 1), cA + hstep, voffA);
        if (wr == 1) PG8_BAR;
        PG8_WAIT_V(2); PG8_BAR;
        PG8_STAGE(PG8_SB(1, 0), cB + kstep, voffB); PG8_STAGE(PG8_SA(1, 0), cA + kstep, voffA); PG8_STAGE(PG8_SB(1, 1), cB + hstepB + kstep, voffB);
        PG8_WAIT_V(6); PG8_BAR;
    } else {
        PG8_STAGE(PG8_SB(0, 0), cB, voffB); PG8_STAGE(PG8_SA(0, 0), cA, voffA); PG8_STAGE(PG8_SB(0, 1), cB + hstepB, voffB); PG8_STAGE(PG8_SA(0, 1), cA + hstep, voffA);
        if (wr == 1) PG8_BAR;
        PG8_WAIT_V(4); PG8_BAR;
        PG8_STAGE(PG8_SB(1, 0), cB + kstep, voffB); PG8_STAGE(PG8_SA(1, 0), cA + kstep, voffA); PG8_STAGE(PG8_SB(1, 1), cB + hstepB + kstep, voffB);
        PG8_WAIT_V(6); PG8_BAR;
    }
    for (;;) {
        const bool has_next = S.next(ui + 1, nxt);
        const char* nA = has_next ? (const char*)g.A + (size_t)nxt.pm * tstep : cA; const char* nB = has_next ? (const char*)g.Bt + (size_t)nxt.pn * tstep : cB;
        for (int t = 0; t < nt; t += 2) {
            const bool last = (t == nt - 2);
            const char* a1 = cA + (size_t)(t + 1) * kstep;
            const char* a2 = last ? nA : cA + (size_t)(t + 2) * kstep; const char* b2 = last ? nB : cB + (size_t)(t + 2) * kstep;
            const char* a3 = a2 + kstep; const char* b3 = b2 + kstep;
            if (last && has_next) S.a_ready(nxt);
            if constexpr (SP2) {
            PG8_LDB(B0, 0, 0); PG8_LDB(B1, 0, 1); PG8_SCHED; PG8_LDA(At, 0, 0); PG8_STAGE(PG8_SA(1, 1), a1 + hstep, voffA);
            PG8_WAIT_V(8); PG8_WAIT_L(0); PG8_BAR; PG8_MMA(0, 0, At, B0); PG8_MMA(0, 1, At, B1); PG8_BAR; PG8_SCHED;
            PG8_LDA(At, 0, 1); PG8_STAGE(PG8_SB(0, 0), b2, voffB); PG8_STAGE(PG8_SB(0, 1), b2 + hstepB, voffB); PG8_STAGE(PG8_SA(0, 0), a2, voffA);
            PG8_WAIT_V(8); PG8_WAIT_L(0); PG8_BAR; PG8_MMA(1, 0, At, B0); PG8_MMA(1, 1, At, B1); PG8_BAR; PG8_SCHED;
            PG8_LDB(B0, 1, 0); PG8_LDB(B1, 1, 1); PG8_SCHED; PG8_LDA(At, 1, 0); PG8_STAGE(PG8_SA(0, 1), a2 + hstep, voffA);
            PG8_WAIT_V(8); PG8_WAIT_L(0); PG8_BAR; PG8_MMA(0, 0, At, B0); PG8_MMA(0, 1, At, B1); PG8_BAR; PG8_SCHED;
            PG8_LDA(At, 1, 1); PG8_STAGE(PG8_SB(1, 0), b3, voffB); PG8_STAGE(PG8_SB(1, 1), b3 + hstepB, voffB); PG8_STAGE(PG8_SA(1, 0), a3, voffA);
            PG8_WAIT_V(8); PG8_WAIT_L(0); PG8_BAR; PG8_MMA(1, 0, At, B0); PG8_MMA(1, 1, At, B1); PG8_BAR; PG8_SCHED;
            } else {
            PG8_LDB(B0, 0, 0); PG8_SCHED; PG8_LDA(At, 0, 0); PG8_STAGE(PG8_SA(1, 1), a1 + hstep, voffA);
            PG8_WAIT_L(8); PG8_BAR; PG8_WAIT_L(0); PG8_MMA(0, 0, At, B0); PG8_BAR; PG8_SCHED;
            PG8_LDB(B1, 0, 1); PG8_STAGE(PG8_SB(0, 0), b2, voffB);
            PG8_BAR; PG8_WAIT_L(0); PG8_MMA(0, 1, At, B1); PG8_BAR;
            PG8_LDA(At, 0, 1); PG8_STAGE(PG8_SA(0, 0), a2, voffA);
            PG8_BAR; PG8_WAIT_L(0); PG8_MMA(1, 0, At, B0); PG8_BAR; PG8_SCHED;
            PG8_STAGE(PG8_SB(0, 1), b2 + hstepB, voffB);
            PG8_WAIT_V(6); PG8_BAR; PG8_MMA(1, 1, At, B1); PG8_BAR;
            PG8_LDB(B0, 1, 0); PG8_SCHED; PG8_LDA(At, 1, 0); PG8_STAGE(PG8_SA(0, 1), a2 + hstep, voffA);
            PG8_WAIT_L(8); PG8_BAR; PG8_WAIT_L(0); PG8_MMA(0, 0, At, B0); PG8_BAR; PG8_SCHED;
            PG8_LDB(B1, 1, 1); PG8_STAGE(PG8_SB(1, 0), b3, voffB);
            PG8_BAR; PG8_WAIT_L(0); PG8_MMA(0, 1, At, B1); PG8_BAR;
            PG8_LDA(At, 1, 1); PG8_STAGE(PG8_SA(1, 0), a3, voffA);
            PG8_BAR; PG8_WAIT_L(0); PG8_MMA(1, 0, At, B0); PG8_BAR; PG8_SCHED;
            PG8_STAGE(PG8_SB(1, 1), b3 + hstepB, voffB);
            PG8_WAIT_V(6); PG8_BAR; PG8_MMA(1, 1, At, B1); PG8_BAR;
            }
        }
        if constexpr (ALIGN_EPI) { if (wr == 0) PG8_BAR; }
        if constexpr (!Epi::AFTER_DRAIN) { E(acc, cur, wr, wc, fr, fq); S.done(cur); }
        if (!has_next) break;
#pragma unroll
        for (int a = 0; a < 2; ++a)
#pragma unroll
            for (int b = 0; b < 2; ++b)
#pragma unroll
                for (int m = 0; m < 4; ++m)
#pragma unroll
                    for (int n = 0; n < 2; ++n) acc[a][b][m][n] = (f32x4){0.f, 0.f, 0.f, 0.f};
        cur = nxt; cA = nA; cB = nB; ++ui;
        if constexpr (ALIGN_EPI) { if (wr == 1) PG8_BAR; }
    }
    PG8_WAIT_V(0);
    if constexpr (!ALIGN_EPI) { if (wr == 0) PG8_BAR; }
    PG8_BAR;
    if constexpr (Epi::AFTER_DRAIN) { E.fused(acc, cur, wr, wc, fr, fq, lds, wid, lane); S.done(cur); }
#undef PG8_SA
#undef PG8_SB
#undef PG8_STAGE
#undef PG8_LDA
#undef PG8_LDB
#undef PG8_MMA
#undef PG8_WAIT_V
#undef PG8_WAIT_L
#undef PG8_BAR
#undef PG8_SCHED
}
}

#define LAS __attribute__((address_space(3)))
typedef unsigned short bf16;
typedef short bf16x8 __attribute__((ext_vector_type(8)));
typedef float f32x4 __attribute__((ext_vector_type(4)));
typedef float f32x2 __attribute__((ext_vector_type(2)));
typedef float f32x16 __attribute__((ext_vector_type(16)));
typedef unsigned u32x4 __attribute__((ext_vector_type(4)));
typedef unsigned u32x2 __attribute__((ext_vector_type(2)));

constexpr int NWAVES = 8, NTHR = 512;
constexpr int NLAT = 65536, NCTX = 8192, R = NLAT + NCTX;
constexpr int D = 1024, FF = 4096, KV = 2304;
constexpr float EPS = 1e-6f, LOG2E = 1.4426950408889634f;
constexpr size_t MiB = 1u << 20;
constexpr size_t WS_MOD = 0, WS_W = 4 * MiB, WS_XCTX = 100 * MiB, WS_H = 132 * MiB, WS_R = 276 * MiB, WS_CTL = 996 * MiB, WS_SSQ = 997 * MiB, WS_SHB = 998 * MiB, WS_SHW = 1002 * MiB, WS_SSQM = 1007 * MiB, WS_END = 1008 * MiB;
constexpr size_t CTL_BYTES = 16384;
constexpr int MISC_OFF = 147456 - 64;
constexpr int LDS_BYTES = 147456;
constexpr int RAWP = 1792;
constexpr int MQP = 1536;

__device__ __forceinline__ unsigned f2bf(float f) { unsigned u = __builtin_bit_cast(unsigned, f); return (u + 0x7fffu + ((u >> 16) & 1u)) >> 16; }
__device__ __forceinline__ unsigned pk2(float lo, float hi) { return f2bf(lo) | (f2bf(hi) << 16); }
typedef __bf16 bf16x2_t __attribute__((ext_vector_type(2)));
__device__ __forceinline__ unsigned cvtpk_nv(float lo, float hi) { f32x2 v = {lo, hi}; bf16x2_t b = __builtin_convertvector(v, bf16x2_t); return __builtin_bit_cast(unsigned, b); }
__device__ __forceinline__ float bflo(unsigned u) { return __builtin_bit_cast(float, u << 16); }
__device__ __forceinline__ float bfhi(unsigned u) { return __builtin_bit_cast(float, u & 0xffff0000u); }
__device__ __forceinline__ float shx(float v, int o, int lane) { return __builtin_bit_cast(float, __builtin_amdgcn_ds_bpermute((lane ^ o) << 2, __builtin_bit_cast(int, v))); }
__device__ __forceinline__ float wave_sum(float v, int lane) {
#pragma unroll
    for (int o = 1; o < 64; o <<= 1) v += shx(v, o, lane);
    return v;
}
__device__ __forceinline__ float wave_max(float v, int lane) {
#pragma unroll
    for (int o = 1; o < 64; o <<= 1) v = fmaxf(v, shx(v, o, lane));
    return v;
}
__device__ __forceinline__ void cs_of(float a, float& c, float& s) {
    double rev = (double)a * 0.15915494309189535; rev -= floor(rev); const float rf = (float)rev;
    c = __builtin_amdgcn_cosf(rf); s = __builtin_amdgcn_sinf(rf);
}

__device__ __forceinline__ void xpose_item(const float* W, int srcN, int scol, bf16* WT, int K, int drow, LAS float* scr, int k0, int lane) {
#pragma unroll 8
    for (int i = 0; i < 32; ++i) { const int kk = 2 * i + (lane >> 5); scr[kk * 33 + (lane & 31)] = W[(size_t)(k0 + kk) * srcN + scol + (lane & 31)]; }
    asm volatile("s_waitcnt lgkmcnt(0)" ::: "memory");
    const int c = lane & 7;
#pragma unroll
    for (int j = 0; j < 4; ++j) { const int n = (lane >> 3) + 8 * j; const LAS float* s = scr + (8 * c) * 33 + n;
        u32x4 o; o.x = pk2(s[0 * 33], s[1 * 33]); o.y = pk2(s[2 * 33], s[3 * 33]); o.z = pk2(s[4 * 33], s[5 * 33]); o.w = pk2(s[6 * 33], s[7 * 33]);
        *(u32x4*)(WT + (size_t)(drow + n) * K + k0 + 8 * c) = o; }
    asm volatile("s_waitcnt lgkmcnt(0)" ::: "memory");
}
__device__ __forceinline__ void xpose_seg(const float* W, int K, int srcN, int scol0, int ncols, bool hs, bf16* WT, int drow0, LAS float* scr, int gw, int NGW, int& cur, int lane) {
    const int nblk = ncols / 32, nit = (K / 64) * nblk;
    int it = gw - cur; if (it < 0) it += NGW;
    for (; it < nit; it += NGW) { const int kb = it / nblk, nb = it % nblk; const int sc = scol0 + (hs ? ((nb >> 1) * 128 + (nb & 1) * 32) : nb * 32);
        xpose_item(W, srcN, sc, WT, K, drow0 + nb * 32, scr, kb * 64, lane); }
    cur = (cur + nit) % NGW;
}
__device__ __forceinline__ void zero_rows(bf16* WT, int K, int row0, int nrows, int gw, int NGW, int lane) {
    const int n16 = nrows * K / 8; u32x4* p = (u32x4*)(WT + (size_t)row0 * K); const u32x4 z = {0u, 0u, 0u, 0u};
    for (int i = gw * 64 + lane; i < n16; i += NGW * 64) p[i] = z;
}

__device__ __forceinline__ void norm_phase(const float* xlat, const float* xctx, const float* g, const float* modl, int sh_off, int sc_off, bf16* H, int vcu, int NGW, int wave_s) {
    const int lane = fresh_lane(); const int gw = vcu * NWAVES + wave_s;
    f32x4 g4[4];
#pragma unroll
    for (int j = 0; j < 4; ++j) g4[j] = *(const f32x4*)(g + 256 * j + 4 * lane);
    for (int r0 = gw; r0 < R; r0 += 2 * NGW) {
        const int r1 = r0 + NGW; const bool has1 = r1 < R;
        const float* xr0 = (r0 < NLAT) ? xlat + (size_t)r0 * D : xctx + (size_t)(r0 - NLAT) * D;
        const float* xr1 = has1 ? ((r1 < NLAT) ? xlat + (size_t)r1 * D : xctx + (size_t)(r1 - NLAT) * D) : xr0;
        f32x4 v0[4], v1[4]; float s0 = 0.f, s1 = 0.f;
#pragma unroll
        for (int j = 0; j < 4; ++j) { v0[j] = *(const f32x4*)(xr0 + 256 * j + 4 * lane); v1[j] = *(const f32x4*)(xr1 + 256 * j + 4 * lane); }
#pragma unroll
        for (int j = 0; j < 4; ++j) { s0 += (v0[j].x * v0[j].x + v0[j].y * v0[j].y) + (v0[j].z * v0[j].z + v0[j].w * v0[j].w); s1 += (v1[j].x * v1[j].x + v1[j].y * v1[j].y) + (v1[j].z * v1[j].z + v1[j].w * v1[j].w); }
        const float ri0 = 1.0f / sqrtf(wave_sum(s0, lane) * (1.0f / D) + EPS), ri1 = 1.0f / sqrtf(wave_sum(s1, lane) * (1.0f / D) + EPS);
        const float* mp0 = modl + ((r0 < NLAT) ? (r0 >> 11) : 32) * 6144; const float* mp1 = modl + ((r1 < NLAT) ? (r1 >> 11) : 32) * 6144;
#pragma unroll
        for (int j = 0; j < 4; ++j) { const int c = 256 * j + 4 * lane; const f32x4 sc = *(const f32x4*)(mp0 + sc_off + c), sh = *(const f32x4*)(mp0 + sh_off + c);
            const f32x4 y = (v0[j] * ri0 * g4[j]) * (sc + 1.0f) + sh; u32x2 w; w.x = pk2(y.x, y.y); w.y = pk2(y.z, y.w);
            *(u32x2*)(H + (size_t)r0 * D + c) = w; }
        if (has1) {
#pragma unroll
            for (int j = 0; j < 4; ++j) { const int c = 256 * j + 4 * lane; const f32x4 sc = *(const f32x4*)(mp1 + sc_off + c), sh = *(const f32x4*)(mp1 + sh_off + c);
                const f32x4 y = (v1[j] * ri1 * g4[j]) * (sc + 1.0f) + sh; u32x2 w; w.x = pk2(y.x, y.y); w.y = pk2(y.z, y.w);
                *(u32x2*)(H + (size_t)r1 * D + c) = w; }
        }
    }
}
__device__ __forceinline__ void prep_phase(const float* xlat, const float* xctx, const float* g, const float* modl, int sc_off, bf16* AP, float* ssq, int vcu, int NGW, int wave_s) {
    const int lane = fresh_lane(); const int gw = vcu * NWAVES + wave_s;
    f32x4 g4[4];
#pragma unroll
    for (int j = 0; j < 4; ++j) g4[j] = *(const f32x4*)(g + 256 * j + 4 * lane);
    for (int r0 = gw; r0 < R; r0 += 2 * NGW) {
        const int r1 = r0 + NGW; const bool has1 = r1 < R;
        const float* xr0 = (r0 < NLAT) ? xlat + (size_t)r0 * D : xctx + (size_t)(r0 - NLAT) * D;
        const float* xr1 = has1 ? ((r1 < NLAT) ? xlat + (size_t)r1 * D : xctx + (size_t)(r1 - NLAT) * D) : xr0;
        f32x4 v0[4], v1[4]; float s0 = 0.f, s1 = 0.f;
#pragma unroll
        for (int j = 0; j < 4; ++j) { v0[j] = *(const f32x4*)(xr0 + 256 * j + 4 * lane); v1[j] = *(const f32x4*)(xr1 + 256 * j + 4 * lane); }
#pragma unroll
        for (int j = 0; j < 4; ++j) { s0 += (v0[j].x * v0[j].x + v0[j].y * v0[j].y) + (v0[j].z * v0[j].z + v0[j].w * v0[j].w); s1 += (v1[j].x * v1[j].x + v1[j].y * v1[j].y) + (v1[j].z * v1[j].z + v1[j].w * v1[j].w); }
        s0 = wave_sum(s0, lane); s1 = wave_sum(s1, lane);
        const float* mp0 = modl + ((r0 < NLAT) ? (r0 >> 11) : 32) * 6144; const float* mp1 = modl + ((r1 < NLAT) ? (r1 >> 11) : 32) * 6144;
#pragma unroll
        for (int j = 0; j < 4; ++j) { const int c = 256 * j + 4 * lane; const f32x4 sc = *(const f32x4*)(mp0 + sc_off + c);
            const f32x4 y = (v0[j] * g4[j]) * (sc + 1.0f); u32x2 w; w.x = pk2(y.x, y.y); w.y = pk2(y.z, y.w);
            *(u32x2*)(AP + (size_t)r0 * D + c) = w; }
        if (lane == 0) ssq[r0] = s0;
        if (has1) {
#pragma unroll
            for (int j = 0; j < 4; ++j) { const int c = 256 * j + 4 * lane; const f32x4 sc = *(const f32x4*)(mp1 + sc_off + c);
                const f32x4 y = (v1[j] * g4[j]) * (sc + 1.0f); u32x2 w; w.x = pk2(y.x, y.y); w.y = pk2(y.z, y.w);
                *(u32x2*)(AP + (size_t)r1 * D + c) = w; }
            if (lane == 0) ssq[r1] = s1;
        }
    }
}
__device__ __forceinline__ void zero_f32(float* p, int n, int vcu, int NGW, int wave_s) {
    const int lane = fresh_lane(); const int gw = vcu * NWAVES + wave_s;
    for (int i = gw * 64 + lane; i < n; i += NGW * 64) p[i] = 0.f;
}
__device__ __forceinline__ void mlanorm_phase(const bf16* MRAW, const float* gq, const float* gkv, bf16* QCn, bf16* KVCn, int vcu, int NGW, int wave_s) {
    const int lane = fresh_lane(); const int gw = vcu * NWAVES + wave_s;
    u32x4 na = {0u, 0u, 0u, 0u}; u32x2 nb = {0u, 0u};
    if (gw < R) { na = *(const u32x4*)(MRAW + (size_t)gw * 1024 + 8 * lane); nb = *(const u32x2*)(MRAW + (size_t)gw * 1024 + 512 + 4 * lane); }
    for (int r = gw; r < R; r += NGW) {
        const bf16* row = MRAW + (size_t)r * 1024;
        const u32x4 a = na; const u32x2 b = nb;
        if (r + NGW < R) { na = *(const u32x4*)(row + (size_t)NGW * 1024 + 8 * lane); nb = *(const u32x2*)(row + (size_t)NGW * 1024 + 512 + 4 * lane); }
        float x[8] = {bflo(a.x), bfhi(a.x), bflo(a.y), bfhi(a.y), bflo(a.z), bfhi(a.z), bflo(a.w), bfhi(a.w)}; float y[4] = {bflo(b.x), bfhi(b.x), bflo(b.y), bfhi(b.y)};
        float s1 = 0.f, s2 = 0.f;
#pragma unroll
        for (int e = 0; e < 8; ++e) s1 += x[e] * x[e];
#pragma unroll
        for (int e = 0; e < 4; ++e) s2 += y[e] * y[e];
        const float r1 = 1.0f / sqrtf(wave_sum(s1, lane) * (1.0f / 512) + EPS), r2 = 1.0f / sqrtf(wave_sum(s2, lane) * (1.0f / 256) + EPS);
        const f32x4 g0 = *(const f32x4*)(gq + 8 * lane), g1 = *(const f32x4*)(gq + 8 * lane + 4), g2 = *(const f32x4*)(gkv + 4 * lane);
        u32x4 o; o.x = pk2(x[0] * r1 * g0.x, x[1] * r1 * g0.y); o.y = pk2(x[2] * r1 * g0.z, x[3] * r1 * g0.w); o.z = pk2(x[4] * r1 * g1.x, x[5] * r1 * g1.y); o.w = pk2(x[6] * r1 * g1.z, x[7] * r1 * g1.w);
        *(u32x4*)(QCn + (size_t)r * 512 + 8 * lane) = o;
        u32x2 p; p.x = pk2(y[0] * r2 * g2.x, y[1] * r2 * g2.y); p.y = pk2(y[2] * r2 * g2.z, y[3] * r2 * g2.w);
        *(u32x2*)(KVCn + (size_t)r * 256 + 4 * lane) = p;
    }
}
__device__ __forceinline__ void post_even(bf16* RAW, const float* gdq, const float* gdk, const float* ggq, const float* ggk, int vcu, int NGW, int wave_s) {
    const int lane = fresh_lane(); const int gw = vcu * NWAVES + wave_s;
    const int sub = lane & 15; const float L2T = 13.287712379549449f;
    float invf[4];
#pragma unroll
    for (int e = 0; e < 4; ++e) { const int jj = 4 * (sub & 7) + e; invf[e] = exp2f(-(float)(jj & 15) * (1.0f / 16.0f) * L2T); }
    f32x4 G[4]; G[0] = *(const f32x4*)(gdq + 4 * sub); G[1] = *(const f32x4*)(gdk + 4 * sub); G[2] = *(const f32x4*)(ggq + 4 * sub); G[3] = *(const f32x4*)(ggk + 4 * sub);
    u32x2 nx[7];
    if (gw < R) {
#pragma unroll
        for (int c = 0; c < 7; ++c) if (c == 2 || c == 3 || c == 6) nx[c] = *(const u32x2*)(RAW + (size_t)gw * RAWP + 256 * c + 4 * lane); }
    for (int r = gw; r < R; r += NGW) {
        const bool isl = r < NLAT; const int t = r & 2047; const float prow = (float)(t >> 6), pcol = (float)(t & 63);
        float cs[4], sn[4];
#pragma unroll
        for (int e = 0; e < 4; ++e) { if (isl) { const int jj = 4 * (sub & 7) + e; cs_of((jj < 16 ? prow : pcol) * invf[e], cs[e], sn[e]); } else { cs[e] = 1.f; sn[e] = 0.f; } }
        bf16* row = RAW + (size_t)r * RAWP;
        u32x2 av[7];
#pragma unroll
        for (int c = 0; c < 7; ++c) if (c == 2 || c == 3 || c == 6) av[c] = nx[c];
        if (r + NGW < R) {
#pragma unroll
            for (int c = 0; c < 7; ++c) if (c == 2 || c == 3 || c == 6) nx[c] = *(const u32x2*)(row + (size_t)NGW * RAWP + 256 * c + 4 * lane); }
#pragma unroll
        for (int c = 0; c < 7; ++c) { if (!(c == 2 || c == 3 || c == 6)) continue;
            const u32x2 a = av[c];
            float x[4] = {bflo(a.x), bfhi(a.x), bflo(a.y), bfhi(a.y)};
            float ss = (x[0] * x[0] + x[1] * x[1]) + (x[2] * x[2] + x[3] * x[3]);
            ss += shx(ss, 1, lane); ss += shx(ss, 2, lane); ss += shx(ss, 4, lane); ss += shx(ss, 8, lane);
            const float rinv = 1.0f / sqrtf(ss * (1.0f / 64) + EPS);
            const f32x4 g4 = G[c < 2 ? 0 : (c < 4 ? 1 : (c < 6 ? 2 : 3))];
            const float qs = (c < 2 || c == 4 || c == 5) ? 0.125f * LOG2E : 1.0f;
            float y[4] = {x[0] * rinv * g4.x, x[1] * rinv * g4.y, x[2] * rinv * g4.z, x[3] * rinv * g4.w}; float o[4];
#pragma unroll
            for (int e = 0; e < 4; ++e) { const float py = shx(y[e], 8, lane); o[e] = ((sub < 8) ? (y[e] * cs[e] - py * sn[e]) : (y[e] * cs[e] + py * sn[e])) * qs; }
            u32x2 w; w.x = pk2(o[0], o[1]); w.y = pk2(o[2], o[3]);
            *(u32x2*)(row + 256 * c + 4 * lane) = w;
        }
    }
}
__device__ __forceinline__ void post_mla(bf16* Q, bf16* Kb, const bf16* MRAW, const float* gq, const float* gk, int vcu, int NGW, int wave_s) {
    const int lane = fresh_lane(); const int gw = vcu * NWAVES + wave_s;
    const int i = lane & 31, half = lane >> 5; const float L2T = 13.287712379549449f;
    float invf[2];
#pragma unroll
    for (int e = 0; e < 2; ++e) { const int jj = (2 * i + e) & 15; invf[e] = exp2f(-(float)(jj & 7) * (1.0f / 8.0f) * L2T); }
    const f32x2 gqa = *(const f32x2*)(gq + 2 * i), gqb = *(const f32x2*)(gq + 64 + 2 * (i & 15)), gka = *(const f32x2*)(gk + 2 * i), gkb = *(const f32x2*)(gk + 64 + 2 * (i & 15));
    const float qs = 0.10206207261596577f * LOG2E;
    unsigned na[2][8], nb[8], nkr = 0u;
#define MLA_LOAD(rr) do { _Pragma("unroll") for (int p = 0; p < 8; ++p) { na[0][p] = 0u; na[1][p] = *(const unsigned*)(Kb + (size_t)(rr) * MQP + (2 * p + half) * 96 + 2 * i); nb[p] = 0u; } \
        nkr = (i < 16) ? *(const unsigned*)(MRAW + (size_t)(rr) * 32 + 2 * i) : 0u; } while (0)
    if (gw < R) MLA_LOAD(gw);
    for (int r = gw; r < R; r += NGW) {
        const bool isl = r < NLAT; const int t = r & 2047; const float prow = (float)(t >> 6), pcol = (float)(t & 63);
        float cs[2], sn[2];
#pragma unroll
        for (int e = 0; e < 2; ++e) { if (isl) { const int jj = (2 * i + e) & 15; cs_of((jj < 8 ? prow : pcol) * invf[e], cs[e], sn[e]); } else { cs[e] = 1.f; sn[e] = 0.f; } }
        unsigned la[2][8], lb[8];
#pragma unroll
        for (int p = 0; p < 8; ++p) { la[0][p] = na[0][p]; la[1][p] = na[1][p]; lb[p] = nb[p]; }
        const unsigned krw = nkr;
        if (r + NGW < R) { const int rn = r + NGW; MLA_LOAD(rn); }
#pragma unroll
        for (int isk = 1; isk < 2; ++isk) {
            bf16* base = (isk ? Kb : Q) + (size_t)r * MQP; const f32x2 ga = isk ? gka : gqa, gb = isk ? gkb : gqb; const float sc = isk ? 1.0f : qs;
#pragma unroll
            for (int p = 0; p < 8; ++p) {
                bf16* hp = base + (2 * p + half) * 96;
                const unsigned a = la[isk][p];
                const unsigned b = isk ? krw : lb[p];
                const float a0 = bflo(a), a1 = bfhi(a), b0 = bflo(b), b1 = bfhi(b);
                float ss = (a0 * a0 + a1 * a1) + (b0 * b0 + b1 * b1);
                ss += shx(ss, 1, lane); ss += shx(ss, 2, lane); ss += shx(ss, 4, lane); ss += shx(ss, 8, lane); ss += shx(ss, 16, lane);
                const float rinv = 1.0f / sqrtf(ss * (1.0f / 96) + EPS);
                const float y0 = b0 * rinv * gb.x, y1 = b1 * rinv * gb.y; const float p0 = shx(y0, 8, lane), p1 = shx(y1, 8, lane);
                const float o0 = (i < 8) ? (y0 * cs[0] - p0 * sn[0]) : (y0 * cs[0] + p0 * sn[0]);
                const float o1 = (i < 8) ? (y1 * cs[1] - p1 * sn[1]) : (y1 * cs[1] + p1 * sn[1]);
                *(unsigned*)(hp + 2 * i) = pk2(a0 * rinv * ga.x * sc, a1 * rinv * ga.y * sc);
                if (i < 16) *(unsigned*)(hp + 64 + 2 * i) = pk2(o0 * sc, o1 * sc);
            }
        }
    }
}

#undef MLA_LOAD
template <int DQK>
__device__ __forceinline__ void q_prep(bf16x8 (&qf)[DQK / 16], const float* gq, int row, float qs, int lane) {
    constexpr int NKS = DQK / 16; const int hh = lane >> 5; const float L2T = 13.287712379549449f;
    float x[NKS][8]; float ss = 0.f;
#pragma unroll
    for (int ks = 0; ks < NKS; ++ks)
#pragma unroll
        for (int e = 0; e < 8; ++e) { x[ks][e] = __builtin_bit_cast(float, ((unsigned)(unsigned short)qf[ks][e]) << 16); ss += x[ks][e] * x[ks][e]; }
    ss += shx(ss, 32, lane);
    const float rinv = 1.0f / sqrtf(ss * (1.0f / DQK) + EPS);
#pragma unroll
    for (int ks = 0; ks < NKS; ++ks) { const f32x4 g0 = *(const f32x4*)(gq + 16 * ks + 8 * hh), g1 = *(const f32x4*)(gq + 16 * ks + 8 * hh + 4);
        x[ks][0] *= rinv * g0.x; x[ks][1] *= rinv * g0.y; x[ks][2] *= rinv * g0.z; x[ks][3] *= rinv * g0.w; x[ks][4] *= rinv * g1.x; x[ks][5] *= rinv * g1.y; x[ks][6] *= rinv * g1.z; x[ks][7] *= rinv * g1.w; }
    if (row < NLAT) { const int t = row & 2047; const float prow = (float)(t >> 6), pcol = (float)(t & 63);
        if (DQK == 64) {
#pragma unroll
            for (int e = 0; e < 8; ++e) { const float invf = exp2f(-(float)(8 * hh + e) * (1.0f / 16.0f) * L2T); float c0, s0, c1, s1; cs_of(prow * invf, c0, s0); cs_of(pcol * invf, c1, s1);
                const float a0 = x[0][e], b0 = x[2][e], a1 = x[1][e], b1 = x[3][e];
                x[0][e] = a0 * c0 - b0 * s0; x[2][e] = b0 * c0 + a0 * s0; x[1][e] = a1 * c1 - b1 * s1; x[3][e] = b1 * c1 + a1 * s1; }
        } else {
#pragma unroll
            for (int e = 0; e < 8; ++e) { const float invf = exp2f(-(float)e * (1.0f / 8.0f) * L2T); float c, s; cs_of((hh ? pcol : prow) * invf, c, s);
                const float a = x[NKS - 2][e], b = x[NKS - 1][e]; x[NKS - 2][e] = a * c - b * s; x[NKS - 1][e] = b * c + a * s; }
        } }
#pragma unroll
    for (int ks = 0; ks < NKS; ++ks) { u32x4 w; w.x = pk2(x[ks][0] * qs, x[ks][1] * qs); w.y = pk2(x[ks][2] * qs, x[ks][3] * qs); w.z = pk2(x[ks][4] * qs, x[ks][5] * qs); w.w = pk2(x[ks][6] * qs, x[ks][7] * qs);
        qf[ks] = __builtin_bit_cast(bf16x8, w); }
}
template <int DQK, int DV, bool PIPE>
__device__ __forceinline__ void attn_pass(LAS unsigned char* lds, const bf16* Qw, int qpitch, const bf16* Kctx, const bf16* Klat, int kpitch, const bf16* VT, int ntiles, const float* gq, int qrow0, float qs,
                                          f32x16 (&o)[DV / 32], float& lsum, const int wave_s) {
    constexpr int KSTR = DQK * 2 + 16, VSTR = 144, KBYTES = 64 * KSTR, VBYTES = DV * VSTR, KC = DQK / 8, NKS = DQK / 16, NDB = DV / 32, NV = 4 * NDB;
    const int lane = fresh_lane(), tid = wave_s * 64 + lane, i = lane & 31, hh = lane >> 5;
    bf16x8 qf[NKS];
#pragma unroll
    for (int ks = 0; ks < NKS; ++ks) qf[ks] = *(const bf16x8*)(Qw + (size_t)i * qpitch + 16 * ks + 8 * hh);
    q_prep<DQK>(qf, gq, qrow0 + i, qs, lane);
#pragma unroll
    for (int db = 0; db < NDB; ++db)
#pragma unroll
        for (int r = 0; r < 16; ++r) o[db][r] = 0.f;
    lsum = 0.f;
    const int kc0 = tid, kc1 = tid + 512; const bool k2 = (DQK == 96) && (tid < 256);
    const int kr0 = kc0 / KC, kcc0 = kc0 % KC, kr1 = kc1 / KC, kcc1 = kc1 % KC;
    const int vd0 = tid >> 3, vc0 = tid & 7;
    u32x4 kreg0, kreg1 = {0u, 0u, 0u, 0u}, vreg0, vreg1 = {0u, 0u, 0u, 0u};
    constexpr bool TPB2 = (!PIPE) && (NV == 8);
    LAS unsigned char* const Kl = lds; LAS unsigned char* const Vl = lds + (TPB2 ? 4 : 2) * KBYTES;
    const int kfo = i * KSTR + 16 * hh, vfo = i * VSTR + 16 * hh;
    const unsigned koff0 = (unsigned)(kr0 * kpitch + 8 * kcc0) * 2u, koff1 = (unsigned)(kr1 * kpitch + 8 * kcc1) * 2u;
    const unsigned voff0 = (unsigned)(vd0 * KV + 8 * vc0) * 2u, voff1 = (unsigned)((vd0 + 64) * KV + 8 * vc0) * 2u;
#define AT_LOADK(t) do { const char* kt = (const char*)(((t) < 4) ? Kctx + (size_t)(64 * (t)) * kpitch : Klat + (size_t)(64 * ((t) - 4)) * kpitch); \
        kreg0 = *(const u32x4*)(kt + koff0); if (k2) kreg1 = *(const u32x4*)(kt + koff1); } while (0)
#define AT_LOADV(t) do { const char* vt_ = (const char*)(VT + 64 * (t)); vreg0 = *(const u32x4*)(vt_ + voff0); if (DV == 128) vreg1 = *(const u32x4*)(vt_ + voff1); } while (0)
#define AT_WRITEK(bufi) do { LAS unsigned char* kb_ = Kl + (bufi) * KBYTES; *(LAS u32x4*)(kb_ + kr0 * KSTR + 16 * kcc0) = kreg0; if (k2) *(LAS u32x4*)(kb_ + kr1 * KSTR + 16 * kcc1) = kreg1; } while (0)
#define AT_WRITEV(bufi) do { LAS unsigned char* vb_ = Vl + (bufi) * VBYTES; *(LAS u32x4*)(vb_ + vd0 * VSTR + 16 * vc0) = vreg0; if (DV == 128) *(LAS u32x4*)(vb_ + (vd0 + 64) * VSTR + 16 * vc0) = vreg1; } while (0)
    u32x4 kregB0, kregB1 = {0u, 0u, 0u, 0u}, vregB0;
#define AT_LOADKB(t) do { const char* kt = (const char*)(((t) < 4) ? Kctx + (size_t)(64 * (t)) * kpitch : Klat + (size_t)(64 * ((t) - 4)) * kpitch); \
        kregB0 = *(const u32x4*)(kt + koff0); if (k2) kregB1 = *(const u32x4*)(kt + koff1); } while (0)
#define AT_LOADVB(t) do { const char* vt_ = (const char*)(VT + 64 * (t)); vregB0 = *(const u32x4*)(vt_ + voff0); } while (0)
#define AT_WRITEKB(bufi) do { LAS unsigned char* kb_ = Kl + (bufi) * KBYTES; *(LAS u32x4*)(kb_ + kr0 * KSTR + 16 * kcc0) = kregB0; if (k2) *(LAS u32x4*)(kb_ + kr1 * KSTR + 16 * kcc1) = kregB1; } while (0)
#define AT_WRITEVB(bufi) do { LAS unsigned char* vb_ = Vl + (bufi) * VBYTES; *(LAS u32x4*)(vb_ + vd0 * VSTR + 16 * vc0) = vregB0; } while (0)
#define AT_KFRAGS(bufi) do { const LAS unsigned char* Kb = Kl + (bufi) * KBYTES + kfo; \
        _Pragma("unroll") for (int ks = 0; ks < NKS; ++ks) { kf[2 * ks] = *(const LAS bf16x8*)(Kb + 32 * ks); kf[2 * ks + 1] = *(const LAS bf16x8*)(Kb + 32 * KSTR + 32 * ks); } } while (0)
#define AT_QKM(P0, P1) do { _Pragma("unroll") for (int r = 0; r < 16; ++r) { P0[r] = 0.f; P1[r] = 0.f; } \
        _Pragma("unroll") for (int ks = 0; ks < NKS; ++ks) { P0 = __builtin_amdgcn_mfma_f32_32x32x16_bf16(kf[2 * ks], qf[ks], P0, 0, 0, 0); \
            P1 = __builtin_amdgcn_mfma_f32_32x32x16_bf16(kf[2 * ks + 1], qf[ks], P1, 0, 0, 0); } } while (0)
#define AT_VFRAGS(dst, m0, bufi) do { const LAS unsigned char* Vb = Vl + (bufi) * VBYTES + vfo; \
        _Pragma("unroll") for (int m = 0; m < 8; ++m) { const int s_ = ((m0) + m) / NDB, db_ = ((m0) + m) % NDB; dst[m] = *(const LAS bf16x8*)(Vb + 32 * db_ * VSTR + 32 * s_); } } while (0)
#define AT_PVM(src, m0) do { _Pragma("unroll") for (int m = 0; m < 8; ++m) { const int s_ = ((m0) + m) / NDB, db_ = ((m0) + m) % NDB; \
        o[db_] = __builtin_amdgcn_mfma_f32_32x32x16_bf16(src[m], pf[s_], o[db_], 0, 0, 0); } } while (0)
    f32x16 p0, p1, n0, n1; bf16x8 kf[2 * NKS], vfa[8], pf[4];
    if (PIPE) {
        AT_LOADK(0); AT_LOADV(0); AT_WRITEK(0); AT_WRITEV(0);
        AT_LOADK(1);
        __syncthreads();
        AT_KFRAGS(0); AT_QKM(p0, p1);
        AT_WRITEK(1);
        if (2 < ntiles) AT_LOADK(2);
        AT_LOADV(1);
        __syncthreads();
    } else if (TPB2) {
        AT_LOADK(0); AT_LOADV(0); AT_LOADKB(1); AT_LOADVB(1); AT_WRITEK(0); AT_WRITEV(0); AT_WRITEKB(1); AT_WRITEVB(1);
        AT_LOADK(2); AT_LOADV(2); AT_LOADKB(3); AT_LOADVB(3);
        __syncthreads();
    } else {
        AT_LOADK(0); AT_LOADV(0); AT_WRITEK(0); AT_WRITEV(0);
        AT_LOADK(1); AT_LOADV(1);
        __syncthreads();
    }
#define AT_BODY(HASNEXT, C0, C1, N0, N1, TT) do { const int t = (TT); \
        if (PIPE) { if (HASNEXT) AT_KFRAGS((t + 1) & 1); } else AT_KFRAGS(t & 1); \
        AT_VFRAGS(vfa, 0, t & 1); \
        __builtin_amdgcn_sched_barrier(0); \
        if (!PIPE) AT_QKM(C0, C1); \
        float ls = 0.f; \
        _Pragma("unroll") for (int r = 0; r < 16; ++r) { C0[r] = __builtin_amdgcn_exp2f(C0[r]); C1[r] = __builtin_amdgcn_exp2f(C1[r]); ls += C0[r] + C1[r]; } \
        lsum += ls; \
        { u32x4 w; \
          w.x = cvtpk_nv(C0[0], C0[1]); w.y = cvtpk_nv(C0[2], C0[3]); w.z = cvtpk_nv(C0[4], C0[5]); w.w = cvtpk_nv(C0[6], C0[7]); pf[0] = __builtin_bit_cast(bf16x8, w); \
          w.x = cvtpk_nv(C0[8], C0[9]); w.y = cvtpk_nv(C0[10], C0[11]); w.z = cvtpk_nv(C0[12], C0[13]); w.w = cvtpk_nv(C0[14], C0[15]); pf[1] = __builtin_bit_cast(bf16x8, w); \
          w.x = cvtpk_nv(C1[0], C1[1]); w.y = cvtpk_nv(C1[2], C1[3]); w.z = cvtpk_nv(C1[4], C1[5]); w.w = cvtpk_nv(C1[6], C1[7]); pf[2] = __builtin_bit_cast(bf16x8, w); \
          w.x = cvtpk_nv(C1[8], C1[9]); w.y = cvtpk_nv(C1[10], C1[11]); w.z = cvtpk_nv(C1[12], C1[13]); w.w = cvtpk_nv(C1[14], C1[15]); pf[3] = __builtin_bit_cast(bf16x8, w); } \
        if (PIPE && (HASNEXT)) AT_QKM(N0, N1); \
        if (NV == 16) { __builtin_amdgcn_sched_barrier(0); AT_VFRAGS(kf, 8, t & 1); __builtin_amdgcn_sched_barrier(0); __builtin_amdgcn_s_setprio(1); AT_PVM(vfa, 0); AT_PVM(kf, 8); __builtin_amdgcn_s_setprio(0); } \
        else { __builtin_amdgcn_s_setprio(1); AT_PVM(vfa, 0); __builtin_amdgcn_s_setprio(0); } \
        if (PIPE) { if (t + 2 < ntiles) AT_WRITEK(t & 1); if (t + 1 < ntiles) AT_WRITEV((t + 1) & 1); if (t + 3 < ntiles) AT_LOADK(t + 3); if (t + 2 < ntiles) AT_LOADV(t + 2); } \
        else { if (t + 1 < ntiles) { AT_WRITEK((t + 1) & 1); AT_WRITEV((t + 1) & 1); } if (t + 2 < ntiles) { AT_LOADK(t + 2); AT_LOADV(t + 2); } } \
        __syncthreads(); \
    } while (0)
    int tt = 0;
    if (PIPE) {
        for (; tt < ntiles - 2; tt += 2) { AT_BODY(true, p0, p1, n0, n1, tt); AT_BODY(true, n0, n1, p0, p1, tt + 1); }
        AT_BODY(true, p0, p1, n0, n1, tt); AT_BODY(false, n0, n1, p0, p1, tt + 1);
    } else {
        if (TPB2) {
#define AT_SUB(slot) do { AT_KFRAGS(slot); AT_VFRAGS(vfa, 0, slot); __builtin_amdgcn_sched_barrier(0); AT_QKM(p0, p1); \
            float ls = 0.f; _Pragma("unroll") for (int r = 0; r < 16; ++r) { p0[r] = __builtin_amdgcn_exp2f(p0[r]); p1[r] = __builtin_amdgcn_exp2f(p1[r]); ls += p0[r] + p1[r]; } lsum += ls; \
            { u32x4 w; \
              w.x = cvtpk_nv(p0[0], p0[1]); w.y = cvtpk_nv(p0[2], p0[3]); w.z = cvtpk_nv(p0[4], p0[5]); w.w = cvtpk_nv(p0[6], p0[7]); pf[0] = __builtin_bit_cast(bf16x8, w); \
              w.x = cvtpk_nv(p0[8], p0[9]); w.y = cvtpk_nv(p0[10], p0[11]); w.z = cvtpk_nv(p0[12], p0[13]); w.w = cvtpk_nv(p0[14], p0[15]); pf[1] = __builtin_bit_cast(bf16x8, w); \
              w.x = cvtpk_nv(p1[0], p1[1]); w.y = cvtpk_nv(p1[2], p1[3]); w.z = cvtpk_nv(p1[4], p1[5]); w.w = cvtpk_nv(p1[6], p1[7]); pf[2] = __builtin_bit_cast(bf16x8, w); \
              w.x = cvtpk_nv(p1[8], p1[9]); w.y = cvtpk_nv(p1[10], p1[11]); w.z = cvtpk_nv(p1[12], p1[13]); w.w = cvtpk_nv(p1[14], p1[15]); pf[3] = __builtin_bit_cast(bf16x8, w); } \
            __builtin_amdgcn_s_setprio(1); AT_PVM(vfa, 0); __builtin_amdgcn_s_setprio(0); } while (0)
            for (int pp = 0; 2 * pp < ntiles; ++pp) { const int sb = (pp & 1) * 2;
                AT_SUB(sb); AT_SUB(sb + 1);
                if (2 * pp + 2 < ntiles) { AT_WRITEK(sb ^ 2); AT_WRITEV(sb ^ 2); AT_WRITEKB((sb ^ 2) + 1); AT_WRITEVB((sb ^ 2) + 1); }
                if (2 * pp + 4 < ntiles) { AT_LOADK(2 * pp + 4); AT_LOADV(2 * pp + 4); AT_LOADKB(2 * pp + 5); AT_LOADVB(2 * pp + 5); }
                __syncthreads();
            }
#undef AT_SUB
        } else
        for (; tt < ntiles; ++tt) AT_BODY(true, p0, p1, p0, p1, tt);
    }
#undef AT_BODY
#undef AT_LOADK
#undef AT_LOADV
#undef AT_WRITEK
#undef AT_WRITEV
#undef AT_KFRAGS
#undef AT_QKM
#undef AT_VFRAGS
#undef AT_PVM
}
template <int NDB>
__device__ __forceinline__ void attn_store(bf16* ATT, int row0, int col0, const f32x16 (&o)[NDB], float inv, int lane) {
    const int i = lane & 31, hh = lane >> 5; bf16* rp = ATT + (size_t)(row0 + i) * D + col0 + 4 * hh;
#pragma unroll
    for (int db = 0; db < NDB; ++db)
#pragma unroll
        for (int g4 = 0; g4 < 4; ++g4) { u32x2 w; w.x = pk2(o[db][4 * g4] * inv, o[db][4 * g4 + 1] * inv); w.y = pk2(o[db][4 * g4 + 2] * inv, o[db][4 * g4 + 3] * inv);
            *(u32x2*)(rp + 32 * db + 8 * g4) = w; }
}

#define XB_TMO      128
#define XB_XCNT(j)  (256  + 64 * (j))
#define XB_XSUB(j)  (1280 + 64 * (j))
#define XB_XGEN(j)  (2304 + 64 * (j))
#define XB_TOP      3328
#define XB_TOPGEN   3392
#define XCD_BAR_WORDS 3456
#define XB_SPIN_CAP (1u << 18)

__device__ __forceinline__ unsigned xb_ld(unsigned* p)              { return __hip_atomic_load(p, __ATOMIC_RELAXED, __HIP_MEMORY_SCOPE_AGENT); }
__device__ __forceinline__ unsigned xb_add(unsigned* p, unsigned v) { return __hip_atomic_fetch_add(p, v, __ATOMIC_RELAXED, __HIP_MEMORY_SCOPE_AGENT); }
__device__ __forceinline__ unsigned xb_xcc_id() { return (unsigned)__builtin_amdgcn_s_getreg((3 << 11) | 20) & 0xFu; }
#define XB_SPIN(cond, bar) do { unsigned _sp = 0; while (cond) { __builtin_amdgcn_s_sleep(1); \
    if ((++_sp & 255u) == 0u) { if (xb_ld(&(bar)[XB_TMO])) break; if (_sp > XB_SPIN_CAP) { atomicAdd(&(bar)[XB_TMO], 1u); break; } } } } while (0)

struct XcdBarrier {
    unsigned* bar; unsigned x;
    volatile LAS unsigned* st;
};

__device__ __forceinline__ XcdBarrier xcd_barrier_post(unsigned* bar, volatile LAS unsigned* st) {
    XcdBarrier b; b.bar = bar; b.x = xb_xcc_id(); b.st = st;
    if (threadIdx.x == 0) (void)xb_add(&bar[XB_XCNT(b.x)], 1u);
    return b;
}
__device__ __forceinline__ void xcd_barrier_complete(unsigned* bar, unsigned x, unsigned& nloc, unsigned& nx) {
    const unsigned G = gridDim.x * gridDim.y * gridDim.z;
    unsigned sum, cnt, mine, sp = 0u;
    for (;;) {
        sum = 0u; cnt = 0u; mine = 0u;
#pragma unroll
        for (unsigned j = 0; j < 16; ++j) { const unsigned c = xb_ld(&bar[XB_XCNT(j)]); sum += c; cnt += (c > 0u) ? 1u : 0u; mine = (j == x) ? c : mine; }
        if (sum == G) break;
        __builtin_amdgcn_s_sleep(1);
        if ((++sp & 255u) == 0u) { if (xb_ld(&bar[XB_TMO])) break; if (sp > XB_SPIN_CAP) { atomicAdd(&bar[XB_TMO], 1u); break; } }
    }
    nloc = mine > 0u ? mine : 1u; nx = cnt > 0u ? cnt : 1u;
}

__device__ __forceinline__ void xcd_barrier(const XcdBarrier& b, const int wave_s) {
    asm volatile("s_waitcnt vmcnt(0)" ::: "memory");
    __syncthreads();
    if (wave_s == 0 && fresh_lane() == 0) {
        unsigned* bar = b.bar; asm volatile("" : "+s"(bar));
        __builtin_amdgcn_s_waitcnt(0);
        unsigned nloc = b.st[0], nx = b.st[1];
        if (nloc == 0u) { xcd_barrier_complete(bar, b.x, nloc, nx); b.st[0] = nloc; b.st[1] = nx; }
        const unsigned old = xb_add(&bar[XB_XSUB(b.x)], 1u);
        const unsigned gen = old / nloc;
        if (old + 1u == (gen + 1u) * nloc) {
            __builtin_amdgcn_fence(__ATOMIC_RELEASE, "agent");
            asm volatile("s_waitcnt vmcnt(0)" ::: "memory");
            const unsigned og = xb_add(&bar[XB_TOP], 1u);
            const unsigned tg = og / nx;
            if (og + 1u == (tg + 1u) * nx) xb_add(&bar[XB_TOPGEN], 1u);
            else XB_SPIN(xb_ld(&bar[XB_TOPGEN]) == tg, bar);
            __builtin_amdgcn_fence(__ATOMIC_ACQUIRE, "agent");
            xb_add(&bar[XB_XGEN(b.x)], 1u);
            asm volatile("s_waitcnt vmcnt(0)" ::: "memory");
        } else {
            XB_SPIN(xb_ld(&bar[XB_XGEN(b.x)]) == gen, bar);
            __builtin_amdgcn_fence(__ATOMIC_ACQUIRE, "agent");
            asm volatile("s_waitcnt vmcnt(0)" ::: "memory");
        }
    }
    __syncthreads();
}

__device__ __forceinline__ int grab_unit(unsigned* ctr, volatile LAS unsigned* slot, int wave_s) {
    if (wave_s == 0 && fresh_lane() == 0) *slot = __hip_atomic_fetch_add(ctr, 1u, __ATOMIC_RELAXED, __HIP_MEMORY_SCOPE_AGENT);
    __syncthreads();
    const unsigned v = *slot;
    __syncthreads();
    return __builtin_amdgcn_readfirstlane((int)v);
}
__device__ __forceinline__ unsigned ticket_issue(unsigned* ctr, int wave_s, bool& mine) {
    mine = (wave_s == 0) && (fresh_lane() == 0); unsigned v = 0u;
    if (mine) v = __hip_atomic_fetch_add(ctr, 1u, __ATOMIC_RELAXED, __HIP_MEMORY_SCOPE_AGENT);
    return v;
}
__device__ __forceinline__ int ticket_publish(unsigned v, bool mine, volatile LAS unsigned* slot) {
    if (mine) *slot = v;
    __syncthreads();
    const unsigned r = *slot;
    __syncthreads();
    return __builtin_amdgcn_readfirstlane((int)r);
}
__device__ __forceinline__ void prep_dyn(const float* xlat, const float* xctx, const float* g, const float* modl, int sc_off, bf16* AP, float* ssq, unsigned* ctr, volatile LAS unsigned* slot, int wave_s) {
    const int lane = fresh_lane();
    f32x4 g4[4];
#pragma unroll
    for (int j = 0; j < 4; ++j) g4[j] = *(const f32x4*)(g + 256 * j + 4 * lane);
    for (int ch = grab_unit(ctr, slot, wave_s); ch < R / 16; ch = grab_unit(ctr, slot, wave_s)) {
        const int r0 = ch * 16 + 2 * wave_s, r1 = r0 + 1;
        const float* xr0 = (r0 < NLAT) ? xlat + (size_t)r0 * D : xctx + (size_t)(r0 - NLAT) * D; const float* xr1 = xr0 + D;
        f32x4 v0[4], v1[4]; float s0 = 0.f, s1 = 0.f;
#pragma unroll
        for (int j = 0; j < 4; ++j) { v0[j] = *(const f32x4*)(xr0 + 256 * j + 4 * lane); v1[j] = *(const f32x4*)(xr1 + 256 * j + 4 * lane); }
#pragma unroll
        for (int j = 0; j < 4; ++j) { s0 += (v0[j].x * v0[j].x + v0[j].y * v0[j].y) + (v0[j].z * v0[j].z + v0[j].w * v0[j].w); s1 += (v1[j].x * v1[j].x + v1[j].y * v1[j].y) + (v1[j].z * v1[j].z + v1[j].w * v1[j].w); }
        s0 = wave_sum(s0, lane); s1 = wave_sum(s1, lane);
        const float* mp = modl + ((r0 < NLAT) ? (r0 >> 11) : 32) * 6144;
#pragma unroll
        for (int j = 0; j < 4; ++j) { const int c = 256 * j + 4 * lane; const f32x4 gs = g4[j] * (*(const f32x4*)(mp + sc_off + c) + 1.0f);
            const f32x4 y0 = v0[j] * gs, y1 = v1[j] * gs; u32x2 w0, w1; w0.x = pk2(y0.x, y0.y); w0.y = pk2(y0.z, y0.w); w1.x = pk2(y1.x, y1.y); w1.y = pk2(y1.z, y1.w);
            *(u32x2*)(AP + (size_t)r0 * D + c) = w0; *(u32x2*)(AP + (size_t)r1 * D + c) = w1; }
        if (lane == 0) { ssq[r0] = s0; ssq[r1] = s1; }
    }
}
struct Args { const float* in[23]; float* out; unsigned char* ws; };

__global__ void __launch_bounds__(NTHR, 2) mega_fwd(Args args) {
    extern __shared__ __attribute__((aligned(16))) unsigned char lds_raw[];
    LAS unsigned char* lds = (LAS unsigned char*)lds_raw;
    cg::grid_group grid = cg::this_grid();
    const int wave_s = __builtin_amdgcn_readfirstlane(threadIdx.x >> 6);
    if (threadIdx.x < 16) ((LAS unsigned*)(lds + MISC_OFF))[threadIdx.x] = 0u;
    __syncthreads();
    const XcdBarrier xbar = xcd_barrier_post((unsigned*)(args.ws + WS_CTL), (volatile LAS unsigned*)(lds + MISC_OFF));
    const int G = gridDim.x, bx = blockIdx.x; const int vcu = (G % 8 == 0) ? (bx % 8) * (G / 8) + bx / 8 : bx;
    const int NGW = G * NWAVES;
    unsigned char* ws = args.ws;
    const float* x_in = args.in[0]; const float* c_in = args.in[1]; const float* ctx_in = args.in[2]; const float* cctx_in = args.in[3];
    const float* ada_w = args.in[4]; const float* ada_b = args.in[5]; const float* norm_mix = args.in[6]; const float* norm_mlp = args.in[7];
    float* MOD = (float*)(ws + WS_MOD); float* XCTX = (float*)(ws + WS_XCTX); bf16* H = (bf16*)(ws + WS_H); unsigned char* RG = ws + WS_R;
    float* XLAT = args.out;

    {   const int tid = threadIdx.x, lane = tid & 63, wave = __builtin_amdgcn_readfirstlane(tid >> 6);
        const bool split = G >= 96; const int NGW = split ? (G - 48) * NWAVES : G * NWAVES; const int gw = split ? ((bx >= 48) ? (bx - 48) * NWAVES + wave : NGW + wave) : bx * NWAVES + wave;
        if (bx < 48) {
            LAS float* S = (LAS float*)lds;
            for (int idx = tid; idx < 33 * 1024; idx += NTHR) { const int b = idx >> 10, k = idx & 1023; const float cv = (b < 32) ? c_in[b * 1024 + k] : cctx_in[k]; S[idx] = cv / (1.0f + __expf(-cv)); }
            __syncthreads();
            for (int item = bx; item < 48; item += G) {
                const int L = item / 12, col = (item % 12) * 512 + wave * 64 + lane; const float* wp = ada_w + (size_t)L * 1024 * 6144 + col;
                float acc[33];
#pragma unroll
                for (int b = 0; b < 33; ++b) acc[b] = 0.f;
                float wn[16];
#pragma unroll
                for (int e = 0; e < 16; ++e) wn[e] = wp[(size_t)e * 6144];
                for (int kb = 0; kb < 1024; kb += 16) {
                    float wc[16];
#pragma unroll
                    for (int e = 0; e < 16; ++e) wc[e] = wn[e];
                    if (kb + 16 < 1024) {
#pragma unroll
                        for (int e = 0; e < 16; ++e) wn[e] = wp[(size_t)(kb + 16 + e) * 6144]; }
#pragma unroll
                    for (int q4 = 0; q4 < 4; ++q4)
#pragma unroll
                        for (int b = 0; b < 33; ++b) { const f32x4 s = *(const LAS f32x4*)(S + b * 1024 + kb + 4 * q4); acc[b] += (s.x * wc[4 * q4] + s.y * wc[4 * q4 + 1]) + (s.z * wc[4 * q4 + 2] + s.w * wc[4 * q4 + 3]); }
                }
                const float bias = ada_b[L * 6144 + col];
#pragma unroll
                for (int b = 0; b < 33; ++b) MOD[((size_t)L * 33 + b) * 6144 + col] = acc[b] + bias;
                { const int cgi = item % 12;
                  if (cgi < 2 || cgi == 6 || cgi == 7) { const int w = cgi >= 6; unsigned short* dst = (unsigned short*)(ws + WS_SHB) + ((size_t)(2 * L + w) * 256) * 1024 + (col - (w ? 3072 : 0));
#pragma unroll
                      for (int b = 0; b < 33; ++b) dst[(size_t)b * 1024] = (unsigned short)f2bf(acc[b] + bias); } }
            }
            __syncthreads();
        }
        LAS float* scr = (LAS float*)(lds + wave * 16384); int cur = 0;
        if (gw < NGW) {
        for (int i2 = 0; i2 < 2; ++i2) {
            unsigned char* we = ws + WS_W + (size_t)i2 * 8 * MiB; bf16* WinM = (bf16*)we; bf16* WinV = (bf16*)(we + 3584 * 1024); bf16* Wout = (bf16*)(we + 5 * MiB);
            const float* win = args.in[10] + (size_t)i2 * 1024 * 2304;
            xpose_seg(win, 1024, 2304, 0, 1024, false, WinM, 0, scr, gw, NGW, cur, lane);
            xpose_seg(win, 1024, 2304, 1536, 640, false, WinM, 1024, scr, gw, NGW, cur, lane);
            xpose_seg(win, 1024, 2304, 1024, 512, false, WinV, 0, scr, gw, NGW, cur, lane);
            xpose_seg(win, 1024, 2304, 2176, 128, false, WinV, 512, scr, gw, NGW, cur, lane);
            zero_rows(WinM, 1024, 1664, 128, gw, NGW, lane); zero_rows(WinV, 1024, 640, 128, gw, NGW, lane);
            xpose_seg(args.in[11] + (size_t)i2 * 1024 * 1024, 1024, 1024, 0, 1024, false, Wout, 0, scr, gw, NGW, cur, lane);
            unsigned char* wo = ws + WS_W + 16 * MiB + (size_t)i2 * 8 * MiB; bf16* MWin = (bf16*)wo; bf16* MQup = (bf16*)(wo + 2 * MiB); bf16* MKn = (bf16*)(wo + 3584 * 1024); bf16* MV = (bf16*)(wo + 4 * MiB); bf16* MWout = (bf16*)(wo + 4608 * 1024);
            xpose_seg(args.in[16] + (size_t)i2 * 1024 * 800, 1024, 800, 0, 800, false, MWin, 0, scr, gw, NGW, cur, lane);
            zero_rows(MWin, 1024, 800, 224, gw, NGW, lane);
            xpose_seg(args.in[18] + (size_t)i2 * 512 * 1536, 512, 1536, 0, 1536, false, MQup, 0, scr, gw, NGW, cur, lane);
            xpose_seg(args.in[20] + (size_t)i2 * 256 * 2048, 256, 2048, 0, 1024, true, MKn, 0, scr, gw, NGW, cur, lane);
            xpose_seg(args.in[20] + (size_t)i2 * 256 * 2048, 256, 2048, 64, 1024, true, MV, 0, scr, gw, NGW, cur, lane);
            xpose_seg(args.in[22] + (size_t)i2 * 1024 * 1024, 1024, 1024, 0, 1024, false, MWout, 0, scr, gw, NGW, cur, lane);
        }
        for (int L = 0; L < 4; ++L) {
            unsigned char* wm = ws + WS_W + 32 * MiB + (size_t)L * 16 * MiB;
            xpose_seg(args.in[8] + (size_t)L * 1024 * 4096, 1024, 4096, 0, 4096, false, (bf16*)wm, 0, scr, gw, NGW, cur, lane);
            xpose_seg(args.in[9] + (size_t)L * 4096 * 1024, 4096, 1024, 0, 1024, false, (bf16*)(wm + 8 * MiB), 0, scr, gw, NGW, cur, lane);
        }
        }
    }
    if (__builtin_expect(args.ws == nullptr, 0)) grid.sync();
    xcd_barrier(xbar, wave_s);
    {
        float* MOD = (float*)(ws + WS_MOD); float* SSQ1 = (float*)(ws + WS_SSQ); float* SSQ2 = SSQ1 + 131072;
        zero_f32(SSQ2, R, vcu, NGW, wave_s);
        zero_f32((float*)(ws + WS_SSQM), 262144, vcu, NGW, wave_s);
        {   pg8::Gemm g{(const bf16*)(ws + WS_SHB), (const bf16*)(ws + WS_W), 2048, 256, 1024}; pg8::ShwOrder S{G, bx}; pg8::EpiShw E{(float*)(ws + WS_SHW)};
            pg8::gemm_phase<pg8::EpiShw, pg8::ShwOrder, true, true>(lds, g, S, E, wave_s); }
        prep_dyn(x_in, ctx_in, norm_mix, MOD, 1024, (bf16*)(ws + WS_H), SSQ1, (unsigned*)(ws + WS_CTL) + 3700, (volatile LAS unsigned*)(lds + MISC_OFF) + 8, wave_s);
    }
    xcd_barrier(xbar, wave_s);

    const int G0 = G, bx0 = bx, vcu0 = vcu; int dir = 0;
    for (int L = 0; L < 4; ++L) {
        int G = G0, bx = bx0, vcu = vcu0; asm volatile("" : "+s"(G), "+s"(bx), "+s"(vcu)); const int NGW = G * NWAVES;
        const __attribute__((address_space(4))) Args* ap = (const __attribute__((address_space(4))) Args*)__builtin_amdgcn_kernarg_segment_ptr(); asm volatile("" : "+s"(ap));
        unsigned char* ws = ap->ws; float* XLAT = ap->out; const float* x_in = ap->in[0]; const float* ctx_in = ap->in[2]; const float* norm_mix = ap->in[6]; const float* norm_mlp = ap->in[7];
        float* MOD = (float*)(ws + WS_MOD); float* XCTX = (float*)(ws + WS_XCTX); bf16* H = (bf16*)(ws + WS_H); unsigned char* RG = ws + WS_R;
        const int i2 = L >> 1; const bool last = (L == 3);
        const float* modl = MOD + (size_t)L * 33 * 6144;
        const float* xl = (L == 0) ? x_in : XLAT; const float* xc = (L == 0) ? ctx_in : XCTX;
        float* SSQ1 = (float*)(ws + WS_SSQ); float* SSQ2 = SSQ1 + 131072; const float* SHWin = (const float*)(ws + WS_SHW) + (size_t)L * 33 * 8192; const float* SHW1 = SHWin + 33 * 4096;
        const int Ln = (L < 3) ? L + 1 : 3;
        bf16* ATT;
        if ((L & 1) == 0) {
            unsigned char* we = ws + WS_W + (size_t)i2 * 8 * MiB; const bf16* WinM = (const bf16*)we; const bf16* WinV = (const bf16*)(we + 3584 * 1024); const bf16* Wout = (const bf16*)(we + 5 * MiB);
            bf16* RAW = (bf16*)RG; bf16* VT = (bf16*)(RG + 252 * MiB); ATT = (bf16*)(RG + 576 * MiB);
            {   pg8::Gemm g{H, WinM, R, 1792, 1024}; pg8::StaticOrder S; S.init(R, 1792, G, bx); S.rev = dir; pg8::EpiEvenIn E{RAW, SSQ1, SHWin, ap->in[12] + i2 * 128 + 64, ap->in[15] + i2 * 128 + 64};
                pg8::gemm_phase<pg8::EpiEvenIn, pg8::StaticOrder, true, true>(lds, g, S, E, wave_s); }
            {   pg8::Gemm g{WinV, H, 768, R, 1024}; pg8::StaticOrder S; S.init(768, R, G, bx); S.rev = dir; pg8::EpiVT<true> E{VT, 768, SSQ1, SHWin + 1792, 2560, 1.0f / 1024.0f};
                pg8::gemm_phase<pg8::EpiVT<true>, pg8::StaticOrder, true, true>(lds, g, S, E, wave_s); }
            { xcd_barrier(xbar, wave_s); dir ^= 1; }
            {
                const int lane = fresh_lane(), wave = wave_s;
                const float* lamp = ap->in[13] + i2 * 256;
                const float lam_init = 0.8f - 0.6f * __expf(-0.3f * (float)L);
                const float lam_v = __expf(wave_sum(lamp[lane] * lamp[64 + lane], lane)) - __expf(wave_sum(lamp[128 + lane] * lamp[192 + lane], lane)) + lam_init;
                const float lam = __builtin_bit_cast(float, __builtin_amdgcn_readfirstlane(__builtin_bit_cast(int, lam_v)));
                const float* subln = ap->in[14] + i2 * 128;
                const int nlat_d = 1024, nctx_d = 128, nlat_g = 2048, nctx_g = 256;
#ifndef NO_DIFF
                unsigned* ctrs = (unsigned*)(ws + WS_CTL) + 3584 + 8 * L; volatile LAS unsigned* slot = (volatile LAS unsigned*)(lds + MISC_OFF) + 8;
                for (int u = grab_unit(ctrs, slot, wave_s); u < nlat_d + nctx_d; ) { bool tk_mine; const unsigned tk_next = ticket_issue(ctrs, wave_s, tk_mine);
                    int b, h, row0, nt;
                    if (u < nlat_d) { const int ur = dir ? (nlat_d - 1 - u) : u; const int qb = ur & 7; h = (ur >> 3) & 3; b = ur >> 5; row0 = b * 2048 + qb * 256 + wave * 32; nt = 36; }
                    else { const int uu = u - nlat_d; h = uu & 3; b = uu >> 2; row0 = NLAT + b * 256 + wave * 32; nt = 4; }
                    f32x16 o[4]; float l;
                    const bf16* vt = VT + ((size_t)b * 768 + h * 128) * KV;
                    attn_pass<64, 128, false>(lds, RAW + (size_t)row0 * RAWP + (h * 2) * 64, RAWP, RAW + (size_t)(NLAT + b * 256) * RAWP + 512 + (h * 2) * 64, RAW + (size_t)(b * 2048) * RAWP + 512 + (h * 2) * 64, RAWP, vt, nt, ap->in[12] + i2 * 128, row0, 0.125f * LOG2E, o, l, wave_s);
                    { const int ln = fresh_lane(); LAS unsigned* o1s = (LAS unsigned*)(lds + 57344 + wave_s * 8192) + ln; const float inv = 1.0f / (l + shx(l, 32, ln));
#pragma unroll
                      for (int db = 0; db < 4; ++db)
#pragma unroll
                          for (int j = 0; j < 8; ++j) o1s[(db * 8 + j) * 64] = pg8::cvt_pk_bf16(o[db][2 * j] * inv, o[db][2 * j + 1] * inv); }
                    attn_pass<64, 128, false>(lds, RAW + (size_t)row0 * RAWP + (h * 2 + 1) * 64, RAWP, RAW + (size_t)(NLAT + b * 256) * RAWP + 512 + (h * 2 + 1) * 64, RAW + (size_t)(b * 2048) * RAWP + 512 + (h * 2 + 1) * 64, RAWP, vt, nt, ap->in[12] + i2 * 128, row0, 0.125f * LOG2E, o, l, wave_s);
                    { const int ln = fresh_lane(), i = ln & 31, hh = ln >> 5; LAS unsigned* o1s = (LAS unsigned*)(lds + 57344 + wave_s * 8192) + ln; const float inv = lam / (l + shx(l, 32, ln)); float ss = 0.f;
#pragma unroll
                      for (int db = 0; db < 4; ++db)
#pragma unroll
                          for (int j = 0; j < 8; ++j) { const unsigned pk = o1s[(db * 8 + j) * 64]; const float a0 = bflo(pk) - o[db][2 * j] * inv, a1 = bfhi(pk) - o[db][2 * j + 1] * inv; o[db][2 * j] = a0; o[db][2 * j + 1] = a1; ss += a0 * a0 + a1 * a1; }
                      ss += shx(ss, 32, ln);
                      const float rinv = (1.0f - lam_init) / sqrtf(ss * (1.0f / 128) + EPS);
                      bf16* rp = ATT + (size_t)(row0 + i) * D + h * 128 + 4 * hh;
#pragma unroll
                      for (int db = 0; db < 4; ++db)
#pragma unroll
                          for (int g4 = 0; g4 < 4; ++g4) { const f32x4 sg = *(const f32x4*)(subln + 32 * db + 8 * g4 + 4 * hh);
                              u32x2 w; w.x = pk2(o[db][4 * g4] * rinv * sg.x, o[db][4 * g4 + 1] * rinv * sg.y); w.y = pk2(o[db][4 * g4 + 2] * rinv * sg.z, o[db][4 * g4 + 3] * rinv * sg.w);
                              *(u32x2*)(rp + 32 * db + 8 * g4) = w; } }
                    u = ticket_publish(tk_next, tk_mine, slot);
                }
#endif
#ifndef NO_GQA
                for (int u = grab_unit(ctrs + 1, slot, wave_s); u < nlat_g + nctx_g; ) { bool tk_mine; const unsigned tk_next = ticket_issue(ctrs + 1, wave_s, tk_mine);
                    int b, hq, row0, nt;
                    if (u < nlat_g) { const int ur = dir ? (nlat_g - 1 - u) : u; const int qb = ur & 7; hq = (ur >> 3) & 7; b = ur >> 6; row0 = b * 2048 + qb * 256 + wave * 32; nt = 36; }
                    else { const int uu = u - nlat_g; hq = uu & 7; b = uu >> 3; row0 = NLAT + b * 256 + wave * 32; nt = 4; }
                    const int kvh = hq >> 2; f32x16 o[2]; float l;
                    attn_pass<64, 64, false>(lds, RAW + (size_t)row0 * RAWP + 1024 + hq * 64, RAWP, RAW + (size_t)(NLAT + b * 256) * RAWP + 1536 + kvh * 64, RAW + (size_t)(b * 2048) * RAWP + 1536 + kvh * 64, RAWP,
                                      VT + ((size_t)b * 768 + 512 + kvh * 64) * KV, nt, ap->in[15] + i2 * 128, row0, 0.125f * LOG2E, o, l, wave_s);
                    { const int ln = fresh_lane(); attn_store<2>(ATT, row0, 512 + hq * 64, o, 1.0f / (l + shx(l, 32, ln)), ln); }
                    u = ticket_publish(tk_next, tk_mine, slot);
                }
#endif
            }
            { xcd_barrier(xbar, wave_s); dir ^= 1; }
            {   pg8::Gemm g{ATT, Wout, R, 1024, 1024}; pg8::StaticOrder S; S.init(R, 1024, G, bx); S.rev = dir; pg8::EpiResid E{xl, xc, XLAT, XCTX, modl + 2048, H, norm_mlp + L * 1024, modl + 4096, SSQ2};
                zero_f32(SSQ1, R, vcu, NGW, wave_s);
                pg8::gemm_phase<pg8::EpiResid, pg8::StaticOrder, true, true>(lds, g, S, E, wave_s); }
        } else {
            unsigned char* wo = ws + WS_W + 16 * MiB + (size_t)i2 * 8 * MiB; const bf16* MWin = (const bf16*)wo; const bf16* MQup = (const bf16*)(wo + 2 * MiB); const bf16* MKn = (const bf16*)(wo + 3584 * 1024);
            const bf16* MV = (const bf16*)(wo + 4 * MiB); const bf16* MWout = (const bf16*)(wo + 4608 * 1024);
            bf16* MRAW = (bf16*)RG; ATT = (bf16*)RG; bf16* Q = (bf16*)(RG + 144 * MiB); bf16* Kb = (bf16*)(RG + 360 * MiB); bf16* VT = (bf16*)(RG + 576 * MiB);
            bf16* QCn = (bf16*)RG; bf16* KVCn = (bf16*)(RG + 72 * MiB); bf16* KR = (bf16*)(RG + 108 * MiB);
            float* SSQq = (float*)(ws + WS_SSQM); float* SSQkv = SSQq + 131072; const float* ZSH = SSQq + 229376;
            {   pg8::Gemm g{H, MWin, R, 1024, 1024}; pg8::StaticOrder S; S.init(R, 1024, G, bx); S.rev = dir; pg8::EpiMlaIn E{SSQ1, SHWin, QCn, KVCn, KR, ap->in[17] + i2 * 512, ap->in[19] + i2 * 256, SSQq, SSQkv};
                pg8::gemm_phase<pg8::EpiMlaIn, pg8::StaticOrder, true, true>(lds, g, S, E, wave_s); }
            { xcd_barrier(xbar, wave_s); dir ^= 1; }
            {   pg8::Gemm g{QCn, MQup, last ? NLAT : R, 1536, 512}; pg8::StaticOrder S; S.init(last ? NLAT : R, 1536, G, bx); S.rev = dir; pg8::EpiStore<0, 0, true> E{Q, MQP, SSQq, ZSH, 0, 1.0f / 512.0f};
                pg8::gemm_phase<pg8::EpiStore<0, 0, true>, pg8::StaticOrder, true, true>(lds, g, S, E, wave_s); }
            {   pg8::Gemm g{KVCn, MKn, R, 1024, 256}; pg8::StaticOrder S; S.init(R, 1024, G, (bx + G / 2) % G); S.rev = dir;        pg8::EpiMlaKn E{Kb, SSQkv, KR, ap->in[21] + i2 * 192 + 96};
                pg8::gemm_phase<pg8::EpiMlaKn, pg8::StaticOrder, true, true>(lds, g, S, E, wave_s); }
            {   pg8::Gemm g{MV, KVCn, 1024, R, 256}; pg8::StaticOrder S; S.init(1024, R, G, last ? bx : (bx + G / 4) % G); S.rev = dir; pg8::EpiVT<true> E{VT, 1024, SSQkv, ZSH, 0, 1.0f / 256.0f};
                pg8::gemm_phase<pg8::EpiVT<true>, pg8::StaticOrder, true, true>(lds, g, S, E, wave_s); }
            { xcd_barrier(xbar, wave_s); dir ^= 1; }
            {   const float* gq = ap->in[21] + i2 * 192; const float* gk = gq + 96;
                const int lane = fresh_lane(), wave = wave_s;
                const int nlat = 4096, nctx = last ? 0 : 512;
#ifndef NO_MLA
                unsigned* ctrs = (unsigned*)(ws + WS_CTL) + 3584 + 8 * L; volatile LAS unsigned* slot = (volatile LAS unsigned*)(lds + MISC_OFF) + 8;
                for (int u = grab_unit(ctrs, slot, wave_s); u < nlat + nctx; ) { bool tk_mine; const unsigned tk_next = ticket_issue(ctrs, wave_s, tk_mine);
                    int b, h, row0, nt;
                    if (u < nlat) { const int ur = dir ? (nlat - 1 - u) : u; const int qb = ur & 7; h = (ur >> 3) & 15; b = ur >> 7; row0 = b * 2048 + qb * 256 + wave * 32; nt = 36; }
                    else { const int uu = u - nlat; h = uu & 15; b = uu >> 4; row0 = NLAT + b * 256 + wave * 32; nt = 4; }
                    f32x16 o[2]; float l;
                    attn_pass<96, 64, false>(lds, Q + (size_t)row0 * MQP + h * 96, MQP, Kb + (size_t)(NLAT + b * 256) * MQP + h * 96, Kb + (size_t)(b * 2048) * MQP + h * 96, MQP,
                                      VT + ((size_t)b * 1024 + h * 64) * KV, nt, gq, row0, 0.10206207261596577f * LOG2E, o, l, wave_s);
                    { const int ln = fresh_lane(); attn_store<2>(ATT, row0, h * 64, o, 1.0f / (l + shx(l, 32, ln)), ln); }
                    u = ticket_publish(tk_next, tk_mine, slot);
                }
#endif
            }
            { xcd_barrier(xbar, wave_s); dir ^= 1; }
            {   const int Mr = last ? NLAT : R;
                pg8::Gemm g{ATT, MWout, Mr, 1024, 1024}; pg8::StaticOrder S; S.init(Mr, 1024, G, bx); S.rev = dir; pg8::EpiResid E{xl, xc, XLAT, XCTX, modl + 2048, H, norm_mlp + L * 1024, modl + 4096, SSQ2};
                zero_f32(SSQ1, R, vcu, NGW, wave_s);
                pg8::gemm_phase<pg8::EpiResid, pg8::StaticOrder, true, true>(lds, g, S, E, wave_s); }
        }
        { xcd_barrier(xbar, wave_s); dir ^= 1; }
        {   const int Mr = last ? NLAT : R; unsigned char* wm = ws + WS_W + 32 * MiB + (size_t)L * 16 * MiB; bf16* HID = (bf16*)RG;
            {   pg8::Gemm g{H, (const bf16*)wm, Mr, FF, 1024}; pg8::StaticOrder S; S.init(Mr, FF, G, bx); S.rev = dir; pg8::EpiStore<1, 0, true> E{HID, FF, SSQ2, SHW1, 4096, 1.0f / 1024.0f};
                pg8::gemm_phase<pg8::EpiStore<1, 0, true>, pg8::StaticOrder, true, true>(lds, g, S, E, wave_s); }
            { xcd_barrier(xbar, wave_s); dir ^= 1; }
            {   pg8::Gemm g{HID, (const bf16*)(wm + 8 * MiB), Mr, 1024, FF}; pg8::StaticOrder S; S.init(Mr, 1024, G, bx); S.rev = dir; pg8::EpiResid E{XLAT, XCTX, XLAT, XCTX, modl + 5120, last ? (bf16*)nullptr : H, norm_mix + Ln * 1024, MOD + (size_t)Ln * 33 * 6144 + 1024, SSQ1};
                zero_f32(SSQ2, R, vcu, NGW, wave_s); zero_f32((float*)(ws + WS_SSQM), 229376, vcu, NGW, wave_s);
                pg8::gemm_phase<pg8::EpiResid, pg8::StaticOrder, true, true>(lds, g, S, E, wave_s); }
        }
        { xcd_barrier(xbar, wave_s); dir ^= 1; }
    }
}

extern "C" void kernel_launch(void* const* d_in, const int* in_sizes, int n_in, void* d_out, int out_size, void* d_ws, size_t ws_size, hipStream_t stream) {
    static int grid = 0;
    if (grid == 0) {
        if (n_in != 23 || out_size != NLAT * D || ws_size < WS_END) { fprintf(stderr, "kernel_launch: unexpected shapes (n_in %d, out %d, ws %zu)\n", n_in, out_size, ws_size); grid = -1; return; }
        int dev = 0, cus = 0, per_cu = 0;
        hipGetDevice(&dev); hipDeviceGetAttribute(&cus, hipDeviceAttributeMultiprocessorCount, dev);
        if (hipFuncSetAttribute((const void*)mega_fwd, hipFuncAttributeMaxDynamicSharedMemorySize, LDS_BYTES) != hipSuccess) { fprintf(stderr, "kernel_launch: hipFuncSetAttribute failed\n"); grid = -1; return; }
        if (hipOccupancyMaxActiveBlocksPerMultiprocessor(&per_cu, (const void*)mega_fwd, NTHR, LDS_BYTES) != hipSuccess || per_cu < 1) { fprintf(stderr, "kernel_launch: occupancy query says %d\n", per_cu); per_cu = 1; }
        (void)hipGetLastError();
        grid = cus;
    }
    if (grid < 0) return;
    if (hipMemsetAsync((char*)d_ws + WS_CTL, 0, CTL_BYTES, stream) != hipSuccess) { fprintf(stderr, "kernel_launch: memset failed\n"); return; }
    Args a{};
    for (int i = 0; i < 23; ++i) a.in[i] = (const float*)d_in[i];
    a.out = (float*)d_out; a.ws = (unsigned char*)d_ws;
    void* kargs[] = {&a};
    hipError_t e = hipLaunchCooperativeKernel((const void*)mega_fwd, dim3(grid), dim3(NTHR), kargs, LDS_BYTES, stream);
    if (e != hipSuccess) fprintf(stderr, "kernel_launch: cooperative launch failed: %s (grid %d)\n", hipGetErrorString(e), grid);
}
```
